# Optimizing an MI355X kernel written in HIP

```python
import math
import jax, jax.numpy as jnp
from jax import lax
import numpy as np

D_MODEL = 1024
BATCH = 8
SEQ = 2048
DEPTH = 4
DEC_BATCH = 128
DEC_SEQ = 1
PAST_LEN = 16384
PAGE_SIZE = 128

N_META = 16
W_BRANCH = 512
D_MIX = 3 * W_BRANCH
CONV_W = 4
RG_BLOCKS = 8
RG_BLOCK = W_BRANCH // RG_BLOCKS
RG_C = 8.0
RET_HEADS = 4
RET_DK = W_BRANCH // RET_HEADS
RET_CHUNK = 64
ROPE_BASE = 10000.0
GDN_HEADS = 4
GDN_DK = W_BRANCH // GDN_HEADS
GDN_CHUNK = 64
EPS = 1e-6
DEEPNORM_ALPHA = (2.0 * DEPTH) ** 0.25
DEEPNORM_BETA = (8.0 * DEPTH) ** -0.25
D_IN = 10 * W_BRANCH + 2 * GDN_HEADS

kernel_name = "hymba_rglru_retention_gdn_deepnorm_step"


def _layernorm(x, w, b):
    x = x.astype(jnp.float32)
    mu = jnp.mean(x, -1, keepdims=True)
    var = jnp.mean(jnp.square(x - mu), -1, keepdims=True)
    return (x - mu) * lax.rsqrt(var + EPS) * w + b


def _heads(t, h):
    b, s, _ = t.shape
    return t.reshape(b, s, h, -1).transpose(0, 2, 1, 3)


def _merge(t):
    b, h, s, d = t.shape
    return t.transpose(0, 2, 1, 3).reshape(b, s, h * d)


def _l2norm(t):
    return t * lax.rsqrt(jnp.sum(t * t, -1, keepdims=True) + EPS)


def _rope(t, pos):
    half = t.shape[-1] // 2
    inv = ROPE_BASE ** (-jnp.arange(half, dtype=jnp.float32) / half)
    ang = pos[:, None] * inv[None, :]
    cos, sin = jnp.cos(ang), jnp.sin(ang)
    t1, t2 = t[..., :half], t[..., half:]
    return jnp.concatenate([t1 * cos - t2 * sin, t1 * sin + t2 * cos], -1)


def _causal_conv(x, buf, w):
    t = x.shape[1]
    xp = jnp.concatenate([buf.astype(x.dtype), x], axis=1)
    y = sum(w[j].astype(jnp.float32) * xp[:, j:j + t] for j in range(CONV_W))
    return y, xp[:, -(CONV_W - 1):]


def _rglru(x, h0, w_a, b_a, w_x, b_x, lam):
    b, t, _ = x.shape
    xb = x.reshape(b, t, RG_BLOCKS, RG_BLOCK)
    r = jax.nn.sigmoid(jnp.einsum('btnc,ncd->btnd', xb, w_a.astype(jnp.float32)).reshape(b, t, W_BRANCH) + b_a)
    i = jax.nn.sigmoid(jnp.einsum('btnc,ncd->btnd', xb, w_x.astype(jnp.float32)).reshape(b, t, W_BRANCH) + b_x)
    log_a = -RG_C * r * jax.nn.softplus(-lam.astype(jnp.float32))
    a = jnp.exp(log_a)
    u = jnp.sqrt(-jnp.expm1(2.0 * log_a)) * (i * x)
    u = u.at[:, 0].add(a[:, 0] * h0.astype(jnp.float32))

    def comb(l, r_):
        a1, b1 = l
        a2, b2 = r_
        return a1 * a2, a2 * b1 + b2

    _, h = lax.associative_scan(comb, (a, u), axis=1)
    return h, h[:, -1]


def _segments(t, lead, chunk):
    segs = []
    if lead > 0:
        segs.append((lead, lead))
    rest = t - lead
    segs.append((rest, chunk if rest % chunk == 0 else rest))
    return segs


def _chunk_run(make_step, chunk, s, xs, lead):
    t = xs[0].shape[2]
    outs, start = [], 0
    for length, c in _segments(t, lead, chunk):
        n = length // c
        seg = tuple(jnp.moveaxis(a[:, :, start:start + length].reshape(a.shape[:2] + (n, c) + a.shape[3:]), 2, 0)
                    for a in xs)
        s, o = lax.scan(make_step(c), s, seg)
        o = jnp.moveaxis(o, 0, 2)
        outs.append(o.reshape(o.shape[:2] + (length,) + o.shape[4:]))
        start += length
    return jnp.concatenate(outs, axis=2), s


def _ret_step(c):
    lg = jnp.log1p(-jnp.exp2(-5.0 - jnp.arange(RET_HEADS, dtype=jnp.float32)))[:, None, None]
    idx = jnp.arange(c, dtype=jnp.float32)
    diff = idx[:, None] - idx[None, :]
    decay = jnp.where(diff >= 0, jnp.exp(lg * jnp.maximum(diff, 0.0)), 0.0)
    q_dec = jnp.exp(lg[:, 0] * (idx + 1.0))[:, :, None]
    k_dec = jnp.exp(lg[:, 0] * (c - 1.0 - idx))[:, :, None]
    s_dec = jnp.exp(lg * c)

    def step(s, xs):
        q, k, v = xs
        sc = jnp.einsum('bhid,bhjd->bhij', q, k) * decay
        o = jnp.einsum('bhij,bhjv->bhiv', sc, v) + jnp.einsum('bhid,bhdv->bhiv', q * q_dec, s)
        s = s * s_dec + jnp.einsum('bhjd,bhjv->bhdv', k * k_dec, v)
        return s, o
    return step


def _gdn_step(c):
    tril = jnp.tril(jnp.ones((c, c), bool))
    strict = jnp.tril(jnp.ones((c, c), bool), -1)
    eye = jnp.eye(c, dtype=jnp.float32)

    def step(s, xs):
        q, k, v, g, beta = xs
        gc = jnp.cumsum(g, axis=-1)
        decay = jnp.exp(jnp.where(tril, gc[..., :, None] - gc[..., None, :], -jnp.inf))
        kb = k * beta[..., None]
        a_low = jnp.where(strict, jnp.einsum('bhid,bhjd->bhij', kb, k) * decay, 0.0)
        rhs = jnp.concatenate([v * beta[..., None], kb * jnp.exp(gc)[..., None]], -1)
        sol = lax.linalg.triangular_solve(eye + a_low, rhs, left_side=True, lower=True)
        u, w = sol[..., :GDN_DK], sol[..., GDN_DK:]
        v_new = u - jnp.einsum('bhik,bhkv->bhiv', w, s)
        att = jnp.einsum('bhid,bhjd->bhij', q, k) * decay
        o = jnp.einsum('bhik,bhkv->bhiv', q * jnp.exp(gc)[..., None], s) + jnp.einsum('bhij,bhjv->bhiv', att, v_new)
        g_last = gc[..., -1:]
        s = s * jnp.exp(g_last)[..., None] + jnp.einsum('bhik,bhiv->bhkv', k * jnp.exp(g_last - gc)[..., None], v_new)
        return s, o
    return step


def _layer(x, pos, lead, h0, rg_buf, s_ret, gdn_buf, s_gdn,
           w_in, rg_conv_w, rg_conv_b, rg_w_a, rg_b_a, rg_w_x, rg_b_x, rg_lambda,
           ret_gn_w, ret_gn_b, gdn_conv_w, gdn_a_log, gdn_dt_bias, gdn_norm_w,
           w_out, ln_w, ln_b):
    f32 = jnp.float32
    W = W_BRANCH
    u = jnp.einsum('btd,de->bte', x, w_in).astype(f32)
    rg_in, rg_z = u[..., 0:W], u[..., W:2 * W]
    r_q, r_k, r_v, r_z = (u[..., (2 + j) * W:(3 + j) * W] for j in range(4))
    g_qkv, g_z = u[..., 6 * W:9 * W], u[..., 9 * W:10 * W]
    g_a, g_b = u[..., 10 * W:10 * W + GDN_HEADS], u[..., 10 * W + GDN_HEADS:]

    rg_c, rg_buf_new = _causal_conv(rg_in, rg_buf, rg_conv_w)
    rg_h, h_new = _rglru(rg_c + rg_conv_b, h0, rg_w_a, rg_b_a, rg_w_x, rg_b_x, rg_lambda)
    y_rg = rg_h * jax.nn.silu(rg_z)

    q = _rope(_heads(r_q, RET_HEADS), pos)
    k = _rope(_heads(r_k, RET_HEADS), pos) * RET_DK ** -0.5
    v = _heads(r_v, RET_HEADS)
    o, s_ret_new = _chunk_run(_ret_step, RET_CHUNK, s_ret.astype(f32), (q, k, v), lead)
    mu = jnp.mean(o, -1, keepdims=True)
    o = (o - mu) * lax.rsqrt(jnp.mean(jnp.square(o - mu), -1, keepdims=True) + EPS)
    y_ret = (_merge(o) * ret_gn_w + ret_gn_b) * jax.nn.silu(r_z)

    gc_, gdn_buf_new = _causal_conv(g_qkv, gdn_buf, gdn_conv_w)
    gc_ = jax.nn.silu(gc_)
    gq = _l2norm(_heads(gc_[..., :W], GDN_HEADS)) * GDN_DK ** -0.5
    gk = _l2norm(_heads(gc_[..., W:2 * W], GDN_HEADS))
    gv = _heads(gc_[..., 2 * W:], GDN_HEADS)
    g_log = -jnp.exp(gdn_a_log.astype(f32)) * jax.nn.softplus(g_a + gdn_dt_bias)
    beta = jax.nn.sigmoid(g_b)
    o, s_gdn_new = _chunk_run(_gdn_step, GDN_CHUNK, s_gdn.astype(f32),
                              (gq, gk, gv, g_log.transpose(0, 2, 1), beta.transpose(0, 2, 1)), lead)
    o = o * lax.rsqrt(jnp.mean(jnp.square(o), -1, keepdims=True) + EPS) * gdn_norm_w
    y_gdn = _merge(o) * jax.nn.silu(g_z)

    mix = jnp.concatenate([y_rg, y_ret, y_gdn], -1)
    out = jnp.einsum('bte,ed->btd', mix, w_out.astype(f32))
    y = _layernorm(DEEPNORM_ALPHA * x.astype(f32) + out, ln_w, ln_b).astype(x.dtype)
    return y, h_new, rg_buf_new, s_ret_new, gdn_buf_new, s_gdn_new


def setup_inputs(seed: int = 0) -> dict:
    key = jax.random.key(seed)
    ks = jax.random.split(key, 32)
    nrm = jax.random.normal
    f32 = jnp.float32
    a_init = jax.random.uniform(ks[12], (DEPTH, W_BRANCH), f32, 0.9, 0.999)
    dt = jnp.exp(jax.random.uniform(ks[16], (DEPTH, GDN_HEADS), f32, math.log(1e-3), math.log(1e-1)))
    return {
        "x_prompt": nrm(ks[0], (BATCH, SEQ, D_MODEL), f32),
        "x_sample": nrm(ks[1], (DEC_BATCH, DEC_SEQ, D_MODEL), f32),
        "state_rglru_h": 0.5 * nrm(ks[2], (DEPTH, DEC_BATCH, W_BRANCH), f32),
        "state_rglru_conv": nrm(ks[3], (DEPTH, DEC_BATCH, CONV_W - 1, W_BRANCH), f32),
        "state_ret": 0.5 * nrm(ks[4], (DEPTH, DEC_BATCH, RET_HEADS, RET_DK, RET_DK), f32),
        "state_gdn_conv": nrm(ks[5], (DEPTH, DEC_BATCH, CONV_W - 1, 3 * W_BRANCH), f32),
        "state_gdn": 0.1 * nrm(ks[6], (DEPTH, DEC_BATCH, GDN_HEADS, GDN_DK, GDN_DK), f32),
        "meta_tokens": nrm(ks[7], (N_META, D_MODEL), f32),
        "w_in": nrm(ks[8], (DEPTH, D_MODEL, D_IN), f32) * D_MODEL ** -0.5,
        "rg_conv_w": nrm(ks[9], (DEPTH, CONV_W, W_BRANCH), f32) * CONV_W ** -0.5,
        "rg_conv_b": 0.01 * nrm(ks[10], (DEPTH, W_BRANCH), f32),
        "rg_w_a": nrm(ks[11], (DEPTH, RG_BLOCKS, RG_BLOCK, RG_BLOCK), f32) * RG_BLOCK ** -0.5,
        "rg_b_a": 0.01 * nrm(ks[13], (DEPTH, W_BRANCH), f32),
        "rg_w_x": nrm(ks[14], (DEPTH, RG_BLOCKS, RG_BLOCK, RG_BLOCK), f32) * RG_BLOCK ** -0.5,
        "rg_b_x": 0.01 * nrm(ks[15], (DEPTH, W_BRANCH), f32),
        "rg_lambda": jnp.log(a_init) - jnp.log1p(-a_init),
        "ret_gn_w": 1.0 + 0.02 * nrm(ks[17], (DEPTH, W_BRANCH), f32),
        "ret_gn_b": 0.01 * nrm(ks[18], (DEPTH, W_BRANCH), f32),
        "gdn_conv_w": nrm(ks[19], (DEPTH, CONV_W, 3 * W_BRANCH), f32) * CONV_W ** -0.5,
        "gdn_a_log": jnp.log(jax.random.uniform(ks[20], (DEPTH, GDN_HEADS), f32, 1.0, 16.0)),
        "gdn_dt_bias": dt + jnp.log(-jnp.expm1(-dt)),
        "gdn_norm_w": 1.0 + 0.02 * nrm(ks[21], (DEPTH, GDN_DK), f32),
        "w_out": nrm(ks[22], (DEPTH, D_MIX, D_MODEL), f32) * (D_MIX ** -0.5) * DEEPNORM_BETA,
        "ln_w": 1.0 + 0.02 * nrm(ks[23], (DEPTH, D_MODEL), f32),
        "ln_b": 0.01 * nrm(ks[24], (DEPTH, D_MODEL), f32),
    }


def reference(x_prompt, x_sample, state_rglru_h, state_rglru_conv, state_ret, state_gdn_conv, state_gdn,
              meta_tokens, w_in, rg_conv_w, rg_conv_b, rg_w_a, rg_b_a, rg_w_x, rg_b_x, rg_lambda,
              ret_gn_w, ret_gn_b, gdn_conv_w, gdn_a_log, gdn_dt_bias, gdn_norm_w, w_out, ln_w, ln_b):
    f32 = jnp.float32
    bp = x_prompt.shape[0]
    meta = jnp.broadcast_to(meta_tokens.astype(x_prompt.dtype)[None], (bp, N_META, D_MODEL))
    xp = jnp.concatenate([meta, x_prompt], axis=1)
    xs = x_sample
    pos_p = jnp.arange(xp.shape[1], dtype=f32)
    pos_s = jnp.arange(xs.shape[1], dtype=f32) + float(PAST_LEN)
    new_p = [[], [], [], [], []]
    new_s = [[], [], [], [], []]
    for l in range(DEPTH):
        params = (w_in[l], rg_conv_w[l], rg_conv_b[l], rg_w_a[l], rg_b_a[l], rg_w_x[l], rg_b_x[l], rg_lambda[l],
                  ret_gn_w[l], ret_gn_b[l], gdn_conv_w[l], gdn_a_log[l], gdn_dt_bias[l], gdn_norm_w[l],
                  w_out[l], ln_w[l], ln_b[l])
        xp, *st_p = _layer(xp, pos_p, N_META,
                           jnp.zeros((bp, W_BRANCH), f32),
                           jnp.zeros((bp, CONV_W - 1, W_BRANCH), f32),
                           jnp.zeros((bp, RET_HEADS, RET_DK, RET_DK), f32),
                           jnp.zeros((bp, CONV_W - 1, 3 * W_BRANCH), f32),
                           jnp.zeros((bp, GDN_HEADS, GDN_DK, GDN_DK), f32),
                           *params)
        xs, *st_s = _layer(xs, pos_s, 0, state_rglru_h[l], state_rglru_conv[l], state_ret[l],
                           state_gdn_conv[l], state_gdn[l], *params)
        for j in range(5):
            new_p[j].append(st_p[j])
            new_s[j].append(st_s[j])
    y_prompt = xp[:, N_META:]
    y_sample = xs
    dts = (state_rglru_h.dtype, state_rglru_conv.dtype, state_ret.dtype, state_gdn_conv.dtype, state_gdn.dtype)
    sp = [jnp.stack(new_p[j]).astype(dts[j]) for j in range(5)]
    ss = [jnp.stack(new_s[j]).astype(dts[j]) for j in range(5)]
    return (y_prompt, y_sample, sp[0], sp[1], sp[2], sp[3], sp[4], ss[0], ss[1], ss[2], ss[3], ss[4])
```

```cpp
#include <hip/hip_runtime.h>
#include <cstdio>
#include <cstdint>
namespace nv {
constexpr int DM = 1024, TP = 2064, NMETA = 16, SEQ = 2048, NBATCH = 8, NSAMP = 128, DEPTH = 4;
constexpr int W = 512, DIN = 5128, DMIX = 1536;
constexpr float EPS = 1e-6f;
constexpr float ALPHA = 1.681792830507429f;

struct Grp { int b0, nB, s0, nS; };
__host__ __device__ inline int grp_rows(const Grp& g) { return g.nB * TP + g.nS; }

__device__ __forceinline__ float sigmoidf_(float x) { return 1.f / (1.f + __expf(-x)); }
__device__ __forceinline__ float siluf_(float x) { return x / (1.f + __expf(-x)); }
__device__ __forceinline__ float softplusf_(float x) { return x > 20.f ? x : log1pf(__expf(x)); }
__device__ __forceinline__ void rope_cs(float pos, int i, float& c, float& s) {
    const float inv = exp2f(-(float)i * (13.287712379549449f / 64.f));
    const float ang = pos * inv;
    const double rev = (double)ang * 0.15915494309189535;
    const double fr = rev - rint(rev);
    const float r = (float)(fr * 6.283185307179586);
    c = __cosf(r); s = __sinf(r);
}

__global__ void build_x(Grp g, const float* __restrict__ xp, const float* __restrict__ xs, const float* __restrict__ meta, float* __restrict__ X) {
    const int m = blockIdx.x, M = grp_rows(g);
    if (m >= M) return;
    const float* src;
    if (m < g.nB * TP) { const int bi = m / TP, t = m % TP; src = t < NMETA ? meta + (size_t)t * DM : xp + ((size_t)(g.b0 + bi) * SEQ + (t - NMETA)) * DM; }
    else src = xs + (size_t)(g.s0 + m - g.nB * TP) * DM;
    for (int c = threadIdx.x; c < DM; c += blockDim.x) X[(size_t)m * DM + c] = src[c];
}

__global__ void __launch_bounds__(256) gemm_f32(const float* __restrict__ A, const float* __restrict__ B, float* __restrict__ C, int M, int N, int K) {
    __shared__ float sA[16][64 + 4];
    __shared__ float sB[16][64 + 4];
    const int tx = threadIdx.x % 16, ty = threadIdx.x / 16;
    const int m0 = blockIdx.y * 64, n0 = blockIdx.x * 64;
    float acc[4][4];
#pragma unroll
    for (int i = 0; i < 4; ++i)
#pragma unroll
        for (int j = 0; j < 4; ++j) acc[i][j] = 0.f;
    for (int k0 = 0; k0 < K; k0 += 16) {
        { const int r = threadIdx.x / 4, kk = (threadIdx.x % 4) * 4; const int gm = m0 + r;
          float4 v = make_float4(0.f, 0.f, 0.f, 0.f);
          if (gm < M) v = *(const float4*)(A + (size_t)gm * K + k0 + kk);
          sA[kk + 0][r] = v.x; sA[kk + 1][r] = v.y; sA[kk + 2][r] = v.z; sA[kk + 3][r] = v.w; }
        { const int kk = threadIdx.x / 16, nn = (threadIdx.x % 16) * 4;
#pragma unroll
          for (int j = 0; j < 4; ++j) { const int gn = n0 + nn + j; sB[kk][nn + j] = gn < N ? B[(size_t)(k0 + kk) * N + gn] : 0.f; } }
        __syncthreads();
#pragma unroll
        for (int kk = 0; kk < 16; ++kk) {
            float a[4], b[4];
#pragma unroll
            for (int i = 0; i < 4; ++i) a[i] = sA[kk][ty * 4 + i];
#pragma unroll
            for (int j = 0; j < 4; ++j) b[j] = sB[kk][tx * 4 + j];
#pragma unroll
            for (int i = 0; i < 4; ++i)
#pragma unroll
                for (int j = 0; j < 4; ++j) acc[i][j] = fmaf(a[i], b[j], acc[i][j]);
        }
        __syncthreads();
    }
#pragma unroll
    for (int i = 0; i < 4; ++i) { const int gm = m0 + ty * 4 + i; if (gm >= M) continue;
#pragma unroll
        for (int j = 0; j < 4; ++j) { const int gn = n0 + tx * 4 + j; if (gn < N) C[(size_t)gm * N + gn] = acc[i][j]; } }
}

struct LayerP {
    const float *rg_conv_w, *rg_conv_b, *rg_w_a, *rg_b_a, *rg_w_x, *rg_b_x, *rg_lambda, *ret_gn_w, *ret_gn_b, *gdn_conv_w, *gdn_a_log, *gdn_dt_bias, *gdn_norm_w, *ln_w, *ln_b;
    const float *st_h, *st_conv, *st_ret, *st_gconv, *st_gdn;
    float *o_hp, *o_cp, *o_rp, *o_gcp, *o_gp, *o_hs, *o_cs, *o_rs, *o_gcs, *o_gs;
};

struct SeqD { int row0, T; float pos0; int gb; int gs; };
__device__ __forceinline__ SeqD seq_of(const Grp& g, int q) {
    SeqD s; if (q < g.nB) { s.row0 = q * TP; s.T = TP; s.pos0 = 0.f; s.gb = g.b0 + q; s.gs = -1; }
    else { s.row0 = g.nB * TP + (q - g.nB); s.T = 1; s.pos0 = 16384.f; s.gb = -1; s.gs = g.s0 + (q - g.nB); }
    return s;
}

__global__ void __launch_bounds__(64) rg_kernel(Grp g, LayerP P, const float* __restrict__ U, float* __restrict__ MIX) {
    const int n = blockIdx.x, d = threadIdx.x, ch = n * 64 + d;
    const SeqD sq = seq_of(g, blockIdx.y);
    __shared__ float sx[64];
    float wa[64], wx[64];
#pragma unroll
    for (int c = 0; c < 64; ++c) { wa[c] = P.rg_w_a[((size_t)n * 64 + c) * 64 + d]; wx[c] = P.rg_w_x[((size_t)n * 64 + c) * 64 + d]; }
    const float cw0 = P.rg_conv_w[0 * W + ch], cw1 = P.rg_conv_w[1 * W + ch], cw2 = P.rg_conv_w[2 * W + ch], cw3 = P.rg_conv_w[3 * W + ch], cb = P.rg_conv_b[ch];
    const float ba = P.rg_b_a[ch], bx = P.rg_b_x[ch], sp = softplusf_(-P.rg_lambda[ch]);
    float x0 = 0.f, x1 = 0.f, x2 = 0.f, h = 0.f;
    if (sq.gs >= 0) { const float* cv = P.st_conv + (size_t)sq.gs * 3 * W; x0 = cv[0 * W + ch]; x1 = cv[1 * W + ch]; x2 = cv[2 * W + ch]; h = P.st_h[(size_t)sq.gs * W + ch]; }
    for (int t = 0; t < sq.T; ++t) {
        const size_t m = (size_t)(sq.row0 + t);
        const float x3 = U[m * DIN + ch], z = U[m * DIN + W + ch];
        const float xr = cw0 * x0 + cw1 * x1 + cw2 * x2 + cw3 * x3 + cb;
        __syncthreads();
        sx[d] = xr;
        __syncthreads();
        float ra = 0.f, rx = 0.f;
#pragma unroll
        for (int c = 0; c < 64; ++c) { const float xc = sx[c]; ra = fmaf(xc, wa[c], ra); rx = fmaf(xc, wx[c], rx); }
        const float r = sigmoidf_(ra + ba), ig = sigmoidf_(rx + bx);
        const float log_a = -8.f * r * sp, a = __expf(log_a);
        const float mult = sqrtf(fmaxf(-expm1f(2.f * log_a), 0.f));
        h = a * h + mult * (ig * xr);
        MIX[m * DMIX + ch] = h * siluf_(z);
        x0 = x1; x1 = x2; x2 = x3;
    }
    if (sq.gb >= 0) { P.o_hp[(size_t)sq.gb * W + ch] = h; float* o = P.o_cp + (size_t)sq.gb * 3 * W; o[0 * W + ch] = x0; o[1 * W + ch] = x1; o[2 * W + ch] = x2; }
    else { P.o_hs[(size_t)sq.gs * W + ch] = h; float* o = P.o_cs + (size_t)sq.gs * 3 * W; o[0 * W + ch] = x0; o[1 * W + ch] = x1; o[2 * W + ch] = x2; }
}

__global__ void __launch_bounds__(256) ret_kernel(Grp g, LayerP P, const float* __restrict__ U, float* __restrict__ MIX) {
    const int hd = blockIdx.x, tid = threadIdx.x, dv = tid & 127, half = tid >> 7;
    const SeqD sq = seq_of(g, blockIdx.y);
    __shared__ float sq_[128], sk_[128], part[2][128], red[256];
    float S[64];
    if (sq.gs >= 0) { const float* st = P.st_ret + ((size_t)sq.gs * 4 + hd) * 16384;
#pragma unroll
        for (int i = 0; i < 64; ++i) S[i] = st[(size_t)(half * 64 + i) * 128 + dv]; }
    else {
#pragma unroll
        for (int i = 0; i < 64; ++i) S[i] = 0.f; }
    const float gam = 1.f - exp2f(-5.f - (float)hd);
    const float gw = P.ret_gn_w[hd * 128 + dv], gb = P.ret_gn_b[hd * 128 + dv];
    for (int t = 0; t < sq.T; ++t) {
        const size_t m = (size_t)(sq.row0 + t); const float* u = U + m * DIN;
        __syncthreads();
        if (tid < 64) {
            float c, s; rope_cs(sq.pos0 + (float)t, tid, c, s);
            const float q1 = u[1024 + hd * 128 + tid], q2 = u[1024 + hd * 128 + 64 + tid];
            const float k1 = u[1536 + hd * 128 + tid], k2 = u[1536 + hd * 128 + 64 + tid];
            sq_[tid] = q1 * c - q2 * s; sq_[64 + tid] = q1 * s + q2 * c;
            const float sc = 0.08838834764831845f;
            sk_[tid] = (k1 * c - k2 * s) * sc; sk_[64 + tid] = (k1 * s + k2 * c) * sc;
        }
        __syncthreads();
        const float v = u[2048 + hd * 128 + dv];
        float acc = 0.f;
#pragma unroll
        for (int i = 0; i < 64; ++i) { S[i] = gam * S[i] + sk_[half * 64 + i] * v; acc = fmaf(sq_[half * 64 + i], S[i], acc); }
        part[half][dv] = acc;
        __syncthreads();
        const float o = part[0][dv] + part[1][dv];
        red[tid] = half == 0 ? o : 0.f;
        __syncthreads();
        for (int s = 128; s > 0; s >>= 1) { if (tid < s) red[tid] += red[tid + s]; __syncthreads(); }
        const float mu = red[0] * (1.f / 128.f);
        __syncthreads();
        red[tid] = half == 0 ? (o - mu) * (o - mu) : 0.f;
        __syncthreads();
        for (int s = 128; s > 0; s >>= 1) { if (tid < s) red[tid] += red[tid + s]; __syncthreads(); }
        const float var = red[0] * (1.f / 128.f);
        if (half == 0) { const float z = u[2560 + hd * 128 + dv]; MIX[m * DMIX + 512 + hd * 128 + dv] = ((o - mu) * rsqrtf(var + EPS) * gw + gb) * siluf_(z); }
    }
    float* so = (sq.gb >= 0) ? P.o_rp + ((size_t)sq.gb * 4 + hd) * 16384 : P.o_rs + ((size_t)sq.gs * 4 + hd) * 16384;
#pragma unroll
    for (int i = 0; i < 64; ++i) so[(size_t)(half * 64 + i) * 128 + dv] = S[i];
}

__global__ void __launch_bounds__(256) gdn_kernel(Grp g, LayerP P, const float* __restrict__ U, float* __restrict__ MIX) {
    const int hd = blockIdx.x, tid = threadIdx.x, dv = tid & 127, half = tid >> 7;
    const SeqD sq = seq_of(g, blockIdx.y);
    __shared__ float sq_[128], sk_[128], sv_[128], part[2][128], red[256], svn[128];
    float S[64];
    if (sq.gs >= 0) { const float* st = P.st_gdn + ((size_t)sq.gs * 4 + hd) * 16384;
#pragma unroll
        for (int i = 0; i < 64; ++i) S[i] = st[(size_t)(half * 64 + i) * 128 + dv]; }
    else {
#pragma unroll
        for (int i = 0; i < 64; ++i) S[i] = 0.f; }
    const int chA = tid < 128 ? hd * 128 + tid : 512 + hd * 128 + (tid - 128);
    const int chB = 1024 + hd * 128 + (tid & 127);
    const float a0 = P.gdn_conv_w[0 * 1536 + chA], a1 = P.gdn_conv_w[1 * 1536 + chA], a2 = P.gdn_conv_w[2 * 1536 + chA], a3 = P.gdn_conv_w[3 * 1536 + chA];
    const float b0 = P.gdn_conv_w[0 * 1536 + chB], b1 = P.gdn_conv_w[1 * 1536 + chB], b2 = P.gdn_conv_w[2 * 1536 + chB], b3 = P.gdn_conv_w[3 * 1536 + chB];
    float xa0 = 0.f, xa1 = 0.f, xa2 = 0.f, xb0 = 0.f, xb1 = 0.f, xb2 = 0.f;
    if (sq.gs >= 0) { const float* cv = P.st_gconv + (size_t)sq.gs * 3 * 1536; xa0 = cv[chA]; xa1 = cv[1536 + chA]; xa2 = cv[2 * 1536 + chA]; xb0 = cv[chB]; xb1 = cv[1536 + chB]; xb2 = cv[2 * 1536 + chB]; }
    const float nA = -__expf(P.gdn_a_log[hd]), dtb = P.gdn_dt_bias[hd], nw = P.gdn_norm_w[dv];
    for (int t = 0; t < sq.T; ++t) {
        const size_t m = (size_t)(sq.row0 + t); const float* u = U + m * DIN;
        const float xa3 = u[3072 + chA], xb3 = u[3072 + chB];
        const float ca = siluf_(a0 * xa0 + a1 * xa1 + a2 * xa2 + a3 * xa3);
        const float cbv = siluf_(b0 * xb0 + b1 * xb1 + b2 * xb2 + b3 * xb3);
        xa0 = xa1; xa1 = xa2; xa2 = xa3; xb0 = xb1; xb1 = xb2; xb2 = xb3;
        __syncthreads();
        red[tid] = ca * ca;
        if (tid < 128) sv_[tid] = cbv;
        __syncthreads();
        for (int s = 64; s > 0; s >>= 1) { if ((tid & 127) < s) red[tid] += red[tid + s]; __syncthreads(); }
        const float ssq = red[tid & 128];
        const float nrm = ca * rsqrtf(ssq + EPS);
        if (tid < 128) sq_[tid] = nrm * 0.08838834764831845f; else sk_[tid - 128] = nrm;
        __syncthreads();
        const float gl = nA * softplusf_(u[5120 + hd] + dtb), eg = __expf(gl), beta = sigmoidf_(u[5124 + hd]);
        float kS = 0.f;
#pragma unroll
        for (int i = 0; i < 64; ++i) kS = fmaf(sk_[half * 64 + i], S[i], kS);
        part[half][dv] = kS;
        __syncthreads();
        const float vn = beta * (sv_[dv] - eg * (part[0][dv] + part[1][dv]));
        float acc = 0.f;
#pragma unroll
        for (int i = 0; i < 64; ++i) { S[i] = eg * S[i] + sk_[half * 64 + i] * vn; acc = fmaf(sq_[half * 64 + i], S[i], acc); }
        __syncthreads();
        part[half][dv] = acc;
        __syncthreads();
        const float o = part[0][dv] + part[1][dv];
        red[tid] = half == 0 ? o * o : 0.f;
        __syncthreads();
        for (int s = 128; s > 0; s >>= 1) { if (tid < s) red[tid] += red[tid + s]; __syncthreads(); }
        const float ms = red[0] * (1.f / 128.f);
        if (half == 0) { const float z = u[4608 + hd * 128 + dv]; MIX[m * DMIX + 1024 + hd * 128 + dv] = o * rsqrtf(ms + EPS) * nw * siluf_(z); }
    }
    float* so = (sq.gb >= 0) ? P.o_gp + ((size_t)sq.gb * 4 + hd) * 16384 : P.o_gs + ((size_t)sq.gs * 4 + hd) * 16384;
#pragma unroll
    for (int i = 0; i < 64; ++i) so[(size_t)(half * 64 + i) * 128 + dv] = S[i];
    float* co = (sq.gb >= 0) ? P.o_gcp + (size_t)sq.gb * 3 * 1536 : P.o_gcs + (size_t)sq.gs * 3 * 1536;
    co[chA] = xa0; co[1536 + chA] = xa1; co[2 * 1536 + chA] = xa2;
    if (tid < 128) { co[chB] = xb0; co[1536 + chB] = xb1; co[2 * 1536 + chB] = xb2; }
}

__global__ void __launch_bounds__(256) ln_kernel(int M, const float* __restrict__ Y, float* __restrict__ X, const float* __restrict__ w, const float* __restrict__ b) {
    const int m = blockIdx.x, tid = threadIdx.x;
    __shared__ float red[256];
    float v[4]; float s = 0.f;
#pragma unroll
    for (int j = 0; j < 4; ++j) { const int c = tid + 256 * j; v[j] = ALPHA * X[(size_t)m * DM + c] + Y[(size_t)m * DM + c]; s += v[j]; }
    red[tid] = s; __syncthreads();
    for (int st = 128; st > 0; st >>= 1) { if (tid < st) red[tid] += red[tid + st]; __syncthreads(); }
    const float mu = red[0] * (1.f / DM); __syncthreads();
    float q = 0.f;
#pragma unroll
    for (int j = 0; j < 4; ++j) { const float d = v[j] - mu; q += d * d; }
    red[tid] = q; __syncthreads();
    for (int st = 128; st > 0; st >>= 1) { if (tid < st) red[tid] += red[tid + st]; __syncthreads(); }
    const float rstd = rsqrtf(red[0] * (1.f / DM) + EPS);
#pragma unroll
    for (int j = 0; j < 4; ++j) { const int c = tid + 256 * j; X[(size_t)m * DM + c] = (v[j] - mu) * rstd * w[c] + b[c]; }
}

__global__ void write_y(Grp g, const float* __restrict__ X, float* __restrict__ yp, float* __restrict__ ys) {
    const int m = blockIdx.x;
    float* dst;
    if (m < g.nB * TP) { const int bi = m / TP, t = m % TP; if (t < NMETA) return; dst = yp + ((size_t)(g.b0 + bi) * SEQ + (t - NMETA)) * DM; }
    else dst = ys + (size_t)(g.s0 + m - g.nB * TP) * DM;
    for (int c = threadIdx.x; c < DM; c += blockDim.x) dst[c] = X[(size_t)m * DM + c];
}

struct Io { const float* in[25]; float* out; };
constexpr size_t O_YP = 0, O_YS = 16777216, O_HP = 16908288, O_CP = 16924672, O_RP = 16973824, O_GCP = 19070976, O_GP = 19218432,
                 O_HS = 21315584, O_CS = 21577728, O_RS = 22364160, O_GCS = 55918592, O_GS = 58277888, O_END = 91832320;

inline LayerP layer_params(const Io& io, int l) {
    LayerP P;
    P.rg_conv_w = io.in[9] + (size_t)l * 4 * W; P.rg_conv_b = io.in[10] + (size_t)l * W; P.rg_w_a = io.in[11] + (size_t)l * 8 * 64 * 64; P.rg_b_a = io.in[12] + (size_t)l * W;
    P.rg_w_x = io.in[13] + (size_t)l * 8 * 64 * 64; P.rg_b_x = io.in[14] + (size_t)l * W; P.rg_lambda = io.in[15] + (size_t)l * W;
    P.ret_gn_w = io.in[16] + (size_t)l * W; P.ret_gn_b = io.in[17] + (size_t)l * W; P.gdn_conv_w = io.in[18] + (size_t)l * 4 * 1536;
    P.gdn_a_log = io.in[19] + (size_t)l * 4; P.gdn_dt_bias = io.in[20] + (size_t)l * 4; P.gdn_norm_w = io.in[21] + (size_t)l * 128;
    P.ln_w = io.in[23] + (size_t)l * DM; P.ln_b = io.in[24] + (size_t)l * DM;
    P.st_h = io.in[2] + (size_t)l * NSAMP * W; P.st_conv = io.in[3] + (size_t)l * NSAMP * 3 * W; P.st_ret = io.in[4] + (size_t)l * NSAMP * 4 * 16384;
    P.st_gconv = io.in[5] + (size_t)l * NSAMP * 3 * 1536; P.st_gdn = io.in[6] + (size_t)l * NSAMP * 4 * 16384;
    float* o = io.out;
    P.o_hp = o + O_HP + (size_t)l * NBATCH * W; P.o_cp = o + O_CP + (size_t)l * NBATCH * 3 * W; P.o_rp = o + O_RP + (size_t)l * NBATCH * 4 * 16384;
    P.o_gcp = o + O_GCP + (size_t)l * NBATCH * 3 * 1536; P.o_gp = o + O_GP + (size_t)l * NBATCH * 4 * 16384;
    P.o_hs = o + O_HS + (size_t)l * NSAMP * W; P.o_cs = o + O_CS + (size_t)l * NSAMP * 3 * W; P.o_rs = o + O_RS + (size_t)l * NSAMP * 4 * 16384;
    P.o_gcs = o + O_GCS + (size_t)l * NSAMP * 3 * 1536; P.o_gs = o + O_GS + (size_t)l * NSAMP * 4 * 16384;
    return P;
}

inline size_t scratch_bytes(const Grp& g) { const size_t M = grp_rows(g); return M * (size_t)(DM + DIN + DMIX) * 4; }
inline void run(const Io& io, Grp g, unsigned char* ws, hipStream_t st, float** x_layers   = nullptr) {
    const int M = grp_rows(g), nSeq = g.nB + g.nS;
    float* X = (float*)ws; float* U = X + (size_t)M * DM; float* MIX = U + (size_t)M * DIN; float* Y = U;
    build_x<<<M, 256, 0, st>>>(g, io.in[0], io.in[1], io.in[7], X);
    for (int l = 0; l < DEPTH; ++l) {
        const LayerP P = layer_params(io, l);
        gemm_f32<<<dim3((DIN + 63) / 64, (M + 63) / 64), 256, 0, st>>>(X, io.in[8] + (size_t)l * DM * DIN, U, M, DIN, DM);
        rg_kernel<<<dim3(8, nSeq), 64, 0, st>>>(g, P, U, MIX);
        ret_kernel<<<dim3(4, nSeq), 256, 0, st>>>(g, P, U, MIX);
        gdn_kernel<<<dim3(4, nSeq), 256, 0, st>>>(g, P, U, MIX);
        gemm_f32<<<dim3(DM / 64, (M + 63) / 64), 256, 0, st>>>(MIX, io.in[22] + (size_t)l * DMIX * DM, Y, M, DM, DMIX);
        ln_kernel<<<M, 256, 0, st>>>(M, Y, X, P.ln_w, P.ln_b);
    }
    write_y<<<M, 256, 0, st>>>(g, X, io.out + O_YP, io.out + O_YS);
}
}

extern "C" void kernel_launch(void* const* d_in, const int* in_sizes, int n_in, void* d_out, int out_size, void* d_ws, size_t ws_size, hipStream_t stream) {
    nv::Io io; for (int i = 0; i < 25; ++i) io.in[i] = (const float*)d_in[i]; io.out = (float*)d_out;
    nv::run(io, nv::Grp{0, 4, 0, 64}, (unsigned char*)d_ws, stream);
    nv::run(io, nv::Grp{4, 4, 64, 64}, (unsigned char*)d_ws, stream);
}
```

```cpp
#include <hip/hip_runtime.h>
#include <cstdio>
#include <cstdint>
#define MK_DEBUG 0
#define MK_PROBE -1
#define MK_LAUNCH_PER_PHASE 1

namespace fx {
#define GAS __attribute__((address_space(1)))
#define LAS __attribute__((address_space(3)))
#define DI __device__ __forceinline__
typedef unsigned short bf16;
typedef short bf16x8 __attribute__((ext_vector_type(8)));
typedef float f32x4 __attribute__((ext_vector_type(4)));
typedef float f32x2 __attribute__((ext_vector_type(2)));
typedef unsigned u32x4 __attribute__((ext_vector_type(4)));
typedef unsigned u32x2 __attribute__((ext_vector_type(2)));
typedef GAS unsigned gu32;

constexpr int NWAVES = 8, NTHR = 512;
constexpr int DM = 1024, TP = 2064, NB = 8, NS = 128, MP = NB * TP, M = MP + NS, DIN = 5120, DINX = 5128, DMIX = 1536, DEPTH = 4, NCH = 33, NCHH = NB * NCH * 4;
constexpr float EPS = 1e-6f, ALPHA = 1.681792830507429f, QSCALE = 0.08838834764831845f;

constexpr size_t MiB = 1u << 20;
constexpr size_t WS_CTL = 0, CTL_ZERO_BYTES = 1 * MiB;
constexpr size_t WS_TAB = 1 * MiB;
constexpr size_t WS_GATEW = 3 * MiB;
constexpr size_t WS_WINT = 4 * MiB;
constexpr size_t WS_WOUTT = 14 * MiB;
constexpr size_t WS_GAB = 17 * MiB;
constexpr size_t WS_RGS = 18 * MiB;
constexpr size_t WS_EGL = 20 * MiB;
constexpr size_t WS_XB = 21 * MiB;
constexpr size_t WS_XF = 54 * MiB;
constexpr size_t WS_U = 119 * MiB;
constexpr size_t WS_MIX = 282 * MiB;
constexpr size_t WS_BETA = 331 * MiB;
constexpr size_t WS_GDN = 348 * MiB;
constexpr size_t WS_RET = 423 * MiB;
constexpr size_t WS_DBG = 465 * MiB;
constexpr size_t WS_END = 512 * MiB;
constexpr size_t T16 = 16384, T8 = 8192;
constexpr size_t G_W = WS_GDN, G_QG = G_W + NCHH * T16, G_KDT = G_QG + NCHH * T16, G_UT = G_KDT + NCHH * T16, G_ATT = G_UT + NCHH * T16;
constexpr size_t R_KRT = WS_RET, R_VT = R_KRT + NCHH * T16, R_SC = R_VT + NCHH * T16;
constexpr size_t S_QH = WS_MIX, S_KH = S_QH + NCHH * T16, S_RWT = WS_XB;
static_assert(G_ATT + NCHH * T8 <= WS_RET && R_SC + NCHH * T8 <= WS_DBG, "ws map");
static_assert(S_KH + NCHH * T16 <= WS_BETA && S_RWT + NCHH * T16 <= WS_XF, "ws alias map");
constexpr int CW_BAR = 4096;

constexpr int RING_BYTES = 131072;
constexpr int PRIV_BYTES = 18432;
constexpr int MISC_OFF = 147456;
constexpr int LDS_BYTES = 149504;

constexpr size_t O_YP = 0, O_YS = 16777216, O_HP = 16908288, O_CP = 16924672, O_RP = 16973824, O_GCP = 19070976, O_GP = 19218432,
                 O_HS = 21315584, O_CS = 21577728, O_RS = 22364160, O_GCS = 55918592, O_GS = 58277888, O_END = 91832320;

DI unsigned f2bf(float f) { unsigned u = __builtin_bit_cast(unsigned, f); return (u + 0x7fffu + ((u >> 16) & 1u)) >> 16; }
DI unsigned pk2(float lo, float hi) { return f2bf(lo) | (f2bf(hi) << 16); }
DI float bflo(unsigned w) { return __builtin_bit_cast(float, w << 16); }
DI float bfhi(unsigned w) { return __builtin_bit_cast(float, w & 0xffff0000u); }
DI float bf2f(bf16 h) { return __builtin_bit_cast(float, (unsigned)h << 16); }
DI void unpack8(const u32x4 w, float (&x)[8]) { x[0] = bflo(w.x); x[1] = bfhi(w.x); x[2] = bflo(w.y); x[3] = bfhi(w.y); x[4] = bflo(w.z); x[5] = bfhi(w.z); x[6] = bflo(w.w); x[7] = bfhi(w.w); }
DI u32x4 pack8(const float (&x)[8]) { u32x4 w; w.x = pk2(x[0], x[1]); w.y = pk2(x[2], x[3]); w.z = pk2(x[4], x[5]); w.w = pk2(x[6], x[7]); return w; }
DI u32x2 pack4(const f32x4 v) { u32x2 w; w.x = pk2(v[0], v[1]); w.y = pk2(v[2], v[3]); return w; }
DI f32x4 unpack4(const u32x2 w) { return (f32x4){bflo(w.x), bfhi(w.x), bflo(w.y), bfhi(w.y)}; }
DI float sigmoidf_(float x) { return 1.f / (1.f + __expf(-x)); }
DI float siluf_(float x) { return x / (1.f + __expf(-x)); }
DI float softplusf_(float x) { return x > 20.f ? x : log1pf(__expf(x)); }
DI float wave_sum(float v) {
#pragma unroll
    for (int o = 1; o < 64; o <<= 1) v += __shfl_xor(v, o);
    return v;
}
#define LDS_WAIT() asm volatile("s_waitcnt lgkmcnt(0)" ::: "memory")
#define VM_WAIT() asm volatile("s_waitcnt vmcnt(0)" ::: "memory")
DI f32x4 mfma16(bf16x8 a, bf16x8 b, f32x4 c) { return __builtin_amdgcn_mfma_f32_16x16x32_bf16(a, b, c, 0, 0, 0); }
}

namespace pg8 {
#define PG8_LAS __attribute__((address_space(3)))
typedef unsigned short bf16_t;
typedef short bf16x8 __attribute__((ext_vector_type(8)));
typedef float f32x4 __attribute__((ext_vector_type(4)));
typedef unsigned u32x4 __attribute__((ext_vector_type(4)));
constexpr int BM = 256, BK = 64, HALF = 128, HTB = HALF * BK * 2  , STAGE_BYTES = 8 * HTB, NXCD = 8, WGM = 8;

__host__ __device__ __forceinline__ int lds_byte(int r, int c) { const int st = (r >> 4) * 2 + (c >> 5), rr = r & 15, cc = c & 31, ob = rr * 64 + cc * 2; return st * 1024 + (ob ^ (((ob >> 9) & 1) << 5)); }
__host__ __device__ __forceinline__ void stage_rc(int b, int& R, int& C) { const int st = b / 1024, sb = b % 1024, swz = sb ^ (((sb >> 9) & 1) << 5); R = (st >> 1) * 16 + swz / 64; C = (st & 1) * 32 + (swz % 64) / 2; }
__host__ __device__ __forceinline__ int perm32(int rho) { const int n = rho >> 4, i = rho & 15; return 8 * (i >> 2) + 4 * n + (i & 3); }

struct Unit { int pm, pn; };
struct Gemm { const bf16_t* A; const bf16_t* Bt; int M, N, K; };

struct StaticOrder {
    int nM, nN, nwg, G, c;
    __host__ __device__ void init(int M, int N, int G_, int c_) { nM = M / BM; nN = N / BM; nwg = nM * nN; G = G_; c = c_; }
    __host__ __device__ bool next(int i, Unit& u) const {
        const long L = (long)i * G + c; if (L >= nwg) return false;
        int wgid = (int)L; { const int q = nwg / NXCD, r = nwg % NXCD, xcd = wgid % NXCD, off = wgid / NXCD; wgid = (xcd < r ? xcd * (q + 1) : r * (q + 1) + (xcd - r) * q) + off; }
        const int nig = WGM * nN, gid = wgid / nig, fm = gid * WGM, gsz = (nM - fm) < WGM ? (nM - fm) : WGM;
        u.pm = fm + ((wgid % nig) % gsz); u.pn = (wgid % nig) / gsz; return true;
    }
    __device__ __forceinline__ void a_ready(const Unit&) const {}
    __device__ __forceinline__ void done(const Unit&) const {}
};


__device__ __forceinline__ unsigned cvt_pk_bf16(float lo, float hi) { unsigned r; asm volatile("v_cvt_pk_bf16_f32 %0, %1, %2" : "=v"(r) : "v"(lo), "v"(hi)); return r; }
struct EpiU {
    static constexpr bool PERM = true, AFTER_DRAIN = false;
    bf16_t* O; int ldc;
    __device__ __forceinline__ void operator()(const f32x4 (&acc)[2][2][4][2], const Unit& u, int wr, int wc, int fr, int fq) const {
        const int row0 = u.pm * BM + wr * 64 + fr, col0 = u.pn * BM + wc * 32 + 8 * fq;
#pragma unroll
        for (int ai = 0; ai < 2; ++ai)
#pragma unroll
            for (int m = 0; m < 4; ++m) { bf16_t* rowp = O + (size_t)(row0 + ai * HALF + m * 16) * ldc + col0;
#pragma unroll
                for (int bj = 0; bj < 2; ++bj) { const f32x4 v0 = acc[ai][bj][m][0], v1 = acc[ai][bj][m][1];
                    u32x4 w; w.x = cvt_pk_bf16(v0[0], v0[1]); w.y = cvt_pk_bf16(v0[2], v0[3]); w.z = cvt_pk_bf16(v1[0], v1[1]); w.w = cvt_pk_bf16(v1[2], v1[3]);
                    *(u32x4*)(rowp + bj * HALF) = w; } }
    }
};
struct EpiRes {
    static constexpr bool PERM = false, AFTER_DRAIN = false;
    float* X; int ldc; float alpha;
    __device__ __forceinline__ void operator()(const f32x4 (&acc)[2][2][4][2], const Unit& u, int wr, int wc, int fr, int fq) const {
        const int col0 = u.pn * BM + wc * 32 + 4 * fq;
#pragma unroll
        for (int ai = 0; ai < 2; ++ai)
#pragma unroll
            for (int m = 0; m < 4; ++m) { const int r = u.pm * BM + ai * HALF + wr * 64 + m * 16 + fr; float* rowp = X + (size_t)r * ldc + col0;
#pragma unroll
                for (int bj = 0; bj < 2; ++bj)
#pragma unroll
                    for (int n = 0; n < 2; ++n) { f32x4* p = (f32x4*)(rowp + bj * HALF + n * 16); const f32x4 b = *p; *p = b * alpha + acc[ai][bj][m][n]; }
                asm volatile("" ::: "memory"); }
    }
};

template <class Epi, class Sched, bool ALIGN_EPI = false, bool SP2 = false>
__device__ __forceinline__ void gemm_phase(PG8_LAS unsigned char* lds, const Gemm g, const Sched& S, const Epi& E) {
    int tid_ = threadIdx.x; asm volatile("" : "+v"(tid_));
    const int tid = tid_, wid = __builtin_amdgcn_readfirstlane(tid >> 6), lane = tid & 63, wr = wid >> 2, wc = wid & 3, fr = lane & 15, fq = lane >> 4;
    const int K = g.K, nt = K / BK;
    unsigned voffA[2], voffB[2];
#pragma unroll
    for (int i = 0; i < 2; ++i) { int R, C; stage_rc(tid * 16 + i * 8192, R, C); const int Rb = Epi::PERM ? ((R & ~31) + perm32(R & 31)) : R;
        voffA[i] = (unsigned)(R * K + C) * 2u; voffB[i] = (unsigned)(Rb * K + C) * 2u; }
    const size_t kstep = (size_t)(BK * 2);
    const size_t hstep = (size_t)HALF * K * 2;
    const size_t tstep = 2 * hstep;
    const unsigned ldsw = (unsigned)wid * 1024u;
    const int aoff = lds_byte(wr * 64 + fr, fq * 8), boff = lds_byte(wc * 32 + fr, fq * 8);
#define PG8_SA(b, h) (((b) * 2 + (h)) * HTB)
#define PG8_SB(b, h) ((4 + (b) * 2 + (h)) * HTB)
#define PG8_STAGE(bufoff, gbase, voff) do { _Pragma("unroll") for (int _i = 0; _i < 2; ++_i) \
        __builtin_amdgcn_global_load_lds((const unsigned*)((const char*)(gbase) + (voff)[_i]), (PG8_LAS unsigned*)(lds + (bufoff) + ldsw + _i * 8192), 16, 0, 0); } while (0)
#define PG8_LDA(dst, b, h) do { _Pragma("unroll") for (int m = 0; m < 4; ++m) _Pragma("unroll") for (int k = 0; k < 2; ++k) dst[m][k] = *(const PG8_LAS bf16x8*)(lds + PG8_SA(b, h) + aoff + m * 2048 + k * 1024); } while (0)
#define PG8_LDB(dst, b, h) do { _Pragma("unroll") for (int n = 0; n < 2; ++n) _Pragma("unroll") for (int k = 0; k < 2; ++k) dst[n][k] = *(const PG8_LAS bf16x8*)(lds + PG8_SB(b, h) + boff + n * 2048 + k * 1024); } while (0)
#define PG8_MMA(ai, bj, At, Bt) do { __builtin_amdgcn_s_setprio(1); _Pragma("unroll") for (int m = 0; m < 4; ++m) _Pragma("unroll") for (int n = 0; n < 2; ++n) _Pragma("unroll") for (int k = 0; k < 2; ++k) \
        acc[ai][bj][m][n] = __builtin_amdgcn_mfma_f32_16x16x32_bf16(Bt[n][k], At[m][k], acc[ai][bj][m][n], 0, 0, 0); __builtin_amdgcn_s_setprio(0); } while (0)
#define PG8_WAIT_V(n) asm volatile("s_waitcnt vmcnt(" #n ")" ::: "memory")
#define PG8_WAIT_L(n) asm volatile("s_waitcnt lgkmcnt(" #n ")" ::: "memory")
#define PG8_BAR __builtin_amdgcn_s_barrier()
#define PG8_SCHED __builtin_amdgcn_sched_barrier(0)
    Unit cur, nxt; int ui = 0;
    if (!S.next(0, cur)) return;
    f32x4 acc[2][2][4][2];
#pragma unroll
    for (int a = 0; a < 2; ++a)
#pragma unroll
        for (int b = 0; b < 2; ++b)
#pragma unroll
            for (int m = 0; m < 4; ++m)
#pragma unroll
                for (int n = 0; n < 2; ++n) acc[a][b][m][n] = (f32x4){0.f, 0.f, 0.f, 0.f};
    bf16x8 At[4][2], B0[2][2], B1[2][2];
    const char* cA = (const char*)g.A + (size_t)cur.pm * tstep; const char* cB = (const char*)g.Bt + (size_t)cur.pn * tstep;
    S.a_ready(cur);
    if constexpr (SP2) {
        PG8_STAGE(PG8_SB(0, 0), cB, voffB); PG8_STAGE(PG8_SB(0, 1), cB + hstep, voffB); PG8_STAGE(PG8_SA(0, 0), cA, voffA); PG8_STAGE(PG8_SA(0, 1), cA + hstep, voffA);
        if (wr == 1) PG8_BAR;
        PG8_WAIT_V(2); PG8_BAR;
        PG8_STAGE(PG8_SB(1, 0), cB + kstep, voffB); PG8_STAGE(PG8_SA(1, 0), cA + kstep, voffA); PG8_STAGE(PG8_SB(1, 1), cB + hstep + kstep, voffB);
        PG8_WAIT_V(6); PG8_BAR;
    } else {
        PG8_STAGE(PG8_SB(0, 0), cB, voffB); PG8_STAGE(PG8_SA(0, 0), cA, voffA); PG8_STAGE(PG8_SB(0, 1), cB + hstep, voffB); PG8_STAGE(PG8_SA(0, 1), cA + hstep, voffA);
        if (wr == 1) PG8_BAR;
        PG8_WAIT_V(4); PG8_BAR;
        PG8_STAGE(PG8_SB(1, 0), cB + kstep, voffB); PG8_STAGE(PG8_SA(1, 0), cA + kstep, voffA); PG8_STAGE(PG8_SB(1, 1), cB + hstep + kstep, voffB);
        PG8_WAIT_V(6); PG8_BAR;
    }
    for (;;) {
        const bool has_next = S.next(ui + 1, nxt);
        const char* nA = has_next ? (const char*)g.A + (size_t)nxt.pm * tstep : cA; const char* nB = has_next ? (const char*)g.Bt + (size_t)nxt.pn * tstep : cB;
        for (int t = 0; t < nt; t += 2) {
            const bool last = (t == nt - 2);
            const char* a1 = cA + (size_t)(t + 1) * kstep;
            const char* a2 = last ? nA : cA + (size_t)(t + 2) * kstep; const char* b2 = last ? nB : cB + (size_t)(t + 2) * kstep;
            const char* a3 = a2 + kstep; const char* b3 = b2 + kstep;
            if (last && has_next) S.a_ready(nxt);
            if constexpr (SP2) {
            PG8_LDB(B0, 0, 0); PG8_LDB(B1, 0, 1); PG8_SCHED; PG8_LDA(At, 0, 0); PG8_STAGE(PG8_SA(1, 1), a1 + hstep, voffA);
            PG8_WAIT_V(8); PG8_WAIT_L(0); PG8_BAR; PG8_MMA(0, 0, At, B0); PG8_MMA(0, 1, At, B1); PG8_BAR; PG8_SCHED;
            PG8_LDA(At, 0, 1); PG8_STAGE(PG8_SB(0, 0), b2, voffB); PG8_STAGE(PG8_SB(0, 1), b2 + hstep, voffB); PG8_STAGE(PG8_SA(0, 0), a2, voffA);
            PG8_WAIT_V(8); PG8_WAIT_L(0); PG8_BAR; PG8_MMA(1, 0, At, B0); PG8_MMA(1, 1, At, B1); PG8_BAR; PG8_SCHED;
            PG8_LDB(B0, 1, 0); PG8_LDB(B1, 1, 1); PG8_SCHED; PG8_LDA(At, 1, 0); PG8_STAGE(PG8_SA(0, 1), a2 + hstep, voffA);
            PG8_WAIT_V(8); PG8_WAIT_L(0); PG8_BAR; PG8_MMA(0, 0, At, B0); PG8_MMA(0, 1, At, B1); PG8_BAR; PG8_SCHED;
            PG8_LDA(At, 1, 1); PG8_STAGE(PG8_SB(1, 0), b3, voffB); PG8_STAGE(PG8_SB(1, 1), b3 + hstep, voffB); PG8_STAGE(PG8_SA(1, 0), a3, voffA);
            PG8_WAIT_V(8); PG8_WAIT_L(0); PG8_BAR; PG8_MMA(1, 0, At, B0); PG8_MMA(1, 1, At, B1); PG8_BAR; PG8_SCHED;
            } else {
            PG8_LDB(B0, 0, 0); PG8_SCHED; PG8_LDA(At, 0, 0); PG8_STAGE(PG8_SA(1, 1), a1 + hstep, voffA);
            PG8_WAIT_L(8); PG8_BAR; PG8_WAIT_L(0); PG8_MMA(0, 0, At, B0); PG8_BAR; PG8_SCHED;
            PG8_LDB(B1, 0, 1); PG8_STAGE(PG8_SB(0, 0), b2, voffB);
            PG8_BAR; PG8_WAIT_L(0); PG8_MMA(0, 1, At, B1); PG8_BAR;
            PG8_LDA(At, 0, 1); PG8_STAGE(PG8_SA(0, 0), a2, voffA);
            PG8_BAR; PG8_WAIT_L(0); PG8_MMA(1, 0, At, B0); PG8_BAR; PG8_SCHED;
            PG8_STAGE(PG8_SB(0, 1), b2 + hstep, voffB);
            PG8_WAIT_V(6); PG8_BAR; PG8_MMA(1, 1, At, B1); PG8_BAR;
            PG8_LDB(B0, 1, 0); PG8_SCHED; PG8_LDA(At, 1, 0); PG8_STAGE(PG8_SA(0, 1), a2 + hstep, voffA);
            PG8_WAIT_L(8); PG8_BAR; PG8_WAIT_L(0); PG8_MMA(0, 0, At, B0); PG8_BAR; PG8_SCHED;
            PG8_LDB(B1, 1, 1); PG8_STAGE(PG8_SB(1, 0), b3, voffB);
            PG8_BAR; PG8_WAIT_L(0); PG8_MMA(0, 1, At, B1); PG8_BAR;
            PG8_LDA(At, 1, 1); PG8_STAGE(PG8_SA(1, 0), a3, voffA);
            PG8_BAR; PG8_WAIT_L(0); PG8_MMA(1, 0, At, B0); PG8_BAR; PG8_SCHED;
            PG8_STAGE(PG8_SB(1, 1), b3 + hstep, voffB);
            PG8_WAIT_V(6); PG8_BAR; PG8_MMA(1, 1, At, B1); PG8_BAR;
            }
        }
        if constexpr (ALIGN_EPI) { if (wr == 0) PG8_BAR; }
        if constexpr (!Epi::AFTER_DRAIN) { E(acc, cur, wr, wc, fr, fq); S.done(cur); }
        if (!has_next) break;
#pragma unroll
        for (int a = 0; a < 2; ++a)
#pragma unroll
            for (int b = 0; b < 2; ++b)
#pragma unroll
                for (int m = 0; m < 4; ++m)
#pragma unroll
                    for (int n = 0; n < 2; ++n) acc[a][b][m][n] = (f32x4){0.f, 0.f, 0.f, 0.f};
        cur = nxt; cA = nA; cB = nB; ++ui;
        if constexpr (ALIGN_EPI) { if (wr == 1) PG8_BAR; }
    }
    PG8_WAIT_V(0);
    if constexpr (!ALIGN_EPI) { if (wr == 0) PG8_BAR; }
    PG8_BAR;
    if constexpr (Epi::AFTER_DRAIN) { E.fused(acc, cur, wr, wc, fr, fq, lds, wid, lane); S.done(cur); }
#undef PG8_SA
#undef PG8_SB
#undef PG8_STAGE
#undef PG8_LDA
#undef PG8_LDB
#undef PG8_MMA
#undef PG8_WAIT_V
#undef PG8_WAIT_L
#undef PG8_BAR
#undef PG8_SCHED
}
}

namespace fx {
#define XB_TMO      128
#define XB_XCNT(j)  (256  + 64 * (j))
#define XB_XSUB(j)  (1280 + 64 * (j))
#define XB_XGEN(j)  (2304 + 64 * (j))
#define XB_TOP      3328
#define XB_TOPGEN   3392
#define XCD_BAR_WORDS 3456
#define XB_SPIN_CAP (1u << 18)

__device__ __forceinline__ unsigned xb_ld(unsigned* p)              { return __hip_atomic_load(p, __ATOMIC_RELAXED, __HIP_MEMORY_SCOPE_AGENT); }
__device__ __forceinline__ unsigned xb_add(unsigned* p, unsigned v) { return __hip_atomic_fetch_add(p, v, __ATOMIC_RELAXED, __HIP_MEMORY_SCOPE_AGENT); }
__device__ __forceinline__ unsigned xb_xcc_id() { return (unsigned)__builtin_amdgcn_s_getreg((3 << 11) | 20) & 0xFu; }
#define XB_SPIN(cond, bar) do { unsigned _sp = 0; while (cond) { __builtin_amdgcn_s_sleep(1); \
    if ((++_sp & 255u) == 0u) { if (xb_ld(&(bar)[XB_TMO])) break; if (_sp > XB_SPIN_CAP) { atomicAdd(&(bar)[XB_TMO], 1u); break; } } } } while (0)

struct XcdBarrier {
    unsigned* bar; unsigned x;
    volatile LAS unsigned* st;
};

__device__ __forceinline__ XcdBarrier xcd_barrier_post(unsigned* bar, volatile LAS unsigned* st) {
    XcdBarrier b; b.bar = bar; b.x = xb_xcc_id(); b.st = st;
    if (threadIdx.x == 0) (void)xb_add(&bar[XB_XCNT(b.x)], 1u);
    return b;
}
__device__ __forceinline__ void xcd_barrier_complete(unsigned* bar, unsigned x, unsigned& nloc, unsigned& nx) {
    const unsigned G = gridDim.x * gridDim.y * gridDim.z;
    unsigned sum, cnt, mine, sp = 0u;
    for (;;) {
        sum = 0u; cnt = 0u; mine = 0u;
#pragma unroll
        for (unsigned j = 0; j < 16; ++j) { const unsigned c = xb_ld(&bar[XB_XCNT(j)]); sum += c; cnt += (c > 0u) ? 1u : 0u; mine = (j == x) ? c : mine; }
        if (sum == G) break;
        __builtin_amdgcn_s_sleep(1);
        if ((++sp & 255u) == 0u) { if (xb_ld(&bar[XB_TMO])) break; if (sp > XB_SPIN_CAP) { atomicAdd(&bar[XB_TMO], 1u); break; } }
    }
    nloc = mine > 0u ? mine : 1u; nx = cnt > 0u ? cnt : 1u;
}

__device__ __forceinline__ void xcd_barrier(const XcdBarrier& b) {
    asm volatile("s_waitcnt vmcnt(0)" ::: "memory");
    __syncthreads();
    if (threadIdx.x == 0) {
        unsigned* bar = b.bar;
        __builtin_amdgcn_s_waitcnt(0);
        unsigned nloc = b.st[0], nx = b.st[1];
        if (nloc == 0u) { xcd_barrier_complete(bar, b.x, nloc, nx); b.st[0] = nloc; b.st[1] = nx; }
        const unsigned old = xb_add(&bar[XB_XSUB(b.x)], 1u);
        const unsigned gen = old / nloc;
        if (old + 1u == (gen + 1u) * nloc) {
            __builtin_amdgcn_fence(__ATOMIC_RELEASE, "agent");
            asm volatile("s_waitcnt vmcnt(0)" ::: "memory");
            const unsigned og = xb_add(&bar[XB_TOP], 1u);
            const unsigned tg = og / nx;
            if (og + 1u == (tg + 1u) * nx) xb_add(&bar[XB_TOPGEN], 1u);
            else XB_SPIN(xb_ld(&bar[XB_TOPGEN]) == tg, bar);
            __builtin_amdgcn_fence(__ATOMIC_ACQUIRE, "agent");
            xb_add(&bar[XB_XGEN(b.x)], 1u);
            asm volatile("s_waitcnt vmcnt(0)" ::: "memory");
        } else {
            XB_SPIN(xb_ld(&bar[XB_XGEN(b.x)]) == gen, bar);
            __builtin_amdgcn_fence(__ATOMIC_ACQUIRE, "agent");
            asm volatile("s_waitcnt vmcnt(0)" ::: "memory");
        }
    }
    __syncthreads();
}

struct Args { const float* in[25]; float* out; unsigned char* ws; int ph_lo, ph_hi; };
struct Ctx { LAS unsigned char* lds; int tid, lane, wave, G, bid; };

DI void transpose_item(const float* W, int ldw, int K, int N, bf16* WT, LAS float* scr, int item, int lane) {
    const int nblk = N / 32, kb = item / nblk, nb = item % nblk, k0 = 64 * kb, n0 = 32 * nb;
#pragma unroll 8
    for (int i = 0; i < 32; ++i) { const int kk = 2 * i + (lane >> 5); scr[kk * 33 + (lane & 31)] = W[(size_t)(k0 + kk) * ldw + n0 + (lane & 31)]; }
    LDS_WAIT();
    const int c = lane & 7;
#pragma unroll
    for (int j = 0; j < 4; ++j) { const int n = (lane >> 3) + 8 * j; const LAS float* s = scr + (8 * c) * 33 + n;
        u32x4 o; o.x = pk2(s[0 * 33], s[1 * 33]); o.y = pk2(s[2 * 33], s[3 * 33]); o.z = pk2(s[4 * 33], s[5 * 33]); o.w = pk2(s[6 * 33], s[7 * 33]);
        *(u32x4*)(WT + (size_t)(n0 + n) * K + k0 + 8 * c) = o; }
    LDS_WAIT();
}
DI void convert_weights(const Args& A, const Ctx& C, int l) {
    LAS float* scr = (LAS float*)(C.lds + C.wave * 16384);
    const int gw = C.bid * NWAVES + C.wave, NGW = C.G * NWAVES;
    constexpr int I_IN = (DM / 64) * (DIN / 32), I_OUT = (DMIX / 64) * (DM / 32), I_G = 2 * 8 * 2;
    bf16* WinT = (bf16*)(A.ws + WS_WINT); bf16* WoutT = (bf16*)(A.ws + WS_WOUTT); bf16* GW = (bf16*)(A.ws + WS_GATEW);
    for (int it = gw; it < I_IN + I_OUT + I_G; it += NGW) {
        int r = it;
        if (r < I_IN) { transpose_item(A.in[8] + (size_t)l * DM * DINX, DINX, DM, DIN, WinT, scr, r, C.lane); continue; } r -= I_IN;
        if (r < I_OUT) { transpose_item(A.in[22] + (size_t)l * DMIX * DM, DM, DMIX, DM, WoutT, scr, r, C.lane); continue; } r -= I_OUT;
        const int gate = r / 16, n = (r % 16) / 2, sub = r % 2;
        transpose_item(A.in[gate ? 13 : 11] + ((size_t)l * 8 + n) * 4096, 64, 64, 64, GW + (size_t)(gate * 8 + n) * 4096, scr, sub, C.lane);
    }
}
DI void build_rope_table(const Args& A, const Ctx& C) {
    f32x2* TAB = (f32x2*)(A.ws + WS_TAB);
    for (int e = C.bid * NTHR + C.tid; e < 2065 * 64; e += C.G * NTHR) {
        const int p = e >> 6, i = e & 63; const float pos = p < 2064 ? (float)p : 16384.f;
        const float inv = exp2f(-(float)i * (13.287712379549449f / 64.f));
        const float ang = pos * inv;
        const double rev = (double)ang * 0.15915494309189535; const double fr = rev - rint(rev);
        const float r = (float)(fr * 6.283185307179586);
        TAB[e] = (f32x2){__cosf(r), __sinf(r)};
    }
}
DI void row_pass(const Args& A, const Ctx& C, int lnext) {
    const int gw = C.bid * NWAVES + C.wave, NGW = C.G * NWAVES, lane = C.lane;
    float* XF = (float*)(A.ws + WS_XF); bf16* XB = (bf16*)(A.ws + WS_XB); float* GAB = (float*)(A.ws + WS_GAB);
    for (int m = gw; m < M; m += NGW) {
        f32x4 v[4];
        if (lnext == 0) {
            const float* src;
            if (m < MP) { const int b = m / TP, t = m % TP; src = t < 16 ? A.in[7] + (size_t)t * DM : A.in[0] + ((size_t)b * 2048 + (t - 16)) * DM; }
            else src = A.in[1] + (size_t)(m - MP) * DM;
#pragma unroll
            for (int j = 0; j < 4; ++j) v[j] = *(const f32x4*)(src + 4 * lane + 256 * j);
        } else {
            const float* src = XF + (size_t)m * DM; float s = 0.f;
#pragma unroll
            for (int j = 0; j < 4; ++j) { v[j] = *(const f32x4*)(src + 4 * lane + 256 * j); s += (v[j][0] + v[j][1]) + (v[j][2] + v[j][3]); }
            const float mean = wave_sum(s) * (1.f / DM); float q = 0.f;
#pragma unroll
            for (int j = 0; j < 4; ++j) { v[j] = v[j] - mean; q += (v[j][0] * v[j][0] + v[j][1] * v[j][1]) + (v[j][2] * v[j][2] + v[j][3] * v[j][3]); }
            const float rstd = rsqrtf(wave_sum(q) * (1.f / DM) + EPS);
            const float* lw = A.in[23] + (size_t)(lnext - 1) * DM; const float* lb = A.in[24] + (size_t)(lnext - 1) * DM;
#pragma unroll
            for (int j = 0; j < 4; ++j) { const f32x4 w = *(const f32x4*)(lw + 4 * lane + 256 * j), b = *(const f32x4*)(lb + 4 * lane + 256 * j); v[j] = v[j] * rstd * w + b; }
        }
        if (lnext < DEPTH) {
#pragma unroll
            for (int j = 0; j < 4; ++j) { *(f32x4*)(XF + (size_t)m * DM + 4 * lane + 256 * j) = v[j]; *(u32x2*)(XB + (size_t)m * DM + 4 * lane + 256 * j) = pack4(v[j]); }
            const float* wg = A.in[8] + (size_t)lnext * DM * DINX + DIN;
            float acc[8];
#pragma unroll
            for (int q = 0; q < 8; ++q) acc[q] = 0.f;
#pragma unroll
            for (int j = 0; j < 4; ++j)
#pragma unroll
                for (int e = 0; e < 4; ++e) { const int k = 4 * lane + 256 * j + e; const f32x4 w0 = *(const f32x4*)(wg + (size_t)k * DINX), w1 = *(const f32x4*)(wg + (size_t)k * DINX + 4);
                    const float x = v[j][e];
                    acc[0] = fmaf(x, w0[0], acc[0]); acc[1] = fmaf(x, w0[1], acc[1]); acc[2] = fmaf(x, w0[2], acc[2]); acc[3] = fmaf(x, w0[3], acc[3]);
                    acc[4] = fmaf(x, w1[0], acc[4]); acc[5] = fmaf(x, w1[1], acc[5]); acc[6] = fmaf(x, w1[2], acc[6]); acc[7] = fmaf(x, w1[3], acc[7]); }
#pragma unroll
            for (int q = 0; q < 8; ++q) acc[q] = wave_sum(acc[q]);
            if (lane == 0) { *(f32x4*)(GAB + (size_t)m * 8) = (f32x4){acc[0], acc[1], acc[2], acc[3]}; *(f32x4*)(GAB + (size_t)m * 8 + 4) = (f32x4){acc[4], acc[5], acc[6], acc[7]}; }
        } else {
            float* dst;
            if (m < MP) { const int b = m / TP, t = m % TP; if (t < 16) continue; dst = A.out + O_YP + ((size_t)b * 2048 + (t - 16)) * DM; }
            else dst = A.out + O_YS + (size_t)(m - MP) * DM;
#pragma unroll
            for (int j = 0; j < 4; ++j) *(f32x4*)(dst + 4 * lane + 256 * j) = v[j];
        }
    }
}

DI void transpose_out(const LAS bf16* T, bf16* outT, int lane) {
#pragma unroll 1
    for (int p = 0; p < 2; ++p) { const int d = lane + 64 * p;
#pragma unroll 2
        for (int i8 = 0; i8 < 8; ++i8) { u32x4 w;
            w.x = (unsigned)T[(i8 * 8 + 0) * 128 + d] | ((unsigned)T[(i8 * 8 + 1) * 128 + d] << 16);
            w.y = (unsigned)T[(i8 * 8 + 2) * 128 + d] | ((unsigned)T[(i8 * 8 + 3) * 128 + d] << 16);
            w.z = (unsigned)T[(i8 * 8 + 4) * 128 + d] | ((unsigned)T[(i8 * 8 + 5) * 128 + d] << 16);
            w.w = (unsigned)T[(i8 * 8 + 6) * 128 + d] | ((unsigned)T[(i8 * 8 + 7) * 128 + d] << 16);
            *(u32x4*)(outT + d * 64 + i8 * 8) = w; } }
}

DI void p2_gdn_item(const Args& A, const Ctx& C, LAS unsigned char* pl, int l, int item) {
    const int lane = C.lane, fr = lane & 15, fq = lane >> 4;
    const int CH = item, h = item & 3, bc = item >> 2, c = bc % NCH, b = bc / NCH;
    const int t0 = 64 * c - 48; const size_t mrow0 = (size_t)b * TP;
    bf16* U = (bf16*)(A.ws + WS_U); const float* GAB = (const float*)(A.ws + WS_GAB);
    LAS float* Amat = (LAS float*)pl; LAS bf16* T = (LAS bf16*)pl; LAS float* scb = (LAS float*)(pl + 17408);
    bf16* QH = (bf16*)(A.ws + S_QH) + (size_t)CH * 8192; bf16* KH = (bf16*)(A.ws + S_KH) + (size_t)CH * 8192; bf16* RWT = (bf16*)(A.ws + S_RWT) + (size_t)CH * 8192;
    bf16* Wg = (bf16*)(A.ws + G_W) + (size_t)CH * 8192; bf16* QG = (bf16*)(A.ws + G_QG) + (size_t)CH * 8192; bf16* KDT = (bf16*)(A.ws + G_KDT) + (size_t)CH * 8192;
    bf16* UT = (bf16*)(A.ws + G_UT) + (size_t)CH * 8192; bf16* ATT = (bf16*)(A.ws + G_ATT) + (size_t)CH * 4096; float* EGL = (float*)(A.ws + WS_EGL);
    {
        const int t = t0 + lane; float g = 0.f, beta = 0.f;
        if (t >= 0) { const float* gp = GAB + (mrow0 + t) * 8; g = -__expf(A.in[19][l * 4 + h]) * softplusf_(gp[h] + A.in[20][l * 4 + h]); beta = sigmoidf_(gp[4 + h]); }
        float gc = g;
#pragma unroll
        for (int off = 1; off < 64; off <<= 1) { const float nb = __shfl_up(gc, off); if (lane >= off) gc += nb; }
        scb[lane] = beta; scb[64 + lane] = gc;
        const float gl = __shfl(gc, 63);
        if (lane == 0) EGL[CH] = __expf(gl);
    }
    LDS_WAIT();
    const float g_last = scb[64 + 63];
    const int tok4 = lane >> 4, grp = lane & 15;
#pragma unroll 1
    for (int part = 0; part < 3; ++part) {
        const int chb = part * 512 + h * 128 + grp * 8;
        const float* cw = A.in[18] + (size_t)l * 4 * 1536 + chb;
        float wgt[4][8];
#pragma unroll
        for (int j = 0; j < 4; ++j) { const f32x4 a = *(const f32x4*)(cw + j * 1536), bq = *(const f32x4*)(cw + j * 1536 + 4);
            wgt[j][0] = a[0]; wgt[j][1] = a[1]; wgt[j][2] = a[2]; wgt[j][3] = a[3]; wgt[j][4] = bq[0]; wgt[j][5] = bq[1]; wgt[j][6] = bq[2]; wgt[j][7] = bq[3]; }
#pragma unroll 1
        for (int it = 0; it < 16; ++it) {
            const int i = it * 4 + tok4, t = t0 + i;
            float y[8], x3[8];
#pragma unroll
            for (int e = 0; e < 8; ++e) { y[e] = 0.f; x3[e] = 0.f; }
#pragma unroll
            for (int j = 0; j < 4; ++j) { const int tt = t - 3 + j;
                if (tt >= 0) { const u32x4 raw = *(const u32x4*)(U + (mrow0 + tt) * DIN + 3072 + chb); float x[8]; unpack8(raw, x);
#pragma unroll
                    for (int e = 0; e < 8; ++e) { y[e] = fmaf(wgt[j][e], x[e], y[e]); if (j == 3) x3[e] = x[e]; } } }
            if (c == NCH - 1 && i >= 61) { float* o = A.out + O_GCP + ((size_t)(l * NB + b) * 3 + (i - 61)) * 1536 + chb;
                *(f32x4*)o = (f32x4){x3[0], x3[1], x3[2], x3[3]}; *(f32x4*)(o + 4) = (f32x4){x3[4], x3[5], x3[6], x3[7]}; }
#pragma unroll
            for (int e = 0; e < 8; ++e) y[e] = siluf_(y[e]);
            const float beta_i = scb[i], gc_i = scb[64 + i];
            if (part < 2) {
                float ss = 0.f;
#pragma unroll
                for (int e = 0; e < 8; ++e) ss = fmaf(y[e], y[e], ss);
                ss += __shfl_xor(ss, 1); ss += __shfl_xor(ss, 2); ss += __shfl_xor(ss, 4); ss += __shfl_xor(ss, 8);
                const float rn = rsqrtf(ss + EPS) * (part == 0 ? QSCALE : 1.f);
#pragma unroll
                for (int e = 0; e < 8; ++e) y[e] *= rn;
            }
            if (part == 0) {
                *(u32x4*)(QH + i * 128 + grp * 8) = pack8(y);
                const float eg = __expf(gc_i);
#pragma unroll
                for (int e = 0; e < 8; ++e) y[e] *= eg;
                *(u32x4*)(QG + i * 128 + grp * 8) = pack8(y);
            } else if (part == 1) {
                *(u32x4*)(KH + i * 128 + grp * 8) = pack8(y);
                const float s = beta_i * __expf(gc_i);
#pragma unroll
                for (int e = 0; e < 8; ++e) y[e] *= s;
                *(LAS u32x4*)(T + i * 128 + grp * 8) = pack8(y);
            } else {
#pragma unroll
                for (int e = 0; e < 8; ++e) y[e] *= beta_i;
                *(LAS u32x4*)(T + i * 128 + grp * 8) = pack8(y);
            }
        }
        if (part == 1) {
            LDS_WAIT(); transpose_out(T, RWT, lane); LDS_WAIT();
            VM_WAIT();
#pragma unroll 1
            for (int it = 0; it < 16; ++it) { const int i = it * 4 + tok4;
                const u32x4 raw = *(const u32x4*)(KH + i * 128 + grp * 8); float y[8]; unpack8(raw, y);
                const float s = __expf(g_last - scb[64 + i]);
#pragma unroll
                for (int e = 0; e < 8; ++e) y[e] *= s;
                *(LAS u32x4*)(T + i * 128 + grp * 8) = pack8(y); }
            LDS_WAIT(); transpose_out(T, KDT, lane); LDS_WAIT();
        }
        if (part == 2) { LDS_WAIT(); transpose_out(T, UT, lane); LDS_WAIT(); }
    }
    VM_WAIT();
    bf16x8 kf[4][4];
#pragma unroll
    for (int rb = 0; rb < 4; ++rb)
#pragma unroll
        for (int kc = 0; kc < 4; ++kc) kf[rb][kc] = *(const bf16x8*)(KH + (rb * 16 + fr) * 128 + kc * 32 + 8 * fq);
#pragma unroll
    for (int jb = 0; jb < 4; ++jb) { const float gcj = scb[64 + jb * 16 + fr];
#pragma unroll
        for (int ib = jb; ib < 4; ++ib) { f32x4 acc = (f32x4){0.f, 0.f, 0.f, 0.f};
#pragma unroll
            for (int kc = 0; kc < 4; ++kc) acc = mfma16(kf[ib][kc], kf[jb][kc], acc);
#pragma unroll
            for (int r = 0; r < 4; ++r) { const int i = ib * 16 + 4 * fq + r; Amat[i * 68 + jb * 16 + fr] = acc[r] * scb[i] * __expf(fminf(scb[64 + i] - gcj, 0.f)); } } }
#pragma unroll 1
    for (int ib = 0; ib < 4; ++ib) { bf16x8 qf[4];
#pragma unroll
        for (int kc = 0; kc < 4; ++kc) qf[kc] = *(const bf16x8*)(QH + (ib * 16 + fr) * 128 + kc * 32 + 8 * fq);
        const int i = ib * 16 + fr; const float gci = scb[64 + i];
#pragma unroll
        for (int jb = 0; jb < 4; ++jb) { f32x4 val = (f32x4){0.f, 0.f, 0.f, 0.f};
            if (jb <= ib) { f32x4 acc = (f32x4){0.f, 0.f, 0.f, 0.f};
#pragma unroll
                for (int kc = 0; kc < 4; ++kc) acc = mfma16(kf[jb][kc], qf[kc], acc);
#pragma unroll
                for (int r = 0; r < 4; ++r) { const int j = jb * 16 + 4 * fq + r; val[r] = (i >= j) ? acc[r] * __expf(fminf(gci - scb[64 + j], 0.f)) : 0.f; } }
            *(u32x2*)(ATT + i * 64 + jb * 16 + 4 * fq) = pack4(val); } }
    LDS_WAIT();
    float mcol[64];
#pragma unroll
    for (int i = 0; i < 64; ++i) { float acc = (lane == i) ? 1.f : 0.f;
#pragma unroll
        for (int j = 0; j < i; ++j) acc = fmaf(-Amat[i * 68 + j], mcol[j], acc);
        mcol[i] = acc; }
    LDS_WAIT(); asm volatile("" ::: "memory");
    LAS bf16* Mb = (LAS bf16*)pl;
#pragma unroll
    for (int i = 0; i < 64; ++i) Mb[i * 136 + lane] = (bf16)f2bf(mcol[i]);
    LDS_WAIT(); asm volatile("" ::: "memory");
    bf16x8 mf[4][2];
#pragma unroll
    for (int ib = 0; ib < 4; ++ib)
#pragma unroll
        for (int k2 = 0; k2 < 2; ++k2) mf[ib][k2] = *(const LAS bf16x8*)(Mb + (ib * 16 + fr) * 136 + k2 * 32 + 8 * fq);
#pragma unroll 2
    for (int db = 0; db < 8; ++db) { bf16x8 rf[2];
#pragma unroll
        for (int k2 = 0; k2 < 2; ++k2) rf[k2] = *(const bf16x8*)(UT + (db * 16 + fr) * 64 + k2 * 32 + 8 * fq);
        f32x4 acc[4];
#pragma unroll
        for (int ib = 0; ib < 4; ++ib) { acc[ib] = (f32x4){0.f, 0.f, 0.f, 0.f};
#pragma unroll
            for (int k2 = 0; k2 < 2; ++k2) acc[ib] = mfma16(mf[ib][k2], rf[k2], acc[ib]); }
#pragma unroll
        for (int ib = 0; ib < 4; ++ib) *(u32x2*)(UT + (db * 16 + fr) * 64 + ib * 16 + 4 * fq) = pack4(acc[ib]); }
#pragma unroll 2
    for (int kb = 0; kb < 8; ++kb) { bf16x8 rf[2];
#pragma unroll
        for (int k2 = 0; k2 < 2; ++k2) rf[k2] = *(const bf16x8*)(RWT + (kb * 16 + fr) * 64 + k2 * 32 + 8 * fq);
#pragma unroll
        for (int ib = 0; ib < 4; ++ib) { f32x4 acc = (f32x4){0.f, 0.f, 0.f, 0.f};
#pragma unroll
            for (int k2 = 0; k2 < 2; ++k2) acc = mfma16(rf[k2], mf[ib][k2], acc);
            *(u32x2*)(Wg + (ib * 16 + fr) * 128 + kb * 16 + 4 * fq) = pack4(acc); } }
    LDS_WAIT();
}

DI void p2_ret_item(const Args& A, const Ctx& C, LAS unsigned char* pl, int l, int item) {
    const int lane = C.lane, fr = lane & 15, fq = lane >> 4;
    const int CH = item, h = item & 3, bc = item >> 2, c = bc % NCH, b = bc / NCH;
    const int t0 = 64 * c - 48; const size_t mrow0 = (size_t)b * TP;
    bf16* U = (bf16*)(A.ws + WS_U); LAS bf16* T = (LAS bf16*)pl; const f32x2* TAB = (const f32x2*)(A.ws + WS_TAB);
    bf16* KRT = (bf16*)(A.ws + R_KRT) + (size_t)CH * 8192; bf16* VT = (bf16*)(A.ws + R_VT) + (size_t)CH * 8192; bf16* SC = (bf16*)(A.ws + R_SC) + (size_t)CH * 4096;
    const float lg2 = log2f(1.f - exp2f(-5.f - (float)h));
    const int tok8 = lane >> 3, d0 = 8 * (lane & 7);
#pragma unroll 1
    for (int part = 0; part < 2; ++part) {
        const int colb = (part ? 1536 : 1024) + h * 128;
#pragma unroll 1
        for (int it = 0; it < 8; ++it) { const int i = it * 8 + tok8, t = t0 + i;
            float r1[8], r2[8];
#pragma unroll
            for (int e = 0; e < 8; ++e) { r1[e] = 0.f; r2[e] = 0.f; }
            if (t >= 0) { bf16* p = U + (mrow0 + t) * DIN + colb + d0;
                float lo[8], hi[8]; unpack8(*(const u32x4*)p, lo); unpack8(*(const u32x4*)(p + 64), hi);
                const f32x4* cs = (const f32x4*)(TAB + (size_t)t * 64 + d0);
                const float sc = part ? QSCALE * exp2f((float)(63 - i) * lg2) : exp2f((float)(i + 1) * lg2);
#pragma unroll
                for (int e2 = 0; e2 < 4; ++e2) { const f32x4 v = cs[e2];
                    r1[2 * e2] = (lo[2 * e2] * v[0] - hi[2 * e2] * v[1]) * sc; r2[2 * e2] = (lo[2 * e2] * v[1] + hi[2 * e2] * v[0]) * sc;
                    r1[2 * e2 + 1] = (lo[2 * e2 + 1] * v[2] - hi[2 * e2 + 1] * v[3]) * sc; r2[2 * e2 + 1] = (lo[2 * e2 + 1] * v[3] + hi[2 * e2 + 1] * v[2]) * sc; }
                *(u32x4*)p = pack8(r1); *(u32x4*)(p + 64) = pack8(r2); }
            if (part) { *(LAS u32x4*)(T + i * 128 + d0) = pack8(r1); *(LAS u32x4*)(T + i * 128 + 64 + d0) = pack8(r2); } }
        if (part) { LDS_WAIT(); transpose_out(T, KRT, lane); LDS_WAIT(); }
    }
    { const int tok4 = lane >> 4, grp = lane & 15;
#pragma unroll 1
        for (int it = 0; it < 16; ++it) { const int i = it * 4 + tok4, t = t0 + i;
            u32x4 raw = (u32x4){0u, 0u, 0u, 0u};
            if (t >= 0) raw = *(const u32x4*)(U + (mrow0 + t) * DIN + 2048 + h * 128 + grp * 8);
            *(LAS u32x4*)(T + i * 128 + grp * 8) = raw; }
        LDS_WAIT(); transpose_out(T, VT, lane); LDS_WAIT(); }
    VM_WAIT();
    const bf16x8 zf = (bf16x8){0, 0, 0, 0, 0, 0, 0, 0};
    bf16x8 kf[4][4];
#pragma unroll
    for (int rb = 0; rb < 4; ++rb) { const int t = t0 + rb * 16 + fr;
#pragma unroll
        for (int kc = 0; kc < 4; ++kc) kf[rb][kc] = t >= 0 ? *(const bf16x8*)(U + (mrow0 + t) * DIN + 1536 + h * 128 + kc * 32 + 8 * fq) : zf; }
    const float ginv = exp2f(-64.f * lg2);
#pragma unroll 1
    for (int ib = 0; ib < 4; ++ib) { bf16x8 qf[4]; const int i = ib * 16 + fr, t = t0 + i;
#pragma unroll
        for (int kc = 0; kc < 4; ++kc) qf[kc] = t >= 0 ? *(const bf16x8*)(U + (mrow0 + t) * DIN + 1024 + h * 128 + kc * 32 + 8 * fq) : zf;
#pragma unroll
        for (int jb = 0; jb < 4; ++jb) { f32x4 val = (f32x4){0.f, 0.f, 0.f, 0.f};
            if (jb <= ib) { f32x4 acc = (f32x4){0.f, 0.f, 0.f, 0.f};
#pragma unroll
                for (int kc = 0; kc < 4; ++kc) acc = mfma16(kf[jb][kc], qf[kc], acc);
#pragma unroll
                for (int r = 0; r < 4; ++r) { const int j = jb * 16 + 4 * fq + r; val[r] = (i >= j) ? acc[r] * ginv : 0.f; } }
            *(u32x2*)(SC + i * 64 + jb * 16 + 4 * fq) = pack4(val); } }
    LDS_WAIT();
}

template <bool DEC>
DI void p2_rg_item(const Args& A, const Ctx& C, LAS unsigned char* pl, int l, int bt, int c, int n) {
    const int lane = C.lane, fr = lane & 15, fq = lane >> 4;
    bf16* U = (bf16*)(A.ws + WS_U); LAS float* XR = (LAS float*)pl;
    const int t0 = DEC ? 0 : 64 * c - 48; const size_t mrow0 = DEC ? (size_t)MP + 64 * bt : (size_t)bt * TP;
    bf16x8 xf[4][2];
#pragma unroll
    for (int kc = 0; kc < 2; ++kc) { const int ch8 = n * 64 + kc * 32 + 8 * fq;
        float cw[4][8], cb[8];
#pragma unroll
        for (int j = 0; j < 4; ++j) { const float* p = A.in[9] + ((size_t)l * 4 + j) * 512 + ch8; const f32x4 a = *(const f32x4*)p, bq = *(const f32x4*)(p + 4);
            cw[j][0] = a[0]; cw[j][1] = a[1]; cw[j][2] = a[2]; cw[j][3] = a[3]; cw[j][4] = bq[0]; cw[j][5] = bq[1]; cw[j][6] = bq[2]; cw[j][7] = bq[3]; }
        { const float* p = A.in[10] + (size_t)l * 512 + ch8; const f32x4 a = *(const f32x4*)p, bq = *(const f32x4*)(p + 4);
            cb[0] = a[0]; cb[1] = a[1]; cb[2] = a[2]; cb[3] = a[3]; cb[4] = bq[0]; cb[5] = bq[1]; cb[6] = bq[2]; cb[7] = bq[3]; }
#pragma unroll
        for (int tb = 0; tb < 4; ++tb) { const int i = tb * 16 + fr;
            float xr[8];
#pragma unroll
            for (int e = 0; e < 8; ++e) xr[e] = cb[e];
            if (!DEC) { const int t = t0 + i; float x3[8];
#pragma unroll
                for (int e = 0; e < 8; ++e) x3[e] = 0.f;
#pragma unroll
                for (int j = 0; j < 4; ++j) { const int tt = t - 3 + j;
                    if (tt >= 0) { float x[8]; unpack8(*(const u32x4*)(U + (mrow0 + tt) * DIN + ch8), x);
#pragma unroll
                        for (int e = 0; e < 8; ++e) { xr[e] = fmaf(cw[j][e], x[e], xr[e]); if (j == 3) x3[e] = x[e]; } } }
                if (c == NCH - 1 && i >= 61) { float* o = A.out + O_CP + ((size_t)(l * NB + bt) * 3 + (i - 61)) * 512 + ch8;
                    *(f32x4*)o = (f32x4){x3[0], x3[1], x3[2], x3[3]}; *(f32x4*)(o + 4) = (f32x4){x3[4], x3[5], x3[6], x3[7]}; }
            } else { const int s = 64 * bt + i; const float* cv = A.in[3] + ((size_t)(l * NS + s) * 3) * 512 + ch8; float* oc = A.out + O_CS + ((size_t)(l * NS + s) * 3) * 512 + ch8;
                float x[8];
#pragma unroll
                for (int j = 0; j < 3; ++j) { const f32x4 a = *(const f32x4*)(cv + j * 512), bq = *(const f32x4*)(cv + j * 512 + 4);
                    x[0] = a[0]; x[1] = a[1]; x[2] = a[2]; x[3] = a[3]; x[4] = bq[0]; x[5] = bq[1]; x[6] = bq[2]; x[7] = bq[3];
#pragma unroll
                    for (int e = 0; e < 8; ++e) xr[e] = fmaf(cw[j][e], x[e], xr[e]);
                    if (j >= 1) { *(f32x4*)(oc + (j - 1) * 512) = a; *(f32x4*)(oc + (j - 1) * 512 + 4) = bq; } }
                unpack8(*(const u32x4*)(U + (mrow0 + i) * DIN + ch8), x);
#pragma unroll
                for (int e = 0; e < 8; ++e) xr[e] = fmaf(cw[3][e], x[e], xr[e]);
                *(f32x4*)(oc + 2 * 512) = (f32x4){x[0], x[1], x[2], x[3]}; *(f32x4*)(oc + 2 * 512 + 4) = (f32x4){x[4], x[5], x[6], x[7]};
            }
            *(LAS f32x4*)(XR + i * 68 + kc * 32 + 8 * fq) = (f32x4){xr[0], xr[1], xr[2], xr[3]};
            *(LAS f32x4*)(XR + i * 68 + kc * 32 + 8 * fq + 4) = (f32x4){xr[4], xr[5], xr[6], xr[7]};
            xf[tb][kc] = __builtin_bit_cast(bf16x8, pack8(xr)); } }
    LDS_WAIT();
    const bf16* GW = (const bf16*)(A.ws + WS_GATEW);
    bf16* MIX = (bf16*)(A.ws + WS_MIX); bf16* BETA = (bf16*)(A.ws + WS_BETA);
#pragma unroll 1
    for (int db = 0; db < 4; ++db) {
        bf16x8 waf[2], wxf[2];
#pragma unroll
        for (int kc = 0; kc < 2; ++kc) { waf[kc] = *(const bf16x8*)(GW + (size_t)(0 * 8 + n) * 4096 + (db * 16 + fr) * 64 + kc * 32 + 8 * fq);
                                         wxf[kc] = *(const bf16x8*)(GW + (size_t)(1 * 8 + n) * 4096 + (db * 16 + fr) * 64 + kc * 32 + 8 * fq); }
        const int chl = db * 16 + 4 * fq, ch0 = n * 64 + chl;
        const f32x4 ba4 = *(const f32x4*)(A.in[12] + (size_t)l * 512 + ch0), bx4 = *(const f32x4*)(A.in[14] + (size_t)l * 512 + ch0), lam4 = *(const f32x4*)(A.in[15] + (size_t)l * 512 + ch0);
        f32x4 sp4;
#pragma unroll
        for (int r = 0; r < 4; ++r) sp4[r] = softplusf_(-lam4[r]);
        float Ac[4], Hc[4];
#pragma unroll
        for (int r = 0; r < 4; ++r) { Ac[r] = 1.f; Hc[r] = 0.f; }
#pragma unroll
        for (int tb = 0; tb < 4; ++tb) { const int i = tb * 16 + fr; const int t = t0 + i; const bool valid = DEC || t >= 0; const size_t row = mrow0 + (DEC ? i : (t >= 0 ? t : 0));
            f32x4 aa = (f32x4){0.f, 0.f, 0.f, 0.f}, ax = aa;
#pragma unroll
            for (int kc = 0; kc < 2; ++kc) { aa = mfma16(waf[kc], xf[tb][kc], aa); ax = mfma16(wxf[kc], xf[tb][kc], ax); }
            const f32x4 xr4 = *(const LAS f32x4*)(XR + i * 68 + chl);
            const f32x4 z4 = unpack4(*(const u32x2*)(U + row * DIN + 512 + ch0));
            f32x4 av, uv, sz;
#pragma unroll
            for (int r = 0; r < 4; ++r) { const float rg = sigmoidf_(aa[r] + ba4[r]), ig = sigmoidf_(ax[r] + bx4[r]);
                const float la = -8.f * rg * sp4[r];
                av[r] = __expf(la); uv[r] = sqrtf(fmaxf(-expm1f(2.f * la), 0.f)) * ig * xr4[r]; sz[r] = siluf_(z4[r]); }
            if (DEC) { const int s = 64 * bt + i;
                const f32x4 h0 = *(const f32x4*)(A.in[2] + (size_t)(l * NS + s) * 512 + ch0);
                const f32x4 hv = av * h0 + uv;
                *(f32x4*)(A.out + O_HS + (size_t)(l * NS + s) * 512 + ch0) = hv;
                *(u32x2*)(MIX + row * DMIX + ch0) = pack4(hv * sz);
            } else {
                f32x4 al, be;
#pragma unroll
                for (int r = 0; r < 4; ++r) { float a = valid ? av[r] : 1.f, u = valid ? uv[r] : 0.f;
#pragma unroll
                    for (int off = 1; off < 16; off <<= 1) { const float pa = __shfl_up(a, off, 16), pu = __shfl_up(u, off, 16); if (fr >= off) { u = fmaf(a, pu, u); a = pa * a; } }
                    const float P = Ac[r] * a, hl = fmaf(a, Hc[r], u);
                    al[r] = hl * sz[r]; be[r] = P * sz[r];
                    Ac[r] = __shfl(P, 15, 16); Hc[r] = __shfl(hl, 15, 16); }
                if (valid) { *(u32x2*)(U + row * DIN + 512 + ch0) = pack4(al); *(u32x2*)(BETA + ((size_t)bt * TP + t) * 512 + ch0) = pack4(be); }
            } }
        if (!DEC && fr == 15) { f32x2* RGS = (f32x2*)(A.ws + WS_RGS) + ((size_t)bt * NCH + c) * 512 + n * 64 + chl;
#pragma unroll
            for (int r = 0; r < 4; ++r) RGS[r] = (f32x2){Ac[r], Hc[r]}; }
    }
    LDS_WAIT();
}

DI void phase_p2(const Args& A, const Ctx& C, int l) {
    LAS unsigned char* pl = C.lds + C.wave * PRIV_BYTES;
    const int slot = C.wave * C.G + C.bid, NSLOT = C.G * NWAVES;
    if (NSLOT <= NCHH) return;
    if (slot < NCHH) { p2_gdn_item(A, C, pl, l, slot); return; }
    const int NL = NSLOT - NCHH, NRG = NB * NCH * 8;
    for (int it = slot - NCHH; it < NRG + NCHH + 16; it += NL) {
        if (it < NRG) { const int n = it & 7, bc = it >> 3; p2_rg_item<false>(A, C, pl, l, bc / NCH, bc % NCH, n); }
        else if (it < NRG + NCHH) p2_ret_item(A, C, pl, l, it - NRG);
        else { const int r = it - NRG - NCHH; p2_rg_item<true>(A, C, pl, l, r >> 3, 0, r & 7); }
    }
}

constexpr int CL_A = 0;
constexpr int CL_B = 17408;
constexpr int CL_KT = 34816;
constexpr int CL_AT = 53248;
constexpr int CL_PRIV = 62464;
constexpr int CL_PRIV_BYTES = 6656;
static_assert(CL_PRIV + 8 * CL_PRIV_BYTES <= MISC_OFF, "chain LDS map");

DI void p3_gdn_chain(const Args& A, const Ctx& C, int l, int b, int h) {
    const int tid = C.tid, lane = C.lane, fr = lane & 15, fq = lane >> 4, vb = C.wave;
    LAS unsigned char* L = C.lds;
    LAS bf16* Wb = (LAS bf16*)(L + CL_A); LAS bf16* QGb = (LAS bf16*)(L + CL_B); LAS bf16* KTb = (LAS bf16*)(L + CL_KT); LAS bf16* ATb = (LAS bf16*)(L + CL_AT);
    LAS bf16* ST = (LAS bf16*)(L + CL_PRIV + vb * CL_PRIV_BYTES); LAS bf16* VNT = ST + 16 * 136;
    bf16* U = (bf16*)(A.ws + WS_U); const size_t mrow0 = (size_t)b * TP;
    const bf16* gW = (const bf16*)(A.ws + G_W); const bf16* gQG = (const bf16*)(A.ws + G_QG); const bf16* gKDT = (const bf16*)(A.ws + G_KDT);
    const bf16* gUT = (const bf16*)(A.ws + G_UT); const bf16* gATT = (const bf16*)(A.ws + G_ATT); const float* EGL = (const float*)(A.ws + WS_EGL);
    for (int e = lane; e < 16 * 136 / 2; e += 64) ((LAS unsigned*)ST)[e] = 0u;
    f32x4 Sacc[8];
#pragma unroll
    for (int kb = 0; kb < 8; ++kb) Sacc[kb] = (f32x4){0.f, 0.f, 0.f, 0.f};
    u32x4 R[7]; u32x2 ur[4]; float eglr;
    const int r16 = tid >> 4, c16 = tid & 15, r8 = tid >> 3, c8 = tid & 7;
#define GDN_PREFETCH(CH_) do { const size_t ch_ = (size_t)(CH_); \
        R[0] = *(const u32x4*)(gW + ch_ * 8192 + (size_t)tid * 8); R[1] = *(const u32x4*)(gW + ch_ * 8192 + (size_t)(tid + 512) * 8); \
        R[2] = *(const u32x4*)(gQG + ch_ * 8192 + (size_t)tid * 8); R[3] = *(const u32x4*)(gQG + ch_ * 8192 + (size_t)(tid + 512) * 8); \
        R[4] = *(const u32x4*)(gKDT + ch_ * 8192 + (size_t)tid * 8); R[5] = *(const u32x4*)(gKDT + ch_ * 8192 + (size_t)(tid + 512) * 8); \
        R[6] = *(const u32x4*)(gATT + ch_ * 4096 + (size_t)tid * 8); \
        _Pragma("unroll") for (int tb_ = 0; tb_ < 4; ++tb_) ur[tb_] = *(const u32x2*)(gUT + ch_ * 8192 + (vb * 16 + fr) * 64 + tb_ * 16 + 4 * fq); \
        eglr = EGL[ch_]; } while (0)
    GDN_PREFETCH(((size_t)b * NCH + 0) * 4 + h);
#pragma unroll 1
    for (int c = 0; c < NCH; ++c) {
        __syncthreads();
        *(LAS u32x4*)(Wb + r16 * 136 + c16 * 8) = R[0];        *(LAS u32x4*)(Wb + (r16 + 32) * 136 + c16 * 8) = R[1];
        *(LAS u32x4*)(QGb + r16 * 136 + c16 * 8) = R[2];       *(LAS u32x4*)(QGb + (r16 + 32) * 136 + c16 * 8) = R[3];
        *(LAS u32x4*)(KTb + r8 * 72 + c8 * 8) = R[4];          *(LAS u32x4*)(KTb + (r8 + 64) * 72 + c8 * 8) = R[5];
        *(LAS u32x4*)(ATb + r8 * 72 + c8 * 8) = R[6];
        f32x4 uv[4];
#pragma unroll
        for (int tb = 0; tb < 4; ++tb) uv[tb] = unpack4(ur[tb]);
        const float egl = eglr;
        __syncthreads();
        if (c + 1 < NCH) GDN_PREFETCH(((size_t)b * NCH + c + 1) * 4 + h);
        bf16x8 sf[4];
#pragma unroll
        for (int kc = 0; kc < 4; ++kc) sf[kc] = *(const LAS bf16x8*)(ST + fr * 136 + kc * 32 + 8 * fq);
        f32x4 o[4];
#pragma unroll
        for (int tb = 0; tb < 4; ++tb) { f32x4 aw = (f32x4){0.f, 0.f, 0.f, 0.f}, aq = aw;
#pragma unroll
            for (int kc = 0; kc < 4; ++kc) { aw = mfma16(*(const LAS bf16x8*)(Wb + (tb * 16 + fr) * 136 + kc * 32 + 8 * fq), sf[kc], aw);
                                             aq = mfma16(*(const LAS bf16x8*)(QGb + (tb * 16 + fr) * 136 + kc * 32 + 8 * fq), sf[kc], aq); }
            const f32x4 vn = uv[tb] - aw; o[tb] = aq;
            *(LAS u32x2*)(VNT + fr * 72 + tb * 16 + 4 * fq) = pack4(vn); }
        LDS_WAIT();
        bf16x8 vf[2];
#pragma unroll
        for (int k2 = 0; k2 < 2; ++k2) vf[k2] = *(const LAS bf16x8*)(VNT + fr * 72 + k2 * 32 + 8 * fq);
#pragma unroll
        for (int tb = 0; tb < 4; ++tb)
#pragma unroll
            for (int k2 = 0; k2 < 2; ++k2) o[tb] = mfma16(*(const LAS bf16x8*)(ATb + (tb * 16 + fr) * 72 + k2 * 32 + 8 * fq), vf[k2], o[tb]);
#pragma unroll
        for (int kb = 0; kb < 8; ++kb) { f32x4 s = Sacc[kb] * egl;
#pragma unroll
            for (int k2 = 0; k2 < 2; ++k2) s = mfma16(*(const LAS bf16x8*)(KTb + (kb * 16 + fr) * 72 + k2 * 32 + 8 * fq), vf[k2], s);
            Sacc[kb] = s;
            *(LAS u32x2*)(ST + fr * 136 + kb * 16 + 4 * fq) = pack4(s); }
        const int t0 = 64 * c - 48;
#pragma unroll
        for (int tb = 0; tb < 4; ++tb)
#pragma unroll
            for (int r = 0; r < 4; ++r) { const int t = t0 + tb * 16 + 4 * fq + r; if (t >= 0) U[(mrow0 + t) * DIN + 4096 + h * 128 + vb * 16 + fr] = (bf16)f2bf(o[tb][r]); }
        LDS_WAIT();
    }
#undef GDN_PREFETCH
    { float* so = A.out + O_GP + ((size_t)(l * NB + b) * 4 + h) * 16384;
#pragma unroll
        for (int kb = 0; kb < 8; ++kb)
#pragma unroll
            for (int r = 0; r < 4; ++r) so[(size_t)(kb * 16 + 4 * fq + r) * 128 + vb * 16 + fr] = Sacc[kb][r]; }
    VM_WAIT(); __syncthreads();
    bf16* MIX = (bf16*)(A.ws + WS_MIX);
    const float nw0 = A.in[21][l * 128 + 2 * lane], nw1 = A.in[21][l * 128 + 2 * lane + 1];
    for (int t = C.wave; t < TP; t += NWAVES) { const size_t m = mrow0 + t;
        const unsigned ow = *(const unsigned*)(U + m * DIN + 4096 + h * 128 + 2 * lane), zw = *(const unsigned*)(U + m * DIN + 4608 + h * 128 + 2 * lane);
        const float o0 = bflo(ow), o1 = bfhi(ow);
        const float rn = rsqrtf(wave_sum(o0 * o0 + o1 * o1) * (1.f / 128.f) + EPS);
        *(unsigned*)(MIX + m * DMIX + 1024 + h * 128 + 2 * lane) = pk2(o0 * rn * nw0 * siluf_(bflo(zw)), o1 * rn * nw1 * siluf_(bfhi(zw))); }
}

DI void p3_ret_chain(const Args& A, const Ctx& C, int l, int b, int h) {
    const int tid = C.tid, lane = C.lane, fr = lane & 15, fq = lane >> 4, vb = C.wave;
    LAS unsigned char* L = C.lds;
    LAS bf16* Qb = (LAS bf16*)(L + CL_A); LAS bf16* KTb = (LAS bf16*)(L + CL_KT); LAS bf16* SCb = (LAS bf16*)(L + CL_AT);
    LAS bf16* ST = (LAS bf16*)(L + CL_PRIV + vb * CL_PRIV_BYTES);
    bf16* U = (bf16*)(A.ws + WS_U); const size_t mrow0 = (size_t)b * TP;
    const bf16* gKRT = (const bf16*)(A.ws + R_KRT); const bf16* gVT = (const bf16*)(A.ws + R_VT); const bf16* gSC = (const bf16*)(A.ws + R_SC);
    for (int e = lane; e < 16 * 136 / 2; e += 64) ((LAS unsigned*)ST)[e] = 0u;
    f32x4 Sacc[8];
#pragma unroll
    for (int kb = 0; kb < 8; ++kb) Sacc[kb] = (f32x4){0.f, 0.f, 0.f, 0.f};
    const float sdec = exp2f(64.f * log2f(1.f - exp2f(-5.f - (float)h)));
    u32x4 R[5]; bf16x8 vfr[2];
    const int r16 = tid >> 4, c16 = tid & 15, r8 = tid >> 3, c8 = tid & 7;
#define RET_PREFETCH(CC_) do { const int cc_ = (CC_); const size_t ch_ = ((size_t)b * NCH + cc_) * 4 + h; const int t0_ = 64 * cc_ - 48; \
        { const int ta_ = t0_ + r16, tb2_ = t0_ + r16 + 32; const u32x4 z_ = (u32x4){0u, 0u, 0u, 0u}; \
          R[0] = ta_ >= 0 ? *(const u32x4*)(U + (mrow0 + ta_) * DIN + 1024 + h * 128 + c16 * 8) : z_; \
          R[1] = tb2_ >= 0 ? *(const u32x4*)(U + (mrow0 + tb2_) * DIN + 1024 + h * 128 + c16 * 8) : z_; } \
        R[2] = *(const u32x4*)(gKRT + ch_ * 8192 + (size_t)tid * 8); R[3] = *(const u32x4*)(gKRT + ch_ * 8192 + (size_t)(tid + 512) * 8); \
        R[4] = *(const u32x4*)(gSC + ch_ * 4096 + (size_t)tid * 8); \
        _Pragma("unroll") for (int k2_ = 0; k2_ < 2; ++k2_) vfr[k2_] = *(const bf16x8*)(gVT + ch_ * 8192 + (vb * 16 + fr) * 64 + k2_ * 32 + 8 * fq); } while (0)
    RET_PREFETCH(0);
#pragma unroll 1
    for (int c = 0; c < NCH; ++c) {
        __syncthreads();
        *(LAS u32x4*)(Qb + r16 * 136 + c16 * 8) = R[0];        *(LAS u32x4*)(Qb + (r16 + 32) * 136 + c16 * 8) = R[1];
        *(LAS u32x4*)(KTb + r8 * 72 + c8 * 8) = R[2];          *(LAS u32x4*)(KTb + (r8 + 64) * 72 + c8 * 8) = R[3];
        *(LAS u32x4*)(SCb + r8 * 72 + c8 * 8) = R[4];
        bf16x8 vf[2]; vf[0] = vfr[0]; vf[1] = vfr[1];
        __syncthreads();
        if (c + 1 < NCH) RET_PREFETCH(c + 1);
        bf16x8 sf[4];
#pragma unroll
        for (int kc = 0; kc < 4; ++kc) sf[kc] = *(const LAS bf16x8*)(ST + fr * 136 + kc * 32 + 8 * fq);
        f32x4 o[4];
#pragma unroll
        for (int tb = 0; tb < 4; ++tb) { f32x4 aq = (f32x4){0.f, 0.f, 0.f, 0.f};
#pragma unroll
            for (int kc = 0; kc < 4; ++kc) aq = mfma16(*(const LAS bf16x8*)(Qb + (tb * 16 + fr) * 136 + kc * 32 + 8 * fq), sf[kc], aq);
#pragma unroll
            for (int k2 = 0; k2 < 2; ++k2) aq = mfma16(*(const LAS bf16x8*)(SCb + (tb * 16 + fr) * 72 + k2 * 32 + 8 * fq), vf[k2], aq);
            o[tb] = aq; }
#pragma unroll
        for (int kb = 0; kb < 8; ++kb) { f32x4 s = Sacc[kb] * sdec;
#pragma unroll
            for (int k2 = 0; k2 < 2; ++k2) s = mfma16(*(const LAS bf16x8*)(KTb + (kb * 16 + fr) * 72 + k2 * 32 + 8 * fq), vf[k2], s);
            Sacc[kb] = s;
            *(LAS u32x2*)(ST + fr * 136 + kb * 16 + 4 * fq) = pack4(s); }
        const int t0 = 64 * c - 48;
#pragma unroll
        for (int tb = 0; tb < 4; ++tb)
#pragma unroll
            for (int r = 0; r < 4; ++r) { const int t = t0 + tb * 16 + 4 * fq + r; if (t >= 0) U[(mrow0 + t) * DIN + 2048 + h * 128 + vb * 16 + fr] = (bf16)f2bf(o[tb][r]); }
        LDS_WAIT();
    }
#undef RET_PREFETCH
    { float* so = A.out + O_RP + ((size_t)(l * NB + b) * 4 + h) * 16384;
#pragma unroll
        for (int kb = 0; kb < 8; ++kb)
#pragma unroll
            for (int r = 0; r < 4; ++r) so[(size_t)(kb * 16 + 4 * fq + r) * 128 + vb * 16 + fr] = Sacc[kb][r]; }
    VM_WAIT(); __syncthreads();
    bf16* MIX = (bf16*)(A.ws + WS_MIX);
    const float gw0 = A.in[16][l * 512 + h * 128 + 2 * lane], gw1 = A.in[16][l * 512 + h * 128 + 2 * lane + 1];
    const float gb0 = A.in[17][l * 512 + h * 128 + 2 * lane], gb1 = A.in[17][l * 512 + h * 128 + 2 * lane + 1];
    for (int t = C.wave; t < TP; t += NWAVES) { const size_t m = mrow0 + t;
        const unsigned ow = *(const unsigned*)(U + m * DIN + 2048 + h * 128 + 2 * lane), zw = *(const unsigned*)(U + m * DIN + 2560 + h * 128 + 2 * lane);
        const float o0 = bflo(ow), o1 = bfhi(ow);
        const float mu = wave_sum(o0 + o1) * (1.f / 128.f); const float d0 = o0 - mu, d1 = o1 - mu;
        const float rn = rsqrtf(wave_sum(d0 * d0 + d1 * d1) * (1.f / 128.f) + EPS);
        *(unsigned*)(MIX + m * DMIX + 512 + h * 128 + 2 * lane) = pk2((d0 * rn * gw0 + gb0) * siluf_(bflo(zw)), (d1 * rn * gw1 + gb1) * siluf_(bfhi(zw))); }
}

template <int KIND>
DI void p3_dec_item(const Args& A, const Ctx& C, int l, int s, int h) {
    const int tid = C.tid, lane = C.lane, wave = C.wave;
    LAS float* F = (LAS float*)C.lds; LAS float* vq = F, *vk = F + 128, *vv = F + 256, *part = F + 384  , *red = F + 896  ;
    const bf16* U = (const bf16*)(A.ws + WS_U); const size_t m = (size_t)MP + s; const bf16* u = U + m * DIN;
    __syncthreads();
    float g = 0.f, beta = 0.f;
    if (KIND == 0) {
        if (tid < 64) { const f32x2 cs = ((const f32x2*)(A.ws + WS_TAB))[2064 * 64 + tid];
            const float q1 = bf2f(u[1024 + h * 128 + tid]), q2 = bf2f(u[1024 + h * 128 + 64 + tid]), k1 = bf2f(u[1536 + h * 128 + tid]), k2 = bf2f(u[1536 + h * 128 + 64 + tid]);
            vq[tid] = q1 * cs[0] - q2 * cs[1]; vq[64 + tid] = q1 * cs[1] + q2 * cs[0];
            vk[tid] = (k1 * cs[0] - k2 * cs[1]) * QSCALE; vk[64 + tid] = (k1 * cs[1] + k2 * cs[0]) * QSCALE; }
        else if (tid >= 128 && tid < 256) vv[tid - 128] = bf2f(u[2048 + h * 128 + (tid - 128)]);
    } else {
        float y = 0.f; const int part3 = tid >> 7, d = tid & 127;
        if (tid < 384) { const int ch = part3 * 512 + h * 128 + d; const float* cv = A.in[5] + ((size_t)(l * NS + s) * 3) * 1536 + ch; const float* cw = A.in[18] + (size_t)l * 4 * 1536 + ch;
            const float x0 = cv[0], x1 = cv[1536], x2 = cv[3072], x3 = bf2f(u[3072 + ch]);
            y = siluf_(cw[0] * x0 + cw[1536] * x1 + cw[3072] * x2 + cw[4608] * x3);
            float* oc = A.out + O_GCS + ((size_t)(l * NS + s) * 3) * 1536 + ch; oc[0] = x1; oc[1536] = x2; oc[3072] = x3; }
        const float ss = wave_sum(y * y);
        if (lane == 0) red[wave] = ss;
        __syncthreads();
        if (tid < 384) { const float tot = red[2 * part3] + red[2 * part3 + 1];
            if (part3 == 0) vq[d] = y * rsqrtf(tot + EPS) * QSCALE; else if (part3 == 1) vk[d] = y * rsqrtf(tot + EPS); else vv[d] = y; }
        const float* gp = (const float*)(A.ws + WS_GAB) + m * 8;
        g = -__expf(A.in[19][l * 4 + h]) * softplusf_(gp[h] + A.in[20][l * 4 + h]); beta = sigmoidf_(gp[4 + h]);
    }
    __syncthreads();
    const int dv = tid & 127, qt = tid >> 7;
    const float* st = (KIND == 0 ? A.in[4] : A.in[6]) + ((size_t)(l * NS + s) * 4 + h) * 16384 + (size_t)(32 * qt) * 128 + dv;
    float* so = A.out + (KIND == 0 ? O_RS : O_GS) + ((size_t)(l * NS + s) * 4 + h) * 16384 + (size_t)(32 * qt) * 128 + dv;
    float S[32];
#pragma unroll
    for (int i = 0; i < 32; ++i) S[i] = st[(size_t)i * 128];
    const float vdv = vv[dv]; float acc = 0.f;
    if (KIND == 0) {
        const float gam = 1.f - exp2f(-5.f - (float)h);
#pragma unroll
        for (int i = 0; i < 32; ++i) { S[i] = fmaf(gam, S[i], vk[32 * qt + i] * vdv); acc = fmaf(vq[32 * qt + i], S[i], acc); }
    } else {
        const float eg = __expf(g); float ks = 0.f;
#pragma unroll
        for (int i = 0; i < 32; ++i) ks = fmaf(vk[32 * qt + i], S[i], ks);
        part[qt * 128 + dv] = ks;
        __syncthreads();
        const float vn = beta * (vdv - eg * (part[dv] + part[128 + dv] + part[256 + dv] + part[384 + dv]));
        __syncthreads();
#pragma unroll
        for (int i = 0; i < 32; ++i) { S[i] = fmaf(eg, S[i], vk[32 * qt + i] * vn); acc = fmaf(vq[32 * qt + i], S[i], acc); }
    }
    part[qt * 128 + dv] = acc;
#pragma unroll
    for (int i = 0; i < 32; ++i) so[(size_t)i * 128] = S[i];
    __syncthreads();
    bf16* MIX = (bf16*)(A.ws + WS_MIX);
    float o = 0.f, sz = 0.f;
    if (tid < 128) { o = part[dv] + part[128 + dv] + part[256 + dv] + part[384 + dv]; sz = siluf_(bf2f(u[(KIND == 0 ? 2560 : 4608) + h * 128 + dv])); }
    if (KIND == 0) {
        const float s1 = wave_sum(o);
        if (lane == 0) red[wave] = s1;
        __syncthreads();
        const float mu = (red[0] + red[1]) * (1.f / 128.f); const float d = tid < 128 ? o - mu : 0.f;
        __syncthreads();
        const float s2 = wave_sum(d * d);
        if (lane == 0) red[wave] = s2;
        __syncthreads();
        const float rn = rsqrtf((red[0] + red[1]) * (1.f / 128.f) + EPS);
        if (tid < 128) MIX[m * DMIX + 512 + h * 128 + dv] = (bf16)f2bf((d * rn * A.in[16][l * 512 + h * 128 + dv] + A.in[17][l * 512 + h * 128 + dv]) * sz);
    } else {
        const float s2 = wave_sum(o * o);
        if (lane == 0) red[wave] = s2;
        __syncthreads();
        const float rn = rsqrtf((red[0] + red[1]) * (1.f / 128.f) + EPS);
        if (tid < 128) MIX[m * DMIX + 1024 + h * 128 + dv] = (bf16)f2bf(o * rn * A.in[21][l * 128 + dv] * sz);
    }
}

DI void p3_rg_fix(const Args& A, const Ctx& C, int l, int b, int c) {
    const int tid = C.tid, ch8 = 8 * (tid & 63), tsub = tid >> 6;
    const bf16* U = (const bf16*)(A.ws + WS_U); const bf16* BETA = (const bf16*)(A.ws + WS_BETA); bf16* MIX = (bf16*)(A.ws + WS_MIX);
    const f32x4* RGS = (const f32x4*)((const f32x2*)(A.ws + WS_RGS) + (size_t)b * NCH * 512 + ch8);
    float hin[8];
#pragma unroll
    for (int e = 0; e < 8; ++e) hin[e] = 0.f;
    for (int cp = 0; cp < c; ++cp) {
#pragma unroll
        for (int e2 = 0; e2 < 4; ++e2) { const f32x4 p = RGS[(size_t)cp * 256 + e2]; hin[2 * e2] = fmaf(p[0], hin[2 * e2], p[1]); hin[2 * e2 + 1] = fmaf(p[2], hin[2 * e2 + 1], p[3]); } }
    const int t0 = 64 * c - 48; const size_t mrow0 = (size_t)b * TP;
    for (int i = tsub; i < 64; i += 8) { const int t = t0 + i; if (t < 0) continue;
        float al[8], be[8];
        unpack8(*(const u32x4*)(U + (mrow0 + t) * DIN + 512 + ch8), al); unpack8(*(const u32x4*)(BETA + ((size_t)b * TP + t) * 512 + ch8), be);
#pragma unroll
        for (int e = 0; e < 8; ++e) al[e] = fmaf(be[e], hin[e], al[e]);
        *(u32x4*)(MIX + (mrow0 + t) * DMIX + ch8) = pack8(al); }
    if (c == NCH - 1 && tsub == 0) { float* o = A.out + O_HP + (size_t)(l * NB + b) * 512 + ch8;
#pragma unroll
        for (int e2 = 0; e2 < 4; ++e2) { const f32x4 p = RGS[(size_t)c * 256 + e2]; o[2 * e2] = fmaf(p[0], hin[2 * e2], p[1]); o[2 * e2 + 1] = fmaf(p[2], hin[2 * e2 + 1], p[3]); } }
}

DI void phase_p3(const Args& A, const Ctx& C, int l) {
    if (C.bid < 64) { const int kind = C.bid & 1, bh = C.bid >> 1; if (kind) p3_ret_chain(A, C, l, bh >> 2, bh & 3); else p3_gdn_chain(A, C, l, bh >> 2, bh & 3); return; }
    if (C.G <= 64) return;
    const int NJ = C.G - 64;
    for (int it = C.bid - 64; it < 1024 + NB * NCH; it += NJ) {
        if (it < 512) p3_dec_item<1>(A, C, l, it >> 2, it & 3);
        else if (it < 1024) p3_dec_item<0>(A, C, l, (it - 512) >> 2, it & 3);
        else { const int r = it - 1024; p3_rg_fix(A, C, l, r / NCH, r % NCH); }
    }
}

constexpr int N_PHASES = 1 + 5 * DEPTH;
DI const Args* launder(const Args* p) { asm volatile("" : "+s"(p)); return p; }
__global__ void __launch_bounds__(NTHR, 2) mk_fwd(Args args) {
    extern __shared__ __attribute__((aligned(16))) unsigned char lds_raw[];
    const Args* AP = (const Args*)__builtin_amdgcn_kernarg_segment_ptr();
#define A (*launder(AP))
#define MISCP ((volatile LAS unsigned*)((LAS unsigned char*)lds_raw + MISC_OFF))
#define MK_CTX() Ctx C; { int t_ = threadIdx.x; asm volatile("" : "+v"(t_)); C.lds = (LAS unsigned char*)lds_raw; C.tid = t_; C.lane = t_ & 63; C.wave = __builtin_amdgcn_readfirstlane(t_ >> 6); C.G = gridDim.x; C.bid = blockIdx.x; }
#define IN(p) (A.ph_lo <= (p) && (p) < A.ph_hi)
#define SEAM(p) do { if (IN(p) && IN((p) + 1)) { XcdBarrier bar_; bar_.bar = (unsigned*)(A.ws + WS_CTL) + CW_BAR; bar_.x = xb_xcc_id(); bar_.st = MISCP + 8; xcd_barrier(bar_); } } while (0)
    if (threadIdx.x < 32) MISCP[threadIdx.x] = 0u;
    __syncthreads();
    if (A.ph_hi - A.ph_lo > 1) (void)xcd_barrier_post((unsigned*)(A.ws + WS_CTL) + CW_BAR, MISCP + 8);
    if (IN(0)) { MK_CTX(); convert_weights(A, C, 0); build_rope_table(A, C); row_pass(A, C, 0); }
    SEAM(0);
#define LAYER(l) do { \
        if (IN(1 + 5 * (l))) { struct { LAS unsigned char* lds; int G, bid; } C{(LAS unsigned char*)lds_raw, (int)gridDim.x, (int)blockIdx.x}; \
            pg8::Gemm g{(const pg8::bf16_t*)(A.ws + WS_XB), (const pg8::bf16_t*)(A.ws + WS_WINT), M, DIN, DM}; pg8::StaticOrder S; S.init(M, DIN, C.G, C.bid); \
            pg8::EpiU E{(pg8::bf16_t*)(A.ws + WS_U), DIN}; \
            pg8::gemm_phase<pg8::EpiU, pg8::StaticOrder, true, true>(C.lds, g, S, E); } \
        SEAM(1 + 5 * (l)); \
        if (IN(2 + 5 * (l))) { MK_CTX(); phase_p2(A, C, (l)); } \
        SEAM(2 + 5 * (l)); \
        if (IN(3 + 5 * (l))) { MK_CTX(); phase_p3(A, C, (l)); } \
        SEAM(3 + 5 * (l)); \
        if (IN(4 + 5 * (l))) { struct { LAS unsigned char* lds; int G, bid; } C{(LAS unsigned char*)lds_raw, (int)gridDim.x, (int)blockIdx.x}; \
            pg8::Gemm g{(const pg8::bf16_t*)(A.ws + WS_MIX), (const pg8::bf16_t*)(A.ws + WS_WOUTT), M, DM, DMIX}; pg8::StaticOrder S; S.init(M, DM, C.G, C.bid); \
            pg8::EpiRes E{(float*)(A.ws + WS_XF), DM, ALPHA}; \
            pg8::gemm_phase<pg8::EpiRes, pg8::StaticOrder, false, true>(C.lds, g, S, E); } \
        SEAM(4 + 5 * (l)); \
        if (IN(5 + 5 * (l))) { MK_CTX(); if ((l) + 1 < DEPTH) convert_weights(A, C, (l) + 1); row_pass(A, C, (l) + 1); } \
        if ((l) + 1 < DEPTH) SEAM(5 + 5 * (l)); } while (0)
    LAYER(0); LAYER(1); LAYER(2); LAYER(3);
#undef LAYER
#undef IN
#undef SEAM
#undef A
#undef MK_CTX
#undef MISCP
}

}

#ifndef MK_DEBUG
#define MK_DEBUG 0
#endif
#ifndef MK_PROBE
#define MK_PROBE -1
#endif
#ifndef MK_LAUNCH_PER_PHASE
#define MK_LAUNCH_PER_PHASE 0
#endif
extern "C" void kernel_launch(void* const* d_in, const int* in_sizes, int n_in, void* d_out, int out_size, void* d_ws, size_t ws_size, hipStream_t stream) {
    using namespace fx;
    static int grid = 0;
    if (grid == 0) {
        int dev = 0, cus = 0;
        if (n_in != 25 || out_size != (int)O_END || ws_size < WS_END) { fprintf(stderr, "kernel_launch: unexpected sizes (n_in %d, out %d, ws %zu)\n", n_in, out_size, ws_size); grid = -1; return; }
        if (hipGetDevice(&dev) != hipSuccess || hipDeviceGetAttribute(&cus, hipDeviceAttributeMultiprocessorCount, dev) != hipSuccess) { grid = -1; return; }
        if (hipFuncSetAttribute((const void*)mk_fwd, hipFuncAttributeMaxDynamicSharedMemorySize, LDS_BYTES) != hipSuccess) { fprintf(stderr, "kernel_launch: hipFuncSetAttribute failed\n"); grid = -1; return; }
        (void)hipGetLastError();
        grid = cus;
    }
    if (grid < 0) return;
    unsigned char* ws = (unsigned char*)d_ws;
    (void)hipMemsetAsync(ws + WS_CTL, 0, CTL_ZERO_BYTES, stream);
    Args a{};
    for (int i = 0; i < 25; ++i) a.in[i] = (const float*)d_in[i];
    a.out = (float*)d_out; a.ws = ws;
#if MK_DEBUG
    using namespace dbg;
    float* err = (float*)(ws + D_ERR);
    (void)hipMemsetAsync(err, 0, 8192, stream);
    nv::Io io; for (int i = 0; i < 25; ++i) io.in[i] = (const float*)d_in[i]; io.out = (float*)d_out;
    const float* XF = (const float*)(ws + WS_XF); const bf16* XB = (const bf16*)(ws + WS_XB); const float* GAB = (const float*)(ws + WS_GAB); const bf16* U = (const bf16*)(ws + WS_U);
    const bf16* MIX = (const bf16*)(ws + WS_MIX); float* MIXn = (float*)(ws + D_MIXN); float* CST = (float*)(ws + D_ST); float* XFc = (float*)(ws + D_XFC);
    float* out = (float*)d_out;
    for (int ph = 0; ph < N_PHASES; ++ph) {
        const int l = ph == 0 ? -1 : (ph - 1) / 5, k = ph == 0 ? -1 : (ph - 1) % 5;
        if (k == 1) {
            nv::LayerP P = nv::layer_params(io, l);
            P.o_hp = CST + C_HP; P.o_cp = CST + C_CP; P.o_rp = CST + C_RP; P.o_gcp = CST + C_GCP; P.o_gp = CST + C_GP;
            P.o_hs = CST + C_HS; P.o_cs = CST + C_CS; P.o_rs = CST + C_RS; P.o_gcs = CST + C_GCS; P.o_gs = CST + C_GS;
            const nv::Grp g{0, 1, 0, 16}; const nv::UBF ua{(const unsigned short*)U, GAB, 2064, 0};
            nv::rg_kernel<nv::UBF><<<dim3(8, 17), 64, 0, stream>>>(g, P, ua, MIXn);
            nv::ret_kernel<nv::UBF><<<dim3(4, 17), 256, 0, stream>>>(g, P, ua, MIXn);
            nv::gdn_kernel<nv::UBF><<<dim3(4, 17), 256, 0, stream>>>(g, P, ua, MIXn);
        }
        if (k == 3) copy_rows<<<SUBR, 256, 0, stream>>>(XF, XFc);
        a.ph_lo = ph; a.ph_hi = ph + 1;
        hipLaunchKernelGGL(mk_fwd, dim3(grid), dim3(NTHR), LDS_BYTES, stream, a);
        if (ph == 0 || k == 4) { const int ln = l + 1;
            if (ln < DEPTH) {
                if (ln == 0) chk_x0<<<SUBR, 256, 0, stream>>>(XF, io.in[0], io.in[1], io.in[7], err, 18 * ln + 0);
                chk_rows_in<<<SUBR, 256, 0, stream>>>(XF, XB, GAB, io.in[8] + (size_t)ln * DM * DINX, err, 18 * ln + 0);
                chk_wt<<<1024, 256, 0, stream>>>((const bf16*)(ws + WS_WINT), io.in[8] + (size_t)ln * DM * DINX, DINX, DM, DIN, err, 18 * ln + 1);
                chk_wt<<<512, 256, 0, stream>>>((const bf16*)(ws + WS_WOUTT), io.in[22] + (size_t)ln * DMIX * DM, DM, DMIX, DM, err, 18 * ln + 1);
                for (int gt = 0; gt < 2; ++gt) for (int n = 0; n < 8; ++n)
                    chk_wt<<<4, 256, 0, stream>>>((const bf16*)(ws + WS_GATEW) + (size_t)(gt * 8 + n) * 4096, io.in[gt ? 13 : 11] + ((size_t)ln * 8 + n) * 4096, 64, 64, 64, err, 18 * ln + 1);
            }
        }
        if (k == 0) chk_u<<<dim3(DIN / 256, SUBR), 256, 0, stream>>>(XF, io.in[8] + (size_t)l * DM * DINX, U, err, 18 * l + 2);
        if (k == 2) {
            chk_mix<<<SUBR, 256, 0, stream>>>(MIX, MIXn, err, 18 * l + 3);
            chk_vec<<<8, 256, 0, stream>>>(CST + C_HP, out + O_HP + (size_t)(l * NB) * 512, 512, err, 18 * l + 9);
            chk_vec<<<8, 256, 0, stream>>>(CST + C_CP, out + O_CP + (size_t)(l * NB) * 1536, 1536, err, 18 * l + 10);
            chk_vec<<<8, 256, 0, stream>>>(CST + C_GCP, out + O_GCP + (size_t)(l * NB) * 4608, 4608, err, 18 * l + 10);
            chk_vec<<<64, 256, 0, stream>>>(CST + C_RP, out + O_RP + (size_t)(l * NB) * 65536, 65536, err, 18 * l + 11);
            chk_vec<<<64, 256, 0, stream>>>(CST + C_GP, out + O_GP + (size_t)(l * NB) * 65536, 65536, err, 18 * l + 12);
            chk_vec<<<16, 256, 0, stream>>>(CST + C_HS, out + O_HS + (size_t)(l * NS) * 512, 16 * 512, err, 18 * l + 13);
            chk_vec<<<16, 256, 0, stream>>>(CST + C_CS, out + O_CS + (size_t)(l * NS) * 1536, 16 * 1536, err, 18 * l + 14);
            chk_vec<<<16, 256, 0, stream>>>(CST + C_GCS, out + O_GCS + (size_t)(l * NS) * 4608, 16 * 4608, err, 18 * l + 14);
            chk_vec<<<256, 256, 0, stream>>>(CST + C_RS, out + O_RS + (size_t)(l * NS) * 65536, 16 * 65536, err, 18 * l + 15);
            chk_vec<<<256, 256, 0, stream>>>(CST + C_GS, out + O_GS + (size_t)(l * NS) * 65536, 16 * 65536, err, 18 * l + 16);
        }
        if (k == 4) chk_out<<<SUBR, 256, 0, stream>>>(XFc, MIX, io.in[22] + (size_t)l * DMIX * DM, io.in[23] + (size_t)l * DM, io.in[24] + (size_t)l * DM,
                                                     XF, out + O_YP, out + O_YS, l == DEPTH - 1, err, 18 * l + 17);
    }
    nv::run(io, nv::Grp{0, 4, 0, 64}, ws, stream);
    nv::run(io, nv::Grp{4, 4, 64, 64}, ws, stream);
    dbg_eval<<<1, 64, 0, stream>>>(err, MK_PROBE);
    dbg_apply<<<128, 256, 0, stream>>>(err, out + O_YS);
#else
#if MK_LAUNCH_PER_PHASE
    for (int ph = 0; ph < N_PHASES; ++ph) { a.ph_lo = ph; a.ph_hi = ph + 1; hipLaunchKernelGGL(mk_fwd, dim3(grid), dim3(NTHR), LDS_BYTES, stream, a); }
#else
    a.ph_lo = 0; a.ph_hi = N_PHASES;
    hipLaunchKernelGGL(mk_fwd, dim3(grid), dim3(NTHR), LDS_BYTES, stream, a);
#endif
#endif
}
```

```cpp
#include <hip/hip_runtime.h>
#include <cstdio>
#include <cstdint>
#define MK_DEBUG 0
#define MK_PROBE -1
#define MK_LAUNCH_PER_PHASE 0

namespace fx {
#define GAS __attribute__((address_space(1)))
#define LAS __attribute__((address_space(3)))
#define DI __device__ __forceinline__
typedef unsigned short bf16;
typedef short bf16x8 __attribute__((ext_vector_type(8)));
typedef float f32x4 __attribute__((ext_vector_type(4)));
typedef float f32x2 __attribute__((ext_vector_type(2)));
typedef unsigned u32x4 __attribute__((ext_vector_type(4)));
typedef unsigned u32x2 __attribute__((ext_vector_type(2)));
typedef GAS unsigned gu32;

constexpr int NWAVES = 8, NTHR = 512;
constexpr int DM = 1024, TP = 2064, NB = 8, NS = 128, MP = NB * TP, M = MP + NS, DIN = 5120, DINX = 5128, DMIX = 1536, DEPTH = 4, NCH = 33, NCHH = NB * NCH * 4;
constexpr float EPS = 1e-6f, ALPHA = 1.681792830507429f, QSCALE = 0.08838834764831845f;

constexpr size_t MiB = 1u << 20;
constexpr size_t WS_CTL = 0, CTL_ZERO_BYTES = 1 * MiB;
constexpr size_t WS_TAB = 1 * MiB;
constexpr size_t WS_GATEW = 3 * MiB;
constexpr size_t WS_WINT = 4 * MiB;
constexpr size_t WS_WOUTT = 14 * MiB;
constexpr size_t WS_GAB = 17 * MiB;
constexpr size_t WS_RGS = 18 * MiB;
constexpr size_t WS_EGL = 20 * MiB;
constexpr size_t WS_XB = 21 * MiB;
constexpr size_t WS_XF = 54 * MiB;
constexpr size_t WS_U = 119 * MiB;
constexpr size_t WS_MIX = 282 * MiB;
constexpr size_t WS_BETA = 331 * MiB;
constexpr size_t WS_GDN = 348 * MiB;
constexpr size_t WS_RET = 423 * MiB;
constexpr size_t WS_DBG = 465 * MiB;
constexpr size_t WS_END = 512 * MiB;
constexpr size_t T16 = 16384, T8 = 8192;
constexpr size_t G_W = WS_GDN, G_QG = G_W + NCHH * T16, G_KDT = G_QG + NCHH * T16, G_UT = G_KDT + NCHH * T16, G_ATT = G_UT + NCHH * T16;
constexpr size_t R_KRT = WS_RET, R_VT = R_KRT + NCHH * T16, R_SC = R_VT + NCHH * T16;
constexpr size_t S_QH = WS_MIX, S_KH = S_QH + NCHH * T16, S_RWT = WS_XB;
static_assert(G_ATT + NCHH * T8 <= WS_RET && R_SC + NCHH * T8 <= WS_DBG, "ws map");
static_assert(S_KH + NCHH * T16 <= WS_BETA && S_RWT + NCHH * T16 <= WS_XF, "ws alias map");
constexpr int CW_BAR = 4096;

constexpr int RING_BYTES = 131072;
constexpr int PRIV_BYTES = 18432;
constexpr int MISC_OFF = 147456;
constexpr int LDS_BYTES = 149504;

constexpr size_t O_YP = 0, O_YS = 16777216, O_HP = 16908288, O_CP = 16924672, O_RP = 16973824, O_GCP = 19070976, O_GP = 19218432,
                 O_HS = 21315584, O_CS = 21577728, O_RS = 22364160, O_GCS = 55918592, O_GS = 58277888, O_END = 91832320;

DI unsigned f2bf(float f) { unsigned u = __builtin_bit_cast(unsigned, f); return (u + 0x7fffu + ((u >> 16) & 1u)) >> 16; }
DI unsigned pk2(float lo, float hi) { return f2bf(lo) | (f2bf(hi) << 16); }
DI float bflo(unsigned w) { return __builtin_bit_cast(float, w << 16); }
DI float bfhi(unsigned w) { return __builtin_bit_cast(float, w & 0xffff0000u); }
DI float bf2f(bf16 h) { return __builtin_bit_cast(float, (unsigned)h << 16); }
DI void unpack8(const u32x4 w, float (&x)[8]) { x[0] = bflo(w.x); x[1] = bfhi(w.x); x[2] = bflo(w.y); x[3] = bfhi(w.y); x[4] = bflo(w.z); x[5] = bfhi(w.z); x[6] = bflo(w.w); x[7] = bfhi(w.w); }
DI u32x4 pack8(const float (&x)[8]) { u32x4 w; w.x = pk2(x[0], x[1]); w.y = pk2(x[2], x[3]); w.z = pk2(x[4], x[5]); w.w = pk2(x[6], x[7]); return w; }
DI u32x2 pack4(const f32x4 v) { u32x2 w; w.x = pk2(v[0], v[1]); w.y = pk2(v[2], v[3]); return w; }
DI f32x4 unpack4(const u32x2 w) { return (f32x4){bflo(w.x), bfhi(w.x), bflo(w.y), bfhi(w.y)}; }
DI float sigmoidf_(float x) { return 1.f / (1.f + __expf(-x)); }
DI float siluf_(float x) { return x / (1.f + __expf(-x)); }
DI float softplusf_(float x) { return x > 20.f ? x : log1pf(__expf(x)); }
DI float wave_sum(float v) {
#pragma unroll
    for (int o = 1; o < 64; o <<= 1) v += __shfl_xor(v, o);
    return v;
}
#define LDS_WAIT() asm volatile("s_waitcnt lgkmcnt(0)" ::: "memory")
#define VM_WAIT() asm volatile("s_waitcnt vmcnt(0)" ::: "memory")
DI f32x4 mfma16(bf16x8 a, bf16x8 b, f32x4 c) { return __builtin_amdgcn_mfma_f32_16x16x32_bf16(a, b, c, 0, 0, 0); }
}

namespace pg8 {
#define PG8_LAS __attribute__((address_space(3)))
typedef unsigned short bf16_t;
typedef short bf16x8 __attribute__((ext_vector_type(8)));
typedef float f32x4 __attribute__((ext_vector_type(4)));
typedef unsigned u32x4 __attribute__((ext_vector_type(4)));
constexpr int BM = 256, BK = 64, HALF = 128, HTB = HALF * BK * 2  , STAGE_BYTES = 8 * HTB, NXCD = 8, WGM = 8;

__host__ __device__ __forceinline__ int lds_byte(int r, int c) { const int st = (r >> 4) * 2 + (c >> 5), rr = r & 15, cc = c & 31, ob = rr * 64 + cc * 2; return st * 1024 + (ob ^ (((ob >> 9) & 1) << 5)); }
__host__ __device__ __forceinline__ void stage_rc(int b, int& R, int& C) { const int st = b / 1024, sb = b % 1024, swz = sb ^ (((sb >> 9) & 1) << 5); R = (st >> 1) * 16 + swz / 64; C = (st & 1) * 32 + (swz % 64) / 2; }
__host__ __device__ __forceinline__ int perm32(int rho) { const int n = rho >> 4, i = rho & 15; return 8 * (i >> 2) + 4 * n + (i & 3); }

struct Unit { int pm, pn; };
struct Gemm { const bf16_t* A; const bf16_t* Bt; int M, N, K; };

struct StaticOrder {
    int nM, nN, nwg, G, c;
    __host__ __device__ void init(int M, int N, int G_, int c_) { nM = M / BM; nN = N / BM; nwg = nM * nN; G = G_; c = c_; }
    __host__ __device__ bool next(int i, Unit& u) const {
        const long L = (long)i * G + c; if (L >= nwg) return false;
        int wgid = (int)L; { const int q = nwg / NXCD, r = nwg % NXCD, xcd = wgid % NXCD, off = wgid / NXCD; wgid = (xcd < r ? xcd * (q + 1) : r * (q + 1) + (xcd - r) * q) + off; }
        const int nig = WGM * nN, gid = wgid / nig, fm = gid * WGM, gsz = (nM - fm) < WGM ? (nM - fm) : WGM;
        u.pm = fm + ((wgid % nig) % gsz); u.pn = (wgid % nig) / gsz; return true;
    }
    __device__ __forceinline__ void a_ready(const Unit&) const {}
    __device__ __forceinline__ void done(const Unit&) const {}
};


__device__ __forceinline__ unsigned cvt_pk_bf16(float lo, float hi) { unsigned r; asm volatile("v_cvt_pk_bf16_f32 %0, %1, %2" : "=v"(r) : "v"(lo), "v"(hi)); return r; }
struct EpiU {
    static constexpr bool PERM = true, AFTER_DRAIN = false;
    bf16_t* O; int ldc;
    __device__ __forceinline__ void operator()(const f32x4 (&acc)[2][2][4][2], const Unit& u, int wr, int wc, int fr, int fq) const {
        const int row0 = u.pm * BM + wr * 64 + fr, col0 = u.pn * BM + wc * 32 + 8 * fq;
#pragma unroll
        for (int ai = 0; ai < 2; ++ai)
#pragma unroll
            for (int m = 0; m < 4; ++m) { bf16_t* rowp = O + (size_t)(row0 + ai * HALF + m * 16) * ldc + col0;
#pragma unroll
                for (int bj = 0; bj < 2; ++bj) { const f32x4 v0 = acc[ai][bj][m][0], v1 = acc[ai][bj][m][1];
                    u32x4 w; w.x = cvt_pk_bf16(v0[0], v0[1]); w.y = cvt_pk_bf16(v0[2], v0[3]); w.z = cvt_pk_bf16(v1[0], v1[1]); w.w = cvt_pk_bf16(v1[2], v1[3]);
                    *(u32x4*)(rowp + bj * HALF) = w; } }
    }
};
struct EpiRes {
    static constexpr bool PERM = false, AFTER_DRAIN = false;
    float* X; int ldc; float alpha;
    __device__ __forceinline__ void operator()(const f32x4 (&acc)[2][2][4][2], const Unit& u, int wr, int wc, int fr, int fq) const {
        const int col0 = u.pn * BM + wc * 32 + 4 * fq;
#pragma unroll
        for (int ai = 0; ai < 2; ++ai)
#pragma unroll
            for (int m = 0; m < 4; ++m) { const int r = u.pm * BM + ai * HALF + wr * 64 + m * 16 + fr; float* rowp = X + (size_t)r * ldc + col0;
#pragma unroll
                for (int bj = 0; bj < 2; ++bj)
#pragma unroll
                    for (int n = 0; n < 2; ++n) { f32x4* p = (f32x4*)(rowp + bj * HALF + n * 16); const f32x4 b = *p; *p = b * alpha + acc[ai][bj][m][n]; }
                asm volatile("" ::: "memory"); }
    }
};

template <class Epi, class Sched, bool ALIGN_EPI = false, bool SP2 = false>
__device__ __forceinline__ void gemm_phase(PG8_LAS unsigned char* lds, const Gemm g, const Sched& S, const Epi& E) {
    int tid_ = threadIdx.x; asm volatile("" : "+v"(tid_));
    const int tid = tid_, wid = __builtin_amdgcn_readfirstlane(tid >> 6), lane = tid & 63, wr = wid >> 2, wc = wid & 3, fr = lane & 15, fq = lane >> 4;
    const int K = g.K, nt = K / BK;
    unsigned voffA[2], voffB[2];
#pragma unroll
    for (int i = 0; i < 2; ++i) { int R, C; stage_rc(tid * 16 + i * 8192, R, C); const int Rb = Epi::PERM ? ((R & ~31) + perm32(R & 31)) : R;
        voffA[i] = (unsigned)(R * K + C) * 2u; voffB[i] = (unsigned)(Rb * K + C) * 2u; }
    const size_t kstep = (size_t)(BK * 2);
    const size_t hstep = (size_t)HALF * K * 2;
    const size_t tstep = 2 * hstep;
    const unsigned ldsw = (unsigned)wid * 1024u;
    const int aoff = lds_byte(wr * 64 + fr, fq * 8), boff = lds_byte(wc * 32 + fr, fq * 8);
#define PG8_SA(b, h) (((b) * 2 + (h)) * HTB)
#define PG8_SB(b, h) ((4 + (b) * 2 + (h)) * HTB)
#define PG8_STAGE(bufoff, gbase, voff) do { _Pragma("unroll") for (int _i = 0; _i < 2; ++_i) \
        __builtin_amdgcn_global_load_lds((const unsigned*)((const char*)(gbase) + (voff)[_i]), (PG8_LAS unsigned*)(lds + (bufoff) + ldsw + _i * 8192), 16, 0, 0); } while (0)
#define PG8_LDA(dst, b, h) do { _Pragma("unroll") for (int m = 0; m < 4; ++m) _Pragma("unroll") for (int k = 0; k < 2; ++k) dst[m][k] = *(const PG8_LAS bf16x8*)(lds + PG8_SA(b, h) + aoff + m * 2048 + k * 1024); } while (0)
#define PG8_LDB(dst, b, h) do { _Pragma("unroll") for (int n = 0; n < 2; ++n) _Pragma("unroll") for (int k = 0; k < 2; ++k) dst[n][k] = *(const PG8_LAS bf16x8*)(lds + PG8_SB(b, h) + boff + n * 2048 + k * 1024); } while (0)
#define PG8_MMA(ai, bj, At, Bt) do { __builtin_amdgcn_s_setprio(1); _Pragma("unroll") for (int m = 0; m < 4; ++m) _Pragma("unroll") for (int n = 0; n < 2; ++n) _Pragma("unroll") for (int k = 0; k < 2; ++k) \
        acc[ai][bj][m][n] = __builtin_amdgcn_mfma_f32_16x16x32_bf16(Bt[n][k], At[m][k], acc[ai][bj][m][n], 0, 0, 0); __builtin_amdgcn_s_setprio(0); } while (0)
#define PG8_WAIT_V(n) asm volatile("s_waitcnt vmcnt(" #n ")" ::: "memory")
#define PG8_WAIT_L(n) asm volatile("s_waitcnt lgkmcnt(" #n ")" ::: "memory")
#define PG8_BAR __builtin_amdgcn_s_barrier()
#define PG8_SCHED __builtin_amdgcn_sched_barrier(0)
    Unit cur, nxt; int ui = 0;
    if (!S.next(0, cur)) return;
    f32x4 acc[2][2][4][2];
#pragma unroll
    for (int a = 0; a < 2; ++a)
#pragma unroll
        for (int b = 0; b < 2; ++b)
#pragma unroll
            for (int m = 0; m < 4; ++m)
#pragma unroll
                for (int n = 0; n < 2; ++n) acc[a][b][m][n] = (f32x4){0.f, 0.f, 0.f, 0.f};
    bf16x8 At[4][2], B0[2][2], B1[2][2];
    const char* cA = (const char*)g.A + (size_t)cur.pm * tstep; const char* cB = (const char*)g.Bt + (size_t)cur.pn * tstep;
    S.a_ready(cur);
    if constexpr (SP2) {
        PG8_STAGE(PG8_SB(0, 0), cB, voffB); PG8_STAGE(PG8_SB(0, 1), cB + hstep, voffB); PG8_STAGE(PG8_SA(0, 0), cA, voffA); PG8_STAGE(PG8_SA(0, 1), cA + hstep, voffA);
        if (wr == 1) PG8_BAR;
        PG8_WAIT_V(2); PG8_BAR;
        PG8_STAGE(PG8_SB(1, 0), cB + kstep, voffB); PG8_STAGE(PG8_SA(1, 0), cA + kstep, voffA); PG8_STAGE(PG8_SB(1, 1), cB + hstep + kstep, voffB);
        PG8_WAIT_V(6); PG8_BAR;
    } else {
        PG8_STAGE(PG8_SB(0, 0), cB, voffB); PG8_STAGE(PG8_SA(0, 0), cA, voffA); PG8_STAGE(PG8_SB(0, 1), cB + hstep, voffB); PG8_STAGE(PG8_SA(0, 1), cA + hstep, voffA);
        if (wr == 1) PG8_BAR;
        PG8_WAIT_V(4); PG8_BAR;
        PG8_STAGE(PG8_SB(1, 0), cB + kstep, voffB); PG8_STAGE(PG8_SA(1, 0), cA + kstep, voffA); PG8_STAGE(PG8_SB(1, 1), cB + hstep + kstep, voffB);
        PG8_WAIT_V(6); PG8_BAR;
    }
    for (;;) {
        const bool has_next = S.next(ui + 1, nxt);
        const char* nA = has_next ? (const char*)g.A + (size_t)nxt.pm * tstep : cA; const char* nB = has_next ? (const char*)g.Bt + (size_t)nxt.pn * tstep : cB;
        for (int t = 0; t < nt; t += 2) {
            const bool last = (t == nt - 2);
            const char* a1 = cA + (size_t)(t + 1) * kstep;
            const char* a2 = last ? nA : cA + (size_t)(t + 2) * kstep; const char* b2 = last ? nB : cB + (size_t)(t + 2) * kstep;
            const char* a3 = a2 + kstep; const char* b3 = b2 + kstep;
            if (last && has_next) S.a_ready(nxt);
            if constexpr (SP2) {
            PG8_LDB(B0, 0, 0); PG8_LDB(B1, 0, 1); PG8_SCHED; PG8_LDA(At, 0, 0); PG8_STAGE(PG8_SA(1, 1), a1 + hstep, voffA);
            PG8_WAIT_V(8); PG8_WAIT_L(0); PG8_BAR; PG8_MMA(0, 0, At, B0); PG8_MMA(0, 1, At, B1); PG8_BAR; PG8_SCHED;
            PG8_LDA(At, 0, 1); PG8_STAGE(PG8_SB(0, 0), b2, voffB); PG8_STAGE(PG8_SB(0, 1), b2 + hstep, voffB); PG8_STAGE(PG8_SA(0, 0), a2, voffA);
            PG8_WAIT_V(8); PG8_WAIT_L(0); PG8_BAR; PG8_MMA(1, 0, At, B0); PG8_MMA(1, 1, At, B1); PG8_BAR; PG8_SCHED;
            PG8_LDB(B0, 1, 0); PG8_LDB(B1, 1, 1); PG8_SCHED; PG8_LDA(At, 1, 0); PG8_STAGE(PG8_SA(0, 1), a2 + hstep, voffA);
            PG8_WAIT_V(8); PG8_WAIT_L(0); PG8_BAR; PG8_MMA(0, 0, At, B0); PG8_MMA(0, 1, At, B1); PG8_BAR; PG8_SCHED;
            PG8_LDA(At, 1, 1); PG8_STAGE(PG8_SB(1, 0), b3, voffB); PG8_STAGE(PG8_SB(1, 1), b3 + hstep, voffB); PG8_STAGE(PG8_SA(1, 0), a3, voffA);
            PG8_WAIT_V(8); PG8_WAIT_L(0); PG8_BAR; PG8_MMA(1, 0, At, B0); PG8_MMA(1, 1, At, B1); PG8_BAR; PG8_SCHED;
            } else {
            PG8_LDB(B0, 0, 0); PG8_SCHED; PG8_LDA(At, 0, 0); PG8_STAGE(PG8_SA(1, 1), a1 + hstep, voffA);
            PG8_WAIT_L(8); PG8_BAR; PG8_WAIT_L(0); PG8_MMA(0, 0, At, B0); PG8_BAR; PG8_SCHED;
            PG8_LDB(B1, 0, 1); PG8_STAGE(PG8_SB(0, 0), b2, voffB);
            PG8_BAR; PG8_WAIT_L(0); PG8_MMA(0, 1, At, B1); PG8_BAR;
            PG8_LDA(At, 0, 1); PG8_STAGE(PG8_SA(0, 0), a2, voffA);
            PG8_BAR; PG8_WAIT_L(0); PG8_MMA(1, 0, At, B0); PG8_BAR; PG8_SCHED;
            PG8_STAGE(PG8_SB(0, 1), b2 + hstep, voffB);
            PG8_WAIT_V(6); PG8_BAR; PG8_MMA(1, 1, At, B1); PG8_BAR;
            PG8_LDB(B0, 1, 0); PG8_SCHED; PG8_LDA(At, 1, 0); PG8_STAGE(PG8_SA(0, 1), a2 + hstep, voffA);
            PG8_WAIT_L(8); PG8_BAR; PG8_WAIT_L(0); PG8_MMA(0, 0, At, B0); PG8_BAR; PG8_SCHED;
            PG8_LDB(B1, 1, 1); PG8_STAGE(PG8_SB(1, 0), b3, voffB);
            PG8_BAR; PG8_WAIT_L(0); PG8_MMA(0, 1, At, B1); PG8_BAR;
            PG8_LDA(At, 1, 1); PG8_STAGE(PG8_SA(1, 0), a3, voffA);
            PG8_BAR; PG8_WAIT_L(0); PG8_MMA(1, 0, At, B0); PG8_BAR; PG8_SCHED;
            PG8_STAGE(PG8_SB(1, 1), b3 + hstep, voffB);
            PG8_WAIT_V(6); PG8_BAR; PG8_MMA(1, 1, At, B1); PG8_BAR;
            }
        }
        if constexpr (ALIGN_EPI) { if (wr == 0) PG8_BAR; }
        if constexpr (!Epi::AFTER_DRAIN) { E(acc, cur, wr, wc, fr, fq); S.done(cur); }
        if (!has_next) break;
#pragma unroll
        for (int a = 0; a < 2; ++a)
#pragma unroll
            for (int b = 0; b < 2; ++b)
#pragma unroll
                for (int m = 0; m < 4; ++m)
#pragma unroll
                    for (int n = 0; n < 2; ++n) acc[a][b][m][n] = (f32x4){0.f, 0.f, 0.f, 0.f};
        cur = nxt; cA = nA; cB = nB; ++ui;
        if constexpr (ALIGN_EPI) { if (wr == 1) PG8_BAR; }
    }
    PG8_WAIT_V(0);
    if constexpr (!ALIGN_EPI) { if (wr == 0) PG8_BAR; }
    PG8_BAR;
    if constexpr (Epi::AFTER_DRAIN) { E.fused(acc, cur, wr, wc, fr, fq, lds, wid, lane); S.done(cur); }
#undef PG8_SA
#undef PG8_SB
#undef PG8_STAGE
#undef PG8_LDA
#undef PG8_LDB
#undef PG8_MMA
#undef PG8_WAIT_V
#undef PG8_WAIT_L
#undef PG8_BAR
#undef PG8_SCHED
}
}

namespace fx {
#define XB_TMO      128
#define XB_XCNT(j)  (256  + 64 * (j))
#define XB_XSUB(j)  (1280 + 64 * (j))
#define XB_XGEN(j)  (2304 + 64 * (j))
#define XB_TOP      3328
#define XB_TOPGEN   3392
#define XCD_BAR_WORDS 3456
#define XB_SPIN_CAP (1u << 18)

__device__ __forceinline__ unsigned xb_ld(unsigned* p)              { return __hip_atomic_load(p, __ATOMIC_RELAXED, __HIP_MEMORY_SCOPE_AGENT); }
__device__ __forceinline__ unsigned xb_add(unsigned* p, unsigned v) { return __hip_atomic_fetch_add(p, v, __ATOMIC_RELAXED, __HIP_MEMORY_SCOPE_AGENT); }
__device__ __forceinline__ unsigned xb_xcc_id() { return (unsigned)__builtin_amdgcn_s_getreg((3 << 11) | 20) & 0xFu; }
#define XB_SPIN(cond, bar) do { unsigned _sp = 0; while (cond) { __builtin_amdgcn_s_sleep(1); \
    if ((++_sp & 255u) == 0u) { if (xb_ld(&(bar)[XB_TMO])) break; if (_sp > XB_SPIN_CAP) { atomicAdd(&(bar)[XB_TMO], 1u); break; } } } } while (0)

struct XcdBarrier {
    unsigned* bar; unsigned x;
    volatile LAS unsigned* st;
};

__device__ __forceinline__ XcdBarrier xcd_barrier_post(unsigned* bar, volatile LAS unsigned* st) {
    XcdBarrier b; b.bar = bar; b.x = xb_xcc_id(); b.st = st;
    if (threadIdx.x == 0) (void)xb_add(&bar[XB_XCNT(b.x)], 1u);
    return b;
}
__device__ __forceinline__ void xcd_barrier_complete(unsigned* bar, unsigned x, unsigned& nloc, unsigned& nx) {
    const unsigned G = gridDim.x * gridDim.y * gridDim.z;
    unsigned sum, cnt, mine, sp = 0u;
    for (;;) {
        sum = 0u; cnt = 0u; mine = 0u;
#pragma unroll
        for (unsigned j = 0; j < 16; ++j) { const unsigned c = xb_ld(&bar[XB_XCNT(j)]); sum += c; cnt += (c > 0u) ? 1u : 0u; mine = (j == x) ? c : mine; }
        if (sum == G) break;
        __builtin_amdgcn_s_sleep(1);
        if ((++sp & 255u) == 0u) { if (xb_ld(&bar[XB_TMO])) break; if (sp > XB_SPIN_CAP) { atomicAdd(&bar[XB_TMO], 1u); break; } }
    }
    nloc = mine > 0u ? mine : 1u; nx = cnt > 0u ? cnt : 1u;
}

__device__ __forceinline__ void xcd_barrier(const XcdBarrier& b) {
    asm volatile("s_waitcnt vmcnt(0)" ::: "memory");
    __syncthreads();
    if (threadIdx.x == 0) {
        unsigned* bar = b.bar;
        __builtin_amdgcn_s_waitcnt(0);
        unsigned nloc = b.st[0], nx = b.st[1];
        if (nloc == 0u) { xcd_barrier_complete(bar, b.x, nloc, nx); b.st[0] = nloc; b.st[1] = nx; }
        const unsigned old = xb_add(&bar[XB_XSUB(b.x)], 1u);
        const unsigned gen = old / nloc;
        if (old + 1u == (gen + 1u) * nloc) {
            __builtin_amdgcn_fence(__ATOMIC_RELEASE, "agent");
            asm volatile("s_waitcnt vmcnt(0)" ::: "memory");
            const unsigned og = xb_add(&bar[XB_TOP], 1u);
            const unsigned tg = og / nx;
            if (og + 1u == (tg + 1u) * nx) xb_add(&bar[XB_TOPGEN], 1u);
            else XB_SPIN(xb_ld(&bar[XB_TOPGEN]) == tg, bar);
            __builtin_amdgcn_fence(__ATOMIC_ACQUIRE, "agent");
            xb_add(&bar[XB_XGEN(b.x)], 1u);
            asm volatile("s_waitcnt vmcnt(0)" ::: "memory");
        } else {
            XB_SPIN(xb_ld(&bar[XB_XGEN(b.x)]) == gen, bar);
            __builtin_amdgcn_fence(__ATOMIC_ACQUIRE, "agent");
            asm volatile("s_waitcnt vmcnt(0)" ::: "memory");
        }
    }
    __syncthreads();
}

struct Args { const float* in[25]; float* out; unsigned char* ws; int ph_lo, ph_hi; };
struct Ctx { LAS unsigned char* lds; int tid, lane, wave, G, bid; };

DI void transpose_item(const float* W, int ldw, int K, int N, bf16* WT, LAS float* scr, int item, int lane) {
    const int nblk = N / 32, kb = item / nblk, nb = item % nblk, k0 = 64 * kb, n0 = 32 * nb;
#pragma unroll 8
    for (int i = 0; i < 32; ++i) { const int kk = 2 * i + (lane >> 5); scr[kk * 33 + (lane & 31)] = W[(size_t)(k0 + kk) * ldw + n0 + (lane & 31)]; }
    LDS_WAIT();
    const int c = lane & 7;
#pragma unroll
    for (int j = 0; j < 4; ++j) { const int n = (lane >> 3) + 8 * j; const LAS float* s = scr + (8 * c) * 33 + n;
        u32x4 o; o.x = pk2(s[0 * 33], s[1 * 33]); o.y = pk2(s[2 * 33], s[3 * 33]); o.z = pk2(s[4 * 33], s[5 * 33]); o.w = pk2(s[6 * 33], s[7 * 33]);
        *(u32x4*)(WT + (size_t)(n0 + n) * K + k0 + 8 * c) = o; }
    LDS_WAIT();
}
DI void convert_weights(const Args& A, const Ctx& C, int l) {
    LAS float* scr = (LAS float*)(C.lds + C.wave * 16384);
    const int gw = C.bid * NWAVES + C.wave, NGW = C.G * NWAVES;
    constexpr int I_IN = (DM / 64) * (DIN / 32), I_OUT = (DMIX / 64) * (DM / 32), I_G = 2 * 8 * 2;
    bf16* WinT = (bf16*)(A.ws + WS_WINT); bf16* WoutT = (bf16*)(A.ws + WS_WOUTT); bf16* GW = (bf16*)(A.ws + WS_GATEW);
    for (int it = gw; it < I_IN + I_OUT + I_G; it += NGW) {
        int r = it;
        if (r < I_IN) { transpose_item(A.in[8] + (size_t)l * DM * DINX, DINX, DM, DIN, WinT, scr, r, C.lane); continue; } r -= I_IN;
        if (r < I_OUT) { transpose_item(A.in[22] + (size_t)l * DMIX * DM, DM, DMIX, DM, WoutT, scr, r, C.lane); continue; } r -= I_OUT;
        const int gate = r / 16, n = (r % 16) / 2, sub = r % 2;
        transpose_item(A.in[gate ? 13 : 11] + ((size_t)l * 8 + n) * 4096, 64, 64, 64, GW + (size_t)(gate * 8 + n) * 4096, scr, sub, C.lane);
    }
}
DI void build_rope_table(const Args& A, const Ctx& C) {
    f32x2* TAB = (f32x2*)(A.ws + WS_TAB);
    for (int e = C.bid * NTHR + C.tid; e < 2065 * 64; e += C.G * NTHR) {
        const int p = e >> 6, i = e & 63; const float pos = p < 2064 ? (float)p : 16384.f;
        const float inv = exp2f(-(float)i * (13.287712379549449f / 64.f));
        const float ang = pos * inv;
        const double rev = (double)ang * 0.15915494309189535; const double fr = rev - rint(rev);
        const float r = (float)(fr * 6.283185307179586);
        TAB[e] = (f32x2){__cosf(r), __sinf(r)};
    }
}
DI void row_pass(const Args& A, const Ctx& C, int lnext) {
    const int gw = C.bid * NWAVES + C.wave, NGW = C.G * NWAVES, lane = C.lane;
    float* XF = (float*)(A.ws + WS_XF); bf16* XB = (bf16*)(A.ws + WS_XB); float* GAB = (float*)(A.ws + WS_GAB);
    for (int m = gw; m < M; m += NGW) {
        f32x4 v[4];
        if (lnext == 0) {
            const float* src;
            if (m < MP) { const int b = m / TP, t = m % TP; src = t < 16 ? A.in[7] + (size_t)t * DM : A.in[0] + ((size_t)b * 2048 + (t - 16)) * DM; }
            else src = A.in[1] + (size_t)(m - MP) * DM;
#pragma unroll
            for (int j = 0; j < 4; ++j) v[j] = *(const f32x4*)(src + 4 * lane + 256 * j);
        } else {
            const float* src = XF + (size_t)m * DM; float s = 0.f;
#pragma unroll
            for (int j = 0; j < 4; ++j) { v[j] = *(const f32x4*)(src + 4 * lane + 256 * j); s += (v[j][0] + v[j][1]) + (v[j][2] + v[j][3]); }
            const float mean = wave_sum(s) * (1.f / DM); float q = 0.f;
#pragma unroll
            for (int j = 0; j < 4; ++j) { v[j] = v[j] - mean; q += (v[j][0] * v[j][0] + v[j][1] * v[j][1]) + (v[j][2] * v[j][2] + v[j][3] * v[j][3]); }
            const float rstd = rsqrtf(wave_sum(q) * (1.f / DM) + EPS);
            const float* lw = A.in[23] + (size_t)(lnext - 1) * DM; const float* lb = A.in[24] + (size_t)(lnext - 1) * DM;
#pragma unroll
            for (int j = 0; j < 4; ++j) { const f32x4 w = *(const f32x4*)(lw + 4 * lane + 256 * j), b = *(const f32x4*)(lb + 4 * lane + 256 * j); v[j] = v[j] * rstd * w + b; }
        }
        if (lnext < DEPTH) {
#pragma unroll
            for (int j = 0; j < 4; ++j) { *(f32x4*)(XF + (size_t)m * DM + 4 * lane + 256 * j) = v[j]; *(u32x2*)(XB + (size_t)m * DM + 4 * lane + 256 * j) = pack4(v[j]); }
            const float* wg = A.in[8] + (size_t)lnext * DM * DINX + DIN;
            float acc[8];
#pragma unroll
            for (int q = 0; q < 8; ++q) acc[q] = 0.f;
#pragma unroll
            for (int j = 0; j < 4; ++j)
#pragma unroll
                for (int e = 0; e < 4; ++e) { const int k = 4 * lane + 256 * j + e; const f32x4 w0 = *(const f32x4*)(wg + (size_t)k * DINX), w1 = *(const f32x4*)(wg + (size_t)k * DINX + 4);
                    const float x = v[j][e];
                    acc[0] = fmaf(x, w0[0], acc[0]); acc[1] = fmaf(x, w0[1], acc[1]); acc[2] = fmaf(x, w0[2], acc[2]); acc[3] = fmaf(x, w0[3], acc[3]);
                    acc[4] = fmaf(x, w1[0], acc[4]); acc[5] = fmaf(x, w1[1], acc[5]); acc[6] = fmaf(x, w1[2], acc[6]); acc[7] = fmaf(x, w1[3], acc[7]); }
#pragma unroll
            for (int q = 0; q < 8; ++q) acc[q] = wave_sum(acc[q]);
            if (lane == 0) { *(f32x4*)(GAB + (size_t)m * 8) = (f32x4){acc[0], acc[1], acc[2], acc[3]}; *(f32x4*)(GAB + (size_t)m * 8 + 4) = (f32x4){acc[4], acc[5], acc[6], acc[7]}; }
        } else {
            float* dst;
            if (m < MP) { const int b = m / TP, t = m % TP; if (t < 16) continue; dst = A.out + O_YP + ((size_t)b * 2048 + (t - 16)) * DM; }
            else dst = A.out + O_YS + (size_t)(m - MP) * DM;
#pragma unroll
            for (int j = 0; j < 4; ++j) *(f32x4*)(dst + 4 * lane + 256 * j) = v[j];
        }
    }
}

DI void transpose_out(const LAS bf16* T, bf16* outT, int lane) {
#pragma unroll 1
    for (int p = 0; p < 2; ++p) { const int d = lane + 64 * p;
#pragma unroll 2
        for (int i8 = 0; i8 < 8; ++i8) { u32x4 w;
            w.x = (unsigned)T[(i8 * 8 + 0) * 128 + d] | ((unsigned)T[(i8 * 8 + 1) * 128 + d] << 16);
            w.y = (unsigned)T[(i8 * 8 + 2) * 128 + d] | ((unsigned)T[(i8 * 8 + 3) * 128 + d] << 16);
            w.z = (unsigned)T[(i8 * 8 + 4) * 128 + d] | ((unsigned)T[(i8 * 8 + 5) * 128 + d] << 16);
            w.w = (unsigned)T[(i8 * 8 + 6) * 128 + d] | ((unsigned)T[(i8 * 8 + 7) * 128 + d] << 16);
            *(u32x4*)(outT + d * 64 + i8 * 8) = w; } }
}

DI void p2_gdn_item(const Args& A, const Ctx& C, LAS unsigned char* pl, int l, int item) {
    const int lane = C.lane, fr = lane & 15, fq = lane >> 4;
    const int CH = item, h = item & 3, bc = item >> 2, c = bc % NCH, b = bc / NCH;
    const int t0 = 64 * c - 48; const size_t mrow0 = (size_t)b * TP;
    bf16* U = (bf16*)(A.ws + WS_U); const float* GAB = (const float*)(A.ws + WS_GAB);
    LAS float* Amat = (LAS float*)pl; LAS bf16* T = (LAS bf16*)pl; LAS float* scb = (LAS float*)(pl + 17408);
    bf16* QH = (bf16*)(A.ws + S_QH) + (size_t)CH * 8192; bf16* KH = (bf16*)(A.ws + S_KH) + (size_t)CH * 8192; bf16* RWT = (bf16*)(A.ws + S_RWT) + (size_t)CH * 8192;
    bf16* Wg = (bf16*)(A.ws + G_W) + (size_t)CH * 8192; bf16* QG = (bf16*)(A.ws + G_QG) + (size_t)CH * 8192; bf16* KDT = (bf16*)(A.ws + G_KDT) + (size_t)CH * 8192;
    bf16* UT = (bf16*)(A.ws + G_UT) + (size_t)CH * 8192; bf16* ATT = (bf16*)(A.ws + G_ATT) + (size_t)CH * 4096; float* EGL = (float*)(A.ws + WS_EGL);
    {
        const int t = t0 + lane; float g = 0.f, beta = 0.f;
        if (t >= 0) { const float* gp = GAB + (mrow0 + t) * 8; g = -__expf(A.in[19][l * 4 + h]) * softplusf_(gp[h] + A.in[20][l * 4 + h]); beta = sigmoidf_(gp[4 + h]); }
        float gc = g;
#pragma unroll
        for (int off = 1; off < 64; off <<= 1) { const float nb = __shfl_up(gc, off); if (lane >= off) gc += nb; }
        scb[lane] = beta; scb[64 + lane] = gc;
        const float gl = __shfl(gc, 63);
        if (lane == 0) EGL[CH] = __expf(gl);
    }
    LDS_WAIT();
    const float g_last = scb[64 + 63];
    const int tok4 = lane >> 4, grp = lane & 15;
#pragma unroll 1
    for (int part = 0; part < 3; ++part) {
        const int chb = part * 512 + h * 128 + grp * 8;
        const float* cw = A.in[18] + (size_t)l * 4 * 1536 + chb;
        float wgt[4][8];
#pragma unroll
        for (int j = 0; j < 4; ++j) { const f32x4 a = *(const f32x4*)(cw + j * 1536), bq = *(const f32x4*)(cw + j * 1536 + 4);
            wgt[j][0] = a[0]; wgt[j][1] = a[1]; wgt[j][2] = a[2]; wgt[j][3] = a[3]; wgt[j][4] = bq[0]; wgt[j][5] = bq[1]; wgt[j][6] = bq[2]; wgt[j][7] = bq[3]; }
#pragma unroll 1
        for (int it = 0; it < 16; ++it) {
            const int i = it * 4 + tok4, t = t0 + i;
            float y[8], x3[8];
#pragma unroll
            for (int e = 0; e < 8; ++e) { y[e] = 0.f; x3[e] = 0.f; }
#pragma unroll
            for (int j = 0; j < 4; ++j) { const int tt = t - 3 + j;
                if (tt >= 0) { const u32x4 raw = *(const u32x4*)(U + (mrow0 + tt) * DIN + 3072 + chb); float x[8]; unpack8(raw, x);
#pragma unroll
                    for (int e = 0; e < 8; ++e) { y[e] = fmaf(wgt[j][e], x[e], y[e]); if (j == 3) x3[e] = x[e]; } } }
            if (c == NCH - 1 && i >= 61) { float* o = A.out + O_GCP + ((size_t)(l * NB + b) * 3 + (i - 61)) * 1536 + chb;
                *(f32x4*)o = (f32x4){x3[0], x3[1], x3[2], x3[3]}; *(f32x4*)(o + 4) = (f32x4){x3[4], x3[5], x3[6], x3[7]}; }
#pragma unroll
            for (int e = 0; e < 8; ++e) y[e] = siluf_(y[e]);
            const float beta_i = scb[i], gc_i = scb[64 + i];
            if (part < 2) {
                float ss = 0.f;
#pragma unroll
                for (int e = 0; e < 8; ++e) ss = fmaf(y[e], y[e], ss);
                ss += __shfl_xor(ss, 1); ss += __shfl_xor(ss, 2); ss += __shfl_xor(ss, 4); ss += __shfl_xor(ss, 8);
                const float rn = rsqrtf(ss + EPS) * (part == 0 ? QSCALE : 1.f);
#pragma unroll
                for (int e = 0; e < 8; ++e) y[e] *= rn;
            }
            if (part == 0) {
                *(u32x4*)(QH + i * 128 + grp * 8) = pack8(y);
                const float eg = __expf(gc_i);
#pragma unroll
                for (int e = 0; e < 8; ++e) y[e] *= eg;
                *(u32x4*)(QG + i * 128 + grp * 8) = pack8(y);
            } else if (part == 1) {
                *(u32x4*)(KH + i * 128 + grp * 8) = pack8(y);
                const float s = beta_i * __expf(gc_i);
#pragma unroll
                for (int e = 0; e < 8; ++e) y[e] *= s;
                *(LAS u32x4*)(T + i * 128 + grp * 8) = pack8(y);
            } else {
#pragma unroll
                for (int e = 0; e < 8; ++e) y[e] *= beta_i;
                *(LAS u32x4*)(T + i * 128 + grp * 8) = pack8(y);
            }
        }
        if (part == 1) {
            LDS_WAIT(); transpose_out(T, RWT, lane); LDS_WAIT();
            VM_WAIT();
#pragma unroll 1
            for (int it = 0; it < 16; ++it) { const int i = it * 4 + tok4;
                const u32x4 raw = *(const u32x4*)(KH + i * 128 + grp * 8); float y[8]; unpack8(raw, y);
                const float s = __expf(g_last - scb[64 + i]);
#pragma unroll
                for (int e = 0; e < 8; ++e) y[e] *= s;
                *(LAS u32x4*)(T + i * 128 + grp * 8) = pack8(y); }
            LDS_WAIT(); transpose_out(T, KDT, lane); LDS_WAIT();
        }
        if (part == 2) { LDS_WAIT(); transpose_out(T, UT, lane); LDS_WAIT(); }
    }
    VM_WAIT();
    bf16x8 kf[4][4];
#pragma unroll
    for (int rb = 0; rb < 4; ++rb)
#pragma unroll
        for (int kc = 0; kc < 4; ++kc) kf[rb][kc] = *(const bf16x8*)(KH + (rb * 16 + fr) * 128 + kc * 32 + 8 * fq);
#pragma unroll
    for (int jb = 0; jb < 4; ++jb) { const float gcj = scb[64 + jb * 16 + fr];
#pragma unroll
        for (int ib = jb; ib < 4; ++ib) { f32x4 acc = (f32x4){0.f, 0.f, 0.f, 0.f};
#pragma unroll
            for (int kc = 0; kc < 4; ++kc) acc = mfma16(kf[ib][kc], kf[jb][kc], acc);
#pragma unroll
            for (int r = 0; r < 4; ++r) { const int i = ib * 16 + 4 * fq + r; Amat[i * 68 + jb * 16 + fr] = acc[r] * scb[i] * __expf(fminf(scb[64 + i] - gcj, 0.f)); } } }
#pragma unroll 1
    for (int ib = 0; ib < 4; ++ib) { bf16x8 qf[4];
#pragma unroll
        for (int kc = 0; kc < 4; ++kc) qf[kc] = *(const bf16x8*)(QH + (ib * 16 + fr) * 128 + kc * 32 + 8 * fq);
        const int i = ib * 16 + fr; const float gci = scb[64 + i];
#pragma unroll
        for (int jb = 0; jb < 4; ++jb) { f32x4 val = (f32x4){0.f, 0.f, 0.f, 0.f};
            if (jb <= ib) { f32x4 acc = (f32x4){0.f, 0.f, 0.f, 0.f};
#pragma unroll
                for (int kc = 0; kc < 4; ++kc) acc = mfma16(kf[jb][kc], qf[kc], acc);
#pragma unroll
                for (int r = 0; r < 4; ++r) { const int j = jb * 16 + 4 * fq + r; val[r] = (i >= j) ? acc[r] * __expf(fminf(gci - scb[64 + j], 0.f)) : 0.f; } }
            *(u32x2*)(ATT + i * 64 + jb * 16 + 4 * fq) = pack4(val); } }
    LDS_WAIT();
    float mcol[64];
#pragma unroll
    for (int i = 0; i < 64; ++i) { float acc = (lane == i) ? 1.f : 0.f;
#pragma unroll
        for (int j = 0; j < i; ++j) acc = fmaf(-Amat[i * 68 + j], mcol[j], acc);
        mcol[i] = acc; }
    LDS_WAIT(); asm volatile("" ::: "memory");
    LAS bf16* Mb = (LAS bf16*)pl;
#pragma unroll
    for (int i = 0; i < 64; ++i) Mb[i * 136 + lane] = (bf16)f2bf(mcol[i]);
    LDS_WAIT(); asm volatile("" ::: "memory");
    bf16x8 mf[4][2];
#pragma unroll
    for (int ib = 0; ib < 4; ++ib)
#pragma unroll
        for (int k2 = 0; k2 < 2; ++k2) mf[ib][k2] = *(const LAS bf16x8*)(Mb + (ib * 16 + fr) * 136 + k2 * 32 + 8 * fq);
#pragma unroll 2
    for (int db = 0; db < 8; ++db) { bf16x8 rf[2];
#pragma unroll
        for (int k2 = 0; k2 < 2; ++k2) rf[k2] = *(const bf16x8*)(UT + (db * 16 + fr) * 64 + k2 * 32 + 8 * fq);
        f32x4 acc[4];
#pragma unroll
        for (int ib = 0; ib < 4; ++ib) { acc[ib] = (f32x4){0.f, 0.f, 0.f, 0.f};
#pragma unroll
            for (int k2 = 0; k2 < 2; ++k2) acc[ib] = mfma16(mf[ib][k2], rf[k2], acc[ib]); }
#pragma unroll
        for (int ib = 0; ib < 4; ++ib) *(u32x2*)(UT + (db * 16 + fr) * 64 + ib * 16 + 4 * fq) = pack4(acc[ib]); }
#pragma unroll 2
    for (int kb = 0; kb < 8; ++kb) { bf16x8 rf[2];
#pragma unroll
        for (int k2 = 0; k2 < 2; ++k2) rf[k2] = *(const bf16x8*)(RWT + (kb * 16 + fr) * 64 + k2 * 32 + 8 * fq);
#pragma unroll
        for (int ib = 0; ib < 4; ++ib) { f32x4 acc = (f32x4){0.f, 0.f, 0.f, 0.f};
#pragma unroll
            for (int k2 = 0; k2 < 2; ++k2) acc = mfma16(rf[k2], mf[ib][k2], acc);
            *(u32x2*)(Wg + (ib * 16 + fr) * 128 + kb * 16 + 4 * fq) = pack4(acc); } }
    LDS_WAIT();
}

DI void p2_ret_item(const Args& A, const Ctx& C, LAS unsigned char* pl, int l, int item) {
    const int lane = C.lane, fr = lane & 15, fq = lane >> 4;
    const int CH = item, h = item & 3, bc = item >> 2, c = bc % NCH, b = bc / NCH;
    const int t0 = 64 * c - 48; const size_t mrow0 = (size_t)b * TP;
    bf16* U = (bf16*)(A.ws + WS_U); LAS bf16* T = (LAS bf16*)pl; const f32x2* TAB = (const f32x2*)(A.ws + WS_TAB);
    bf16* KRT = (bf16*)(A.ws + R_KRT) + (size_t)CH * 8192; bf16* VT = (bf16*)(A.ws + R_VT) + (size_t)CH * 8192; bf16* SC = (bf16*)(A.ws + R_SC) + (size_t)CH * 4096;
    const float lg2 = log2f(1.f - exp2f(-5.f - (float)h));
    const int tok8 = lane >> 3, d0 = 8 * (lane & 7);
#pragma unroll 1
    for (int part = 0; part < 2; ++part) {
        const int colb = (part ? 1536 : 1024) + h * 128;
#pragma unroll 1
        for (int it = 0; it < 8; ++it) { const int i = it * 8 + tok8, t = t0 + i;
            float r1[8], r2[8];
#pragma unroll
            for (int e = 0; e < 8; ++e) { r1[e] = 0.f; r2[e] = 0.f; }
            if (t >= 0) { bf16* p = U + (mrow0 + t) * DIN + colb + d0;
                float lo[8], hi[8]; unpack8(*(const u32x4*)p, lo); unpack8(*(const u32x4*)(p + 64), hi);
                const f32x4* cs = (const f32x4*)(TAB + (size_t)t * 64 + d0);
                const float sc = part ? QSCALE * exp2f((float)(63 - i) * lg2) : exp2f((float)(i + 1) * lg2);
#pragma unroll
                for (int e2 = 0; e2 < 4; ++e2) { const f32x4 v = cs[e2];
                    r1[2 * e2] = (lo[2 * e2] * v[0] - hi[2 * e2] * v[1]) * sc; r2[2 * e2] = (lo[2 * e2] * v[1] + hi[2 * e2] * v[0]) * sc;
                    r1[2 * e2 + 1] = (lo[2 * e2 + 1] * v[2] - hi[2 * e2 + 1] * v[3]) * sc; r2[2 * e2 + 1] = (lo[2 * e2 + 1] * v[3] + hi[2 * e2 + 1] * v[2]) * sc; }
                *(u32x4*)p = pack8(r1); *(u32x4*)(p + 64) = pack8(r2); }
            if (part) { *(LAS u32x4*)(T + i * 128 + d0) = pack8(r1); *(LAS u32x4*)(T + i * 128 + 64 + d0) = pack8(r2); } }
        if (part) { LDS_WAIT(); transpose_out(T, KRT, lane); LDS_WAIT(); }
    }
    { const int tok4 = lane >> 4, grp = lane & 15;
#pragma unroll 1
        for (int it = 0; it < 16; ++it) { const int i = it * 4 + tok4, t = t0 + i;
            u32x4 raw = (u32x4){0u, 0u, 0u, 0u};
            if (t >= 0) raw = *(const u32x4*)(U + (mrow0 + t) * DIN + 2048 + h * 128 + grp * 8);
            *(LAS u32x4*)(T + i * 128 + grp * 8) = raw; }
        LDS_WAIT(); transpose_out(T, VT, lane); LDS_WAIT(); }
    VM_WAIT();
    const bf16x8 zf = (bf16x8){0, 0, 0, 0, 0, 0, 0, 0};
    bf16x8 kf[4][4];
#pragma unroll
    for (int rb = 0; rb < 4; ++rb) { const int t = t0 + rb * 16 + fr;
#pragma unroll
        for (int kc = 0; kc < 4; ++kc) kf[rb][kc] = t >= 0 ? *(const bf16x8*)(U + (mrow0 + t) * DIN + 1536 + h * 128 + kc * 32 + 8 * fq) : zf; }
    const float ginv = exp2f(-64.f * lg2);
#pragma unroll 1
    for (int ib = 0; ib < 4; ++ib) { bf16x8 qf[4]; const int i = ib * 16 + fr, t = t0 + i;
#pragma unroll
        for (int kc = 0; kc < 4; ++kc) qf[kc] = t >= 0 ? *(const bf16x8*)(U + (mrow0 + t) * DIN + 1024 + h * 128 + kc * 32 + 8 * fq) : zf;
#pragma unroll
        for (int jb = 0; jb < 4; ++jb) { f32x4 val = (f32x4){0.f, 0.f, 0.f, 0.f};
            if (jb <= ib) { f32x4 acc = (f32x4){0.f, 0.f, 0.f, 0.f};
#pragma unroll
                for (int kc = 0; kc < 4; ++kc) acc = mfma16(kf[jb][kc], qf[kc], acc);
#pragma unroll
                for (int r = 0; r < 4; ++r) { const int j = jb * 16 + 4 * fq + r; val[r] = (i >= j) ? acc[r] * ginv : 0.f; } }
            *(u32x2*)(SC + i * 64 + jb * 16 + 4 * fq) = pack4(val); } }
    LDS_WAIT();
}

template <bool DEC>
DI void p2_rg_item(const Args& A, const Ctx& C, LAS unsigned char* pl, int l, int bt, int c, int n) {
    const int lane = C.lane, fr = lane & 15, fq = lane >> 4;
    bf16* U = (bf16*)(A.ws + WS_U); LAS float* XR = (LAS float*)pl;
    const int t0 = DEC ? 0 : 64 * c - 48; const size_t mrow0 = DEC ? (size_t)MP + 64 * bt : (size_t)bt * TP;
    bf16x8 xf[4][2];
#pragma unroll
    for (int kc = 0; kc < 2; ++kc) { const int ch8 = n * 64 + kc * 32 + 8 * fq;
        float cw[4][8], cb[8];
#pragma unroll
        for (int j = 0; j < 4; ++j) { const float* p = A.in[9] + ((size_t)l * 4 + j) * 512 + ch8; const f32x4 a = *(const f32x4*)p, bq = *(const f32x4*)(p + 4);
            cw[j][0] = a[0]; cw[j][1] = a[1]; cw[j][2] = a[2]; cw[j][3] = a[3]; cw[j][4] = bq[0]; cw[j][5] = bq[1]; cw[j][6] = bq[2]; cw[j][7] = bq[3]; }
        { const float* p = A.in[10] + (size_t)l * 512 + ch8; const f32x4 a = *(const f32x4*)p, bq = *(const f32x4*)(p + 4);
            cb[0] = a[0]; cb[1] = a[1]; cb[2] = a[2]; cb[3] = a[3]; cb[4] = bq[0]; cb[5] = bq[1]; cb[6] = bq[2]; cb[7] = bq[3]; }
#pragma unroll
        for (int tb = 0; tb < 4; ++tb) { const int i = tb * 16 + fr;
            float xr[8];
#pragma unroll
            for (int e = 0; e < 8; ++e) xr[e] = cb[e];
            if (!DEC) { const int t = t0 + i; float x3[8];
#pragma unroll
                for (int e = 0; e < 8; ++e) x3[e] = 0.f;
#pragma unroll
                for (int j = 0; j < 4; ++j) { const int tt = t - 3 + j;
                    if (tt >= 0) { float x[8]; unpack8(*(const u32x4*)(U + (mrow0 + tt) * DIN + ch8), x);
#pragma unroll
                        for (int e = 0; e < 8; ++e) { xr[e] = fmaf(cw[j][e], x[e], xr[e]); if (j == 3) x3[e] = x[e]; } } }
                if (c == NCH - 1 && i >= 61) { float* o = A.out + O_CP + ((size_t)(l * NB + bt) * 3 + (i - 61)) * 512 + ch8;
                    *(f32x4*)o = (f32x4){x3[0], x3[1], x3[2], x3[3]}; *(f32x4*)(o + 4) = (f32x4){x3[4], x3[5], x3[6], x3[7]}; }
            } else { const int s = 64 * bt + i; const float* cv = A.in[3] + ((size_t)(l * NS + s) * 3) * 512 + ch8; float* oc = A.out + O_CS + ((size_t)(l * NS + s) * 3) * 512 + ch8;
                float x[8];
#pragma unroll
                for (int j = 0; j < 3; ++j) { const f32x4 a = *(const f32x4*)(cv + j * 512), bq = *(const f32x4*)(cv + j * 512 + 4);
                    x[0] = a[0]; x[1] = a[1]; x[2] = a[2]; x[3] = a[3]; x[4] = bq[0]; x[5] = bq[1]; x[6] = bq[2]; x[7] = bq[3];
#pragma unroll
                    for (int e = 0; e < 8; ++e) xr[e] = fmaf(cw[j][e], x[e], xr[e]);
                    if (j >= 1) { *(f32x4*)(oc + (j - 1) * 512) = a; *(f32x4*)(oc + (j - 1) * 512 + 4) = bq; } }
                unpack8(*(const u32x4*)(U + (mrow0 + i) * DIN + ch8), x);
#pragma unroll
                for (int e = 0; e < 8; ++e) xr[e] = fmaf(cw[3][e], x[e], xr[e]);
                *(f32x4*)(oc + 2 * 512) = (f32x4){x[0], x[1], x[2], x[3]}; *(f32x4*)(oc + 2 * 512 + 4) = (f32x4){x[4], x[5], x[6], x[7]};
            }
            *(LAS f32x4*)(XR + i * 68 + kc * 32 + 8 * fq) = (f32x4){xr[0], xr[1], xr[2], xr[3]};
            *(LAS f32x4*)(XR + i * 68 + kc * 32 + 8 * fq + 4) = (f32x4){xr[4], xr[5], xr[6], xr[7]};
            xf[tb][kc] = __builtin_bit_cast(bf16x8, pack8(xr)); } }
    LDS_WAIT();
    const bf16* GW = (const bf16*)(A.ws + WS_GATEW);
    bf16* MIX = (bf16*)(A.ws + WS_MIX); bf16* BETA = (bf16*)(A.ws + WS_BETA);
#pragma unroll 1
    for (int db = 0; db < 4; ++db) {
        bf16x8 waf[2], wxf[2];
#pragma unroll
        for (int kc = 0; kc < 2; ++kc) { waf[kc] = *(const bf16x8*)(GW + (size_t)(0 * 8 + n) * 4096 + (db * 16 + fr) * 64 + kc * 32 + 8 * fq);
                                         wxf[kc] = *(const bf16x8*)(GW + (size_t)(1 * 8 + n) * 4096 + (db * 16 + fr) * 64 + kc * 32 + 8 * fq); }
        const int chl = db * 16 + 4 * fq, ch0 = n * 64 + chl;
        const f32x4 ba4 = *(const f32x4*)(A.in[12] + (size_t)l * 512 + ch0), bx4 = *(const f32x4*)(A.in[14] + (size_t)l * 512 + ch0), lam4 = *(const f32x4*)(A.in[15] + (size_t)l * 512 + ch0);
        f32x4 sp4;
#pragma unroll
        for (int r = 0; r < 4; ++r) sp4[r] = softplusf_(-lam4[r]);
        float Ac[4], Hc[4];
#pragma unroll
        for (int r = 0; r < 4; ++r) { Ac[r] = 1.f; Hc[r] = 0.f; }
#pragma unroll
        for (int tb = 0; tb < 4; ++tb) { const int i = tb * 16 + fr; const int t = t0 + i; const bool valid = DEC || t >= 0; const size_t row = mrow0 + (DEC ? i : (t >= 0 ? t : 0));
            f32x4 aa = (f32x4){0.f, 0.f, 0.f, 0.f}, ax = aa;
#pragma unroll
            for (int kc = 0; kc < 2; ++kc) { aa = mfma16(waf[kc], xf[tb][kc], aa); ax = mfma16(wxf[kc], xf[tb][kc], ax); }
            const f32x4 xr4 = *(const LAS f32x4*)(XR + i * 68 + chl);
            const f32x4 z4 = unpack4(*(const u32x2*)(U + row * DIN + 512 + ch0));
            f32x4 av, uv, sz;
#pragma unroll
            for (int r = 0; r < 4; ++r) { const float rg = sigmoidf_(aa[r] + ba4[r]), ig = sigmoidf_(ax[r] + bx4[r]);
                const float la = -8.f * rg * sp4[r];
                av[r] = __expf(la); uv[r] = sqrtf(fmaxf(-expm1f(2.f * la), 0.f)) * ig * xr4[r]; sz[r] = siluf_(z4[r]); }
            if (DEC) { const int s = 64 * bt + i;
                const f32x4 h0 = *(const f32x4*)(A.in[2] + (size_t)(l * NS + s) * 512 + ch0);
                const f32x4 hv = av * h0 + uv;
                *(f32x4*)(A.out + O_HS + (size_t)(l * NS + s) * 512 + ch0) = hv;
                *(u32x2*)(MIX + row * DMIX + ch0) = pack4(hv * sz);
            } else {
                f32x4 al, be;
#pragma unroll
                for (int r = 0; r < 4; ++r) { float a = valid ? av[r] : 1.f, u = valid ? uv[r] : 0.f;
#pragma unroll
                    for (int off = 1; off < 16; off <<= 1) { const float pa = __shfl_up(a, off, 16), pu = __shfl_up(u, off, 16); if (fr >= off) { u = fmaf(a, pu, u); a = pa * a; } }
                    const float P = Ac[r] * a, hl = fmaf(a, Hc[r], u);
                    al[r] = hl * sz[r]; be[r] = P * sz[r];
                    Ac[r] = __shfl(P, 15, 16); Hc[r] = __shfl(hl, 15, 16); }
                if (valid) { *(u32x2*)(U + row * DIN + 512 + ch0) = pack4(al); *(u32x2*)(BETA + ((size_t)bt * TP + t) * 512 + ch0) = pack4(be); }
            } }
        if (!DEC && fr == 15) { f32x2* RGS = (f32x2*)(A.ws + WS_RGS) + ((size_t)bt * NCH + c) * 512 + n * 64 + chl;
#pragma unroll
            for (int r = 0; r < 4; ++r) RGS[r] = (f32x2){Ac[r], Hc[r]}; }
    }
    LDS_WAIT();
}

DI void phase_p2(const Args& A, const Ctx& C, int l) {
    LAS unsigned char* pl = C.lds + C.wave * PRIV_BYTES;
    const int slot = C.wave * C.G + C.bid, NSLOT = C.G * NWAVES;
    if (NSLOT <= NCHH) return;
    if (slot < NCHH) { p2_gdn_item(A, C, pl, l, slot); return; }
    const int NL = NSLOT - NCHH, NRG = NB * NCH * 8;
    for (int it = slot - NCHH; it < NRG + NCHH + 16; it += NL) {
        if (it < NRG) { const int n = it & 7, bc = it >> 3; p2_rg_item<false>(A, C, pl, l, bc / NCH, bc % NCH, n); }
        else if (it < NRG + NCHH) p2_ret_item(A, C, pl, l, it - NRG);
        else { const int r = it - NRG - NCHH; p2_rg_item<true>(A, C, pl, l, r >> 3, 0, r & 7); }
    }
}

constexpr int CL_A = 0;
constexpr int CL_B = 17408;
constexpr int CL_KT = 34816;
constexpr int CL_AT = 53248;
constexpr int CL_PRIV = 62464;
constexpr int CL_PRIV_BYTES = 6656;
static_assert(CL_PRIV + 8 * CL_PRIV_BYTES <= MISC_OFF, "chain LDS map");

DI void p3_gdn_chain(const Args& A, const Ctx& C, int l, int b, int h) {
    const int tid = C.tid, lane = C.lane, fr = lane & 15, fq = lane >> 4, vb = C.wave;
    LAS unsigned char* L = C.lds;
    LAS bf16* Wb = (LAS bf16*)(L + CL_A); LAS bf16* QGb = (LAS bf16*)(L + CL_B); LAS bf16* KTb = (LAS bf16*)(L + CL_KT); LAS bf16* ATb = (LAS bf16*)(L + CL_AT);
    LAS bf16* ST = (LAS bf16*)(L + CL_PRIV + vb * CL_PRIV_BYTES); LAS bf16* VNT = ST + 16 * 136;
    bf16* U = (bf16*)(A.ws + WS_U); const size_t mrow0 = (size_t)b * TP;
    const bf16* gW = (const bf16*)(A.ws + G_W); const bf16* gQG = (const bf16*)(A.ws + G_QG); const bf16* gKDT = (const bf16*)(A.ws + G_KDT);
    const bf16* gUT = (const bf16*)(A.ws + G_UT); const bf16* gATT = (const bf16*)(A.ws + G_ATT); const float* EGL = (const float*)(A.ws + WS_EGL);
    for (int e = lane; e < 16 * 136 / 2; e += 64) ((LAS unsigned*)ST)[e] = 0u;
    f32x4 Sacc[8];
#pragma unroll
    for (int kb = 0; kb < 8; ++kb) Sacc[kb] = (f32x4){0.f, 0.f, 0.f, 0.f};
    u32x4 R[7]; u32x2 ur[4]; float eglr;
    const int r16 = tid >> 4, c16 = tid & 15, r8 = tid >> 3, c8 = tid & 7;
#define GDN_PREFETCH(CH_) do { const size_t ch_ = (size_t)(CH_); \
        R[0] = *(const u32x4*)(gW + ch_ * 8192 + (size_t)tid * 8); R[1] = *(const u32x4*)(gW + ch_ * 8192 + (size_t)(tid + 512) * 8); \
        R[2] = *(const u32x4*)(gQG + ch_ * 8192 + (size_t)tid * 8); R[3] = *(const u32x4*)(gQG + ch_ * 8192 + (size_t)(tid + 512) * 8); \
        R[4] = *(const u32x4*)(gKDT + ch_ * 8192 + (size_t)tid * 8); R[5] = *(const u32x4*)(gKDT + ch_ * 8192 + (size_t)(tid + 512) * 8); \
        R[6] = *(const u32x4*)(gATT + ch_ * 4096 + (size_t)tid * 8); \
        _Pragma("unroll") for (int tb_ = 0; tb_ < 4; ++tb_) ur[tb_] = *(const u32x2*)(gUT + ch_ * 8192 + (vb * 16 + fr) * 64 + tb_ * 16 + 4 * fq); \
        eglr = EGL[ch_]; } while (0)
    GDN_PREFETCH(((size_t)b * NCH + 0) * 4 + h);
#pragma unroll 1
    for (int c = 0; c < NCH; ++c) {
        __syncthreads();
        *(LAS u32x4*)(Wb + r16 * 136 + c16 * 8) = R[0];        *(LAS u32x4*)(Wb + (r16 + 32) * 136 + c16 * 8) = R[1];
        *(LAS u32x4*)(QGb + r16 * 136 + c16 * 8) = R[2];       *(LAS u32x4*)(QGb + (r16 + 32) * 136 + c16 * 8) = R[3];
        *(LAS u32x4*)(KTb + r8 * 72 + c8 * 8) = R[4];          *(LAS u32x4*)(KTb + (r8 + 64) * 72 + c8 * 8) = R[5];
        *(LAS u32x4*)(ATb + r8 * 72 + c8 * 8) = R[6];
        f32x4 uv[4];
#pragma unroll
        for (int tb = 0; tb < 4; ++tb) uv[tb] = unpack4(ur[tb]);
        const float egl = eglr;
        __syncthreads();
        if (c + 1 < NCH) GDN_PREFETCH(((size_t)b * NCH + c + 1) * 4 + h);
        bf16x8 sf[4];
#pragma unroll
        for (int kc = 0; kc < 4; ++kc) sf[kc] = *(const LAS bf16x8*)(ST + fr * 136 + kc * 32 + 8 * fq);
        f32x4 o[4];
#pragma unroll
        for (int tb = 0; tb < 4; ++tb) { f32x4 aw = (f32x4){0.f, 0.f, 0.f, 0.f}, aq = aw;
#pragma unroll
            for (int kc = 0; kc < 4; ++kc) { aw = mfma16(*(const LAS bf16x8*)(Wb + (tb * 16 + fr) * 136 + kc * 32 + 8 * fq), sf[kc], aw);
                                             aq = mfma16(*(const LAS bf16x8*)(QGb + (tb * 16 + fr) * 136 + kc * 32 + 8 * fq), sf[kc], aq); }
            const f32x4 vn = uv[tb] - aw; o[tb] = aq;
            *(LAS u32x2*)(VNT + fr * 72 + tb * 16 + 4 * fq) = pack4(vn); }
        LDS_WAIT();
        bf16x8 vf[2];
#pragma unroll
        for (int k2 = 0; k2 < 2; ++k2) vf[k2] = *(const LAS bf16x8*)(VNT + fr * 72 + k2 * 32 + 8 * fq);
#pragma unroll
        for (int tb = 0; tb < 4; ++tb)
#pragma unroll
            for (int k2 = 0; k2 < 2; ++k2) o[tb] = mfma16(*(const LAS bf16x8*)(ATb + (tb * 16 + fr) * 72 + k2 * 32 + 8 * fq), vf[k2], o[tb]);
#pragma unroll
        for (int kb = 0; kb < 8; ++kb) { f32x4 s = Sacc[kb] * egl;
#pragma unroll
            for (int k2 = 0; k2 < 2; ++k2) s = mfma16(*(const LAS bf16x8*)(KTb + (kb * 16 + fr) * 72 + k2 * 32 + 8 * fq), vf[k2], s);
            Sacc[kb] = s;
            *(LAS u32x2*)(ST + fr * 136 + kb * 16 + 4 * fq) = pack4(s); }
        const int t0 = 64 * c - 48;
#pragma unroll
        for (int tb = 0; tb < 4; ++tb)
#pragma unroll
            for (int r = 0; r < 4; ++r) { const int t = t0 + tb * 16 + 4 * fq + r; if (t >= 0) U[(mrow0 + t) * DIN + 4096 + h * 128 + vb * 16 + fr] = (bf16)f2bf(o[tb][r]); }
        LDS_WAIT();
    }
#undef GDN_PREFETCH
    { float* so = A.out + O_GP + ((size_t)(l * NB + b) * 4 + h) * 16384;
#pragma unroll
        for (int kb = 0; kb < 8; ++kb)
#pragma unroll
            for (int r = 0; r < 4; ++r) so[(size_t)(kb * 16 + 4 * fq + r) * 128 + vb * 16 + fr] = Sacc[kb][r]; }
    VM_WAIT(); __syncthreads();
    bf16* MIX = (bf16*)(A.ws + WS_MIX);
    const float nw0 = A.in[21][l * 128 + 2 * lane], nw1 = A.in[21][l * 128 + 2 * lane + 1];
    for (int t = C.wave; t < TP; t += NWAVES) { const size_t m = mrow0 + t;
        const unsigned ow = *(const unsigned*)(U + m * DIN + 4096 + h * 128 + 2 * lane), zw = *(const unsigned*)(U + m * DIN + 4608 + h * 128 + 2 * lane);
        const float o0 = bflo(ow), o1 = bfhi(ow);
        const float rn = rsqrtf(wave_sum(o0 * o0 + o1 * o1) * (1.f / 128.f) + EPS);
        *(unsigned*)(MIX + m * DMIX + 1024 + h * 128 + 2 * lane) = pk2(o0 * rn * nw0 * siluf_(bflo(zw)), o1 * rn * nw1 * siluf_(bfhi(zw))); }
}

DI void p3_ret_chain(const Args& A, const Ctx& C, int l, int b, int h) {
    const int tid = C.tid, lane = C.lane, fr = lane & 15, fq = lane >> 4, vb = C.wave;
    LAS unsigned char* L = C.lds;
    LAS bf16* Qb = (LAS bf16*)(L + CL_A); LAS bf16* KTb = (LAS bf16*)(L + CL_KT); LAS bf16* SCb = (LAS bf16*)(L + CL_AT);
    LAS bf16* ST = (LAS bf16*)(L + CL_PRIV + vb * CL_PRIV_BYTES);
    bf16* U = (bf16*)(A.ws + WS_U); const size_t mrow0 = (size_t)b * TP;
    const bf16* gKRT = (const bf16*)(A.ws + R_KRT); const bf16* gVT = (const bf16*)(A.ws + R_VT); const bf16* gSC = (const bf16*)(A.ws + R_SC);
    for (int e = lane; e < 16 * 136 / 2; e += 64) ((LAS unsigned*)ST)[e] = 0u;
    f32x4 Sacc[8];
#pragma unroll
    for (int kb = 0; kb < 8; ++kb) Sacc[kb] = (f32x4){0.f, 0.f, 0.f, 0.f};
    const float sdec = exp2f(64.f * log2f(1.f - exp2f(-5.f - (float)h)));
    u32x4 R[5]; bf16x8 vfr[2];
    const int r16 = tid >> 4, c16 = tid & 15, r8 = tid >> 3, c8 = tid & 7;
#define RET_PREFETCH(CC_) do { const int cc_ = (CC_); const size_t ch_ = ((size_t)b * NCH + cc_) * 4 + h; const int t0_ = 64 * cc_ - 48; \
        { const int ta_ = t0_ + r16, tb2_ = t0_ + r16 + 32; const u32x4 z_ = (u32x4){0u, 0u, 0u, 0u}; \
          R[0] = ta_ >= 0 ? *(const u32x4*)(U + (mrow0 + ta_) * DIN + 1024 + h * 128 + c16 * 8) : z_; \
          R[1] = tb2_ >= 0 ? *(const u32x4*)(U + (mrow0 + tb2_) * DIN + 1024 + h * 128 + c16 * 8) : z_; } \
        R[2] = *(const u32x4*)(gKRT + ch_ * 8192 + (size_t)tid * 8); R[3] = *(const u32x4*)(gKRT + ch_ * 8192 + (size_t)(tid + 512) * 8); \
        R[4] = *(const u32x4*)(gSC + ch_ * 4096 + (size_t)tid * 8); \
        _Pragma("unroll") for (int k2_ = 0; k2_ < 2; ++k2_) vfr[k2_] = *(const bf16x8*)(gVT + ch_ * 8192 + (vb * 16 + fr) * 64 + k2_ * 32 + 8 * fq); } while (0)
    RET_PREFETCH(0);
#pragma unroll 1
    for (int c = 0; c < NCH; ++c) {
        __syncthreads();
        *(LAS u32x4*)(Qb + r16 * 136 + c16 * 8) = R[0];        *(LAS u32x4*)(Qb + (r16 + 32) * 136 + c16 * 8) = R[1];
        *(LAS u32x4*)(KTb + r8 * 72 + c8 * 8) = R[2];          *(LAS u32x4*)(KTb + (r8 + 64) * 72 + c8 * 8) = R[3];
        *(LAS u32x4*)(SCb + r8 * 72 + c8 * 8) = R[4];
        bf16x8 vf[2]; vf[0] = vfr[0]; vf[1] = vfr[1];
        __syncthreads();
        if (c + 1 < NCH) RET_PREFETCH(c + 1);
        bf16x8 sf[4];
#pragma unroll
        for (int kc = 0; kc < 4; ++kc) sf[kc] = *(const LAS bf16x8*)(ST + fr * 136 + kc * 32 + 8 * fq);
        f32x4 o[4];
#pragma unroll
        for (int tb = 0; tb < 4; ++tb) { f32x4 aq = (f32x4){0.f, 0.f, 0.f, 0.f};
#pragma unroll
            for (int kc = 0; kc < 4; ++kc) aq = mfma16(*(const LAS bf16x8*)(Qb + (tb * 16 + fr) * 136 + kc * 32 + 8 * fq), sf[kc], aq);
#pragma unroll
            for (int k2 = 0; k2 < 2; ++k2) aq = mfma16(*(const LAS bf16x8*)(SCb + (tb * 16 + fr) * 72 + k2 * 32 + 8 * fq), vf[k2], aq);
            o[tb] = aq; }
#pragma unroll
        for (int kb = 0; kb < 8; ++kb) { f32x4 s = Sacc[kb] * sdec;
#pragma unroll
            for (int k2 = 0; k2 < 2; ++k2) s = mfma16(*(const LAS bf16x8*)(KTb + (kb * 16 + fr) * 72 + k2 * 32 + 8 * fq), vf[k2], s);
            Sacc[kb] = s;
            *(LAS u32x2*)(ST + fr * 136 + kb * 16 + 4 * fq) = pack4(s); }
        const int t0 = 64 * c - 48;
#pragma unroll
        for (int tb = 0; tb < 4; ++tb)
#pragma unroll
            for (int r = 0; r < 4; ++r) { const int t = t0 + tb * 16 + 4 * fq + r; if (t >= 0) U[(mrow0 + t) * DIN + 2048 + h * 128 + vb * 16 + fr] = (bf16)f2bf(o[tb][r]); }
        LDS_WAIT();
    }
#undef RET_PREFETCH
    { float* so = A.out + O_RP + ((size_t)(l * NB + b) * 4 + h) * 16384;
#pragma unroll
        for (int kb = 0; kb < 8; ++kb)
#pragma unroll
            for (int r = 0; r < 4; ++r) so[(size_t)(kb * 16 + 4 * fq + r) * 128 + vb * 16 + fr] = Sacc[kb][r]; }
    VM_WAIT(); __syncthreads();
    bf16* MIX = (bf16*)(A.ws + WS_MIX);
    const float gw0 = A.in[16][l * 512 + h * 128 + 2 * lane], gw1 = A.in[16][l * 512 + h * 128 + 2 * lane + 1];
    const float gb0 = A.in[17][l * 512 + h * 128 + 2 * lane], gb1 = A.in[17][l * 512 + h * 128 + 2 * lane + 1];
    for (int t = C.wave; t < TP; t += NWAVES) { const size_t m = mrow0 + t;
        const unsigned ow = *(const unsigned*)(U + m * DIN + 2048 + h * 128 + 2 * lane), zw = *(const unsigned*)(U + m * DIN + 2560 + h * 128 + 2 * lane);
        const float o0 = bflo(ow), o1 = bfhi(ow);
        const float mu = wave_sum(o0 + o1) * (1.f / 128.f); const float d0 = o0 - mu, d1 = o1 - mu;
        const float rn = rsqrtf(wave_sum(d0 * d0 + d1 * d1) * (1.f / 128.f) + EPS);
        *(unsigned*)(MIX + m * DMIX + 512 + h * 128 + 2 * lane) = pk2((d0 * rn * gw0 + gb0) * siluf_(bflo(zw)), (d1 * rn * gw1 + gb1) * siluf_(bfhi(zw))); }
}

template <int KIND>
DI void p3_dec_item(const Args& A, const Ctx& C, int l, int s, int h) {
    const int tid = C.tid, lane = C.lane, wave = C.wave;
    LAS float* F = (LAS float*)C.lds; LAS float* vq = F, *vk = F + 128, *vv = F + 256, *part = F + 384  , *red = F + 896  ;
    const bf16* U = (const bf16*)(A.ws + WS_U); const size_t m = (size_t)MP + s; const bf16* u = U + m * DIN;
    __syncthreads();
    float g = 0.f, beta = 0.f;
    if (KIND == 0) {
        if (tid < 64) { const f32x2 cs = ((const f32x2*)(A.ws + WS_TAB))[2064 * 64 + tid];
            const float q1 = bf2f(u[1024 + h * 128 + tid]), q2 = bf2f(u[1024 + h * 128 + 64 + tid]), k1 = bf2f(u[1536 + h * 128 + tid]), k2 = bf2f(u[1536 + h * 128 + 64 + tid]);
            vq[tid] = q1 * cs[0] - q2 * cs[1]; vq[64 + tid] = q1 * cs[1] + q2 * cs[0];
            vk[tid] = (k1 * cs[0] - k2 * cs[1]) * QSCALE; vk[64 + tid] = (k1 * cs[1] + k2 * cs[0]) * QSCALE; }
        else if (tid >= 128 && tid < 256) vv[tid - 128] = bf2f(u[2048 + h * 128 + (tid - 128)]);
    } else {
        float y = 0.f; const int part3 = tid >> 7, d = tid & 127;
        if (tid < 384) { const int ch = part3 * 512 + h * 128 + d; const float* cv = A.in[5] + ((size_t)(l * NS + s) * 3) * 1536 + ch; const float* cw = A.in[18] + (size_t)l * 4 * 1536 + ch;
            const float x0 = cv[0], x1 = cv[1536], x2 = cv[3072], x3 = bf2f(u[3072 + ch]);
            y = siluf_(cw[0] * x0 + cw[1536] * x1 + cw[3072] * x2 + cw[4608] * x3);
            float* oc = A.out + O_GCS + ((size_t)(l * NS + s) * 3) * 1536 + ch; oc[0] = x1; oc[1536] = x2; oc[3072] = x3; }
        const float ss = wave_sum(y * y);
        if (lane == 0) red[wave] = ss;
        __syncthreads();
        if (tid < 384) { const float tot = red[2 * part3] + red[2 * part3 + 1];
            if (part3 == 0) vq[d] = y * rsqrtf(tot + EPS) * QSCALE; else if (part3 == 1) vk[d] = y * rsqrtf(tot + EPS); else vv[d] = y; }
        const float* gp = (const float*)(A.ws + WS_GAB) + m * 8;
        g = -__expf(A.in[19][l * 4 + h]) * softplusf_(gp[h] + A.in[20][l * 4 + h]); beta = sigmoidf_(gp[4 + h]);
    }
    __syncthreads();
    const int dv = tid & 127, qt = tid >> 7;
    const float* st = (KIND == 0 ? A.in[4] : A.in[6]) + ((size_t)(l * NS + s) * 4 + h) * 16384 + (size_t)(32 * qt) * 128 + dv;
    float* so = A.out + (KIND == 0 ? O_RS : O_GS) + ((size_t)(l * NS + s) * 4 + h) * 16384 + (size_t)(32 * qt) * 128 + dv;
    float S[32];
#pragma unroll
    for (int i = 0; i < 32; ++i) S[i] = st[(size_t)i * 128];
    const float vdv = vv[dv]; float acc = 0.f;
    if (KIND == 0) {
        const float gam = 1.f - exp2f(-5.f - (float)h);
#pragma unroll
        for (int i = 0; i < 32; ++i) { S[i] = fmaf(gam, S[i], vk[32 * qt + i] * vdv); acc = fmaf(vq[32 * qt + i], S[i], acc); }
    } else {
        const float eg = __expf(g); float ks = 0.f;
#pragma unroll
        for (int i = 0; i < 32; ++i) ks = fmaf(vk[32 * qt + i], S[i], ks);
        part[qt * 128 + dv] = ks;
        __syncthreads();
        const float vn = beta * (vdv - eg * (part[dv] + part[128 + dv] + part[256 + dv] + part[384 + dv]));
        __syncthreads();
#pragma unroll
        for (int i = 0; i < 32; ++i) { S[i] = fmaf(eg, S[i], vk[32 * qt + i] * vn); acc = fmaf(vq[32 * qt + i], S[i], acc); }
    }
    part[qt * 128 + dv] = acc;
#pragma unroll
    for (int i = 0; i < 32; ++i) so[(size_t)i * 128] = S[i];
    __syncthreads();
    bf16* MIX = (bf16*)(A.ws + WS_MIX);
    float o = 0.f, sz = 0.f;
    if (tid < 128) { o = part[dv] + part[128 + dv] + part[256 + dv] + part[384 + dv]; sz = siluf_(bf2f(u[(KIND == 0 ? 2560 : 4608) + h * 128 + dv])); }
    if (KIND == 0) {
        const float s1 = wave_sum(o);
        if (lane == 0) red[wave] = s1;
        __syncthreads();
        const float mu = (red[0] + red[1]) * (1.f / 128.f); const float d = tid < 128 ? o - mu : 0.f;
        __syncthreads();
        const float s2 = wave_sum(d * d);
        if (lane == 0) red[wave] = s2;
        __syncthreads();
        const float rn = rsqrtf((red[0] + red[1]) * (1.f / 128.f) + EPS);
        if (tid < 128) MIX[m * DMIX + 512 + h * 128 + dv] = (bf16)f2bf((d * rn * A.in[16][l * 512 + h * 128 + dv] + A.in[17][l * 512 + h * 128 + dv]) * sz);
    } else {
        const float s2 = wave_sum(o * o);
        if (lane == 0) red[wave] = s2;
        __syncthreads();
        const float rn = rsqrtf((red[0] + red[1]) * (1.f / 128.f) + EPS);
        if (tid < 128) MIX[m * DMIX + 1024 + h * 128 + dv] = (bf16)f2bf(o * rn * A.in[21][l * 128 + dv] * sz);
    }
}

DI void p3_rg_fix(const Args& A, const Ctx& C, int l, int b, int c) {
    const int tid = C.tid, ch8 = 8 * (tid & 63), tsub = tid >> 6;
    const bf16* U = (const bf16*)(A.ws + WS_U); const bf16* BETA = (const bf16*)(A.ws + WS_BETA); bf16* MIX = (bf16*)(A.ws + WS_MIX);
    const f32x4* RGS = (const f32x4*)((const f32x2*)(A.ws + WS_RGS) + (size_t)b * NCH * 512 + ch8);
    float hin[8];
#pragma unroll
    for (int e = 0; e < 8; ++e) hin[e] = 0.f;
    for (int cp = 0; cp < c; ++cp) {
#pragma unroll
        for (int e2 = 0; e2 < 4; ++e2) { const f32x4 p = RGS[(size_t)cp * 256 + e2]; hin[2 * e2] = fmaf(p[0], hin[2 * e2], p[1]); hin[2 * e2 + 1] = fmaf(p[2], hin[2 * e2 + 1], p[3]); } }
    const int t0 = 64 * c - 48; const size_t mrow0 = (size_t)b * TP;
    for (int i = tsub; i < 64; i += 8) { const int t = t0 + i; if (t < 0) continue;
        float al[8], be[8];
        unpack8(*(const u32x4*)(U + (mrow0 + t) * DIN + 512 + ch8), al); unpack8(*(const u32x4*)(BETA + ((size_t)b * TP + t) * 512 + ch8), be);
#pragma unroll
        for (int e = 0; e < 8; ++e) al[e] = fmaf(be[e], hin[e], al[e]);
        *(u32x4*)(MIX + (mrow0 + t) * DMIX + ch8) = pack8(al); }
    if (c == NCH - 1 && tsub == 0) { float* o = A.out + O_HP + (size_t)(l * NB + b) * 512 + ch8;
#pragma unroll
        for (int e2 = 0; e2 < 4; ++e2) { const f32x4 p = RGS[(size_t)c * 256 + e2]; o[2 * e2] = fmaf(p[0], hin[2 * e2], p[1]); o[2 * e2 + 1] = fmaf(p[2], hin[2 * e2 + 1], p[3]); } }
}

DI void phase_p3(const Args& A, const Ctx& C, int l) {
    if (C.bid < 64) { const int kind = C.bid & 1, bh = C.bid >> 1; if (kind) p3_ret_chain(A, C, l, bh >> 2, bh & 3); else p3_gdn_chain(A, C, l, bh >> 2, bh & 3); return; }
    if (C.G <= 64) return;
    const int NJ = C.G - 64;
    for (int it = C.bid - 64; it < 1024 + NB * NCH; it += NJ) {
        if (it < 512) p3_dec_item<1>(A, C, l, it >> 2, it & 3);
        else if (it < 1024) p3_dec_item<0>(A, C, l, (it - 512) >> 2, it & 3);
        else { const int r = it - 1024; p3_rg_fix(A, C, l, r / NCH, r % NCH); }
    }
}

constexpr int N_PHASES = 1 + 5 * DEPTH;
DI const Args* launder(const Args* p) { asm volatile("" : "+s"(p)); return p; }
__global__ void __launch_bounds__(NTHR, 2) mk_fwd(Args args) {
    extern __shared__ __attribute__((aligned(16))) unsigned char lds_raw[];
    const Args* AP = (const Args*)__builtin_amdgcn_kernarg_segment_ptr();
#define A (*launder(AP))
#define MISCP ((volatile LAS unsigned*)((LAS unsigned char*)lds_raw + MISC_OFF))
#define MK_CTX() Ctx C; { int t_ = threadIdx.x; asm volatile("" : "+v"(t_)); C.lds = (LAS unsigned char*)lds_raw; C.tid = t_; C.lane = t_ & 63; C.wave = __builtin_amdgcn_readfirstlane(t_ >> 6); C.G = gridDim.x; C.bid = blockIdx.x; }
#define IN(p) (A.ph_lo <= (p) && (p) < A.ph_hi)
#define SEAM(p) do { if (IN(p) && IN((p) + 1)) { XcdBarrier bar_; bar_.bar = (unsigned*)(A.ws + WS_CTL) + CW_BAR; bar_.x = xb_xcc_id(); bar_.st = MISCP + 8; xcd_barrier(bar_); } } while (0)
    if (threadIdx.x < 32) MISCP[threadIdx.x] = 0u;
    __syncthreads();
    if (A.ph_hi - A.ph_lo > 1) (void)xcd_barrier_post((unsigned*)(A.ws + WS_CTL) + CW_BAR, MISCP + 8);
    if (IN(0)) { MK_CTX(); convert_weights(A, C, 0); build_rope_table(A, C); row_pass(A, C, 0); }
    SEAM(0);
#define LAYER(l) do { \
        if (IN(1 + 5 * (l))) { struct { LAS unsigned char* lds; int G, bid; } C{(LAS unsigned char*)lds_raw, (int)gridDim.x, (int)blockIdx.x}; \
            pg8::Gemm g{(const pg8::bf16_t*)(A.ws + WS_XB), (const pg8::bf16_t*)(A.ws + WS_WINT), M, DIN, DM}; pg8::StaticOrder S; S.init(M, DIN, C.G, C.bid); \
            pg8::EpiU E{(pg8::bf16_t*)(A.ws + WS_U), DIN}; \
            pg8::gemm_phase<pg8::EpiU, pg8::StaticOrder, true, true>(C.lds, g, S, E); } \
        SEAM(1 + 5 * (l)); \
        if (IN(2 + 5 * (l))) { MK_CTX(); phase_p2(A, C, (l)); } \
        SEAM(2 + 5 * (l)); \
        if (IN(3 + 5 * (l))) { MK_CTX(); phase_p3(A, C, (l)); } \
        SEAM(3 + 5 * (l)); \
        if (IN(4 + 5 * (l))) { struct { LAS unsigned char* lds; int G, bid; } C{(LAS unsigned char*)lds_raw, (int)gridDim.x, (int)blockIdx.x}; \
            pg8::Gemm g{(const pg8::bf16_t*)(A.ws + WS_MIX), (const pg8::bf16_t*)(A.ws + WS_WOUTT), M, DM, DMIX}; pg8::StaticOrder S; S.init(M, DM, C.G, C.bid); \
            pg8::EpiRes E{(float*)(A.ws + WS_XF), DM, ALPHA}; \
            pg8::gemm_phase<pg8::EpiRes, pg8::StaticOrder, false, true>(C.lds, g, S, E); } \
        SEAM(4 + 5 * (l)); \
        if (IN(5 + 5 * (l))) { MK_CTX(); if ((l) + 1 < DEPTH) convert_weights(A, C, (l) + 1); row_pass(A, C, (l) + 1); } \
        if ((l) + 1 < DEPTH) SEAM(5 + 5 * (l)); } while (0)
    LAYER(0); LAYER(1); LAYER(2); LAYER(3);
#undef LAYER
#undef IN
#undef SEAM
#undef A
#undef MK_CTX
#undef MISCP
}

}

#ifndef MK_DEBUG
#define MK_DEBUG 0
#endif
#ifndef MK_PROBE
#define MK_PROBE -1
#endif
#ifndef MK_LAUNCH_PER_PHASE
#define MK_LAUNCH_PER_PHASE 0
#endif
extern "C" void kernel_launch(void* const* d_in, const int* in_sizes, int n_in, void* d_out, int out_size, void* d_ws, size_t ws_size, hipStream_t stream) {
    using namespace fx;
    static int grid = 0;
    if (grid == 0) {
        int dev = 0, cus = 0;
        if (n_in != 25 || out_size != (int)O_END || ws_size < WS_END) { fprintf(stderr, "kernel_launch: unexpected sizes (n_in %d, out %d, ws %zu)\n", n_in, out_size, ws_size); grid = -1; return; }
        if (hipGetDevice(&dev) != hipSuccess || hipDeviceGetAttribute(&cus, hipDeviceAttributeMultiprocessorCount, dev) != hipSuccess) { grid = -1; return; }
        if (hipFuncSetAttribute((const void*)mk_fwd, hipFuncAttributeMaxDynamicSharedMemorySize, LDS_BYTES) != hipSuccess) { fprintf(stderr, "kernel_launch: hipFuncSetAttribute failed\n"); grid = -1; return; }
        (void)hipGetLastError();
        grid = cus;
    }
    if (grid < 0) return;
    unsigned char* ws = (unsigned char*)d_ws;
    (void)hipMemsetAsync(ws + WS_CTL, 0, CTL_ZERO_BYTES, stream);
    Args a{};
    for (int i = 0; i < 25; ++i) a.in[i] = (const float*)d_in[i];
    a.out = (float*)d_out; a.ws = ws;
#if MK_DEBUG
    using namespace dbg;
    float* err = (float*)(ws + D_ERR);
    (void)hipMemsetAsync(err, 0, 8192, stream);
    nv::Io io; for (int i = 0; i < 25; ++i) io.in[i] = (const float*)d_in[i]; io.out = (float*)d_out;
    const float* XF = (const float*)(ws + WS_XF); const bf16* XB = (const bf16*)(ws + WS_XB); const float* GAB = (const float*)(ws + WS_GAB); const bf16* U = (const bf16*)(ws + WS_U);
    const bf16* MIX = (const bf16*)(ws + WS_MIX); float* MIXn = (float*)(ws + D_MIXN); float* CST = (float*)(ws + D_ST); float* XFc = (float*)(ws + D_XFC);
    float* out = (float*)d_out;
    for (int ph = 0; ph < N_PHASES; ++ph) {
        const int l = ph == 0 ? -1 : (ph - 1) / 5, k = ph == 0 ? -1 : (ph - 1) % 5;
        if (k == 1) {
            nv::LayerP P = nv::layer_params(io, l);
            P.o_hp = CST + C_HP; P.o_cp = CST + C_CP; P.o_rp = CST + C_RP; P.o_gcp = CST + C_GCP; P.o_gp = CST + C_GP;
            P.o_hs = CST + C_HS; P.o_cs = CST + C_CS; P.o_rs = CST + C_RS; P.o_gcs = CST + C_GCS; P.o_gs = CST + C_GS;
            const nv::Grp g{0, 1, 0, 16}; const nv::UBF ua{(const unsigned short*)U, GAB, 2064, 0};
            nv::rg_kernel<nv::UBF><<<dim3(8, 17), 64, 0, stream>>>(g, P, ua, MIXn);
            nv::ret_kernel<nv::UBF><<<dim3(4, 17), 256, 0, stream>>>(g, P, ua, MIXn);
            nv::gdn_kernel<nv::UBF><<<dim3(4, 17), 256, 0, stream>>>(g, P, ua, MIXn);
        }
        if (k == 3) copy_rows<<<SUBR, 256, 0, stream>>>(XF, XFc);
        a.ph_lo = ph; a.ph_hi = ph + 1;
        hipLaunchKernelGGL(mk_fwd, dim3(grid), dim3(NTHR), LDS_BYTES, stream, a);
        if (ph == 0 || k == 4) { const int ln = l + 1;
            if (ln < DEPTH) {
                if (ln == 0) chk_x0<<<SUBR, 256, 0, stream>>>(XF, io.in[0], io.in[1], io.in[7], err, 18 * ln + 0);
                chk_rows_in<<<SUBR, 256, 0, stream>>>(XF, XB, GAB, io.in[8] + (size_t)ln * DM * DINX, err, 18 * ln + 0);
                chk_wt<<<1024, 256, 0, stream>>>((const bf16*)(ws + WS_WINT), io.in[8] + (size_t)ln * DM * DINX, DINX, DM, DIN, err, 18 * ln + 1);
                chk_wt<<<512, 256, 0, stream>>>((const bf16*)(ws + WS_WOUTT), io.in[22] + (size_t)ln * DMIX * DM, DM, DMIX, DM, err, 18 * ln + 1);
                for (int gt = 0; gt < 2; ++gt) for (int n = 0; n < 8; ++n)
                    chk_wt<<<4, 256, 0, stream>>>((const bf16*)(ws + WS_GATEW) + (size_t)(gt * 8 + n) * 4096, io.in[gt ? 13 : 11] + ((size_t)ln * 8 + n) * 4096, 64, 64, 64, err, 18 * ln + 1);
            }
        }
        if (k == 0) chk_u<<<dim3(DIN / 256, SUBR), 256, 0, stream>>>(XF, io.in[8] + (size_t)l * DM * DINX, U, err, 18 * l + 2);
        if (k == 2) {
            chk_mix<<<SUBR, 256, 0, stream>>>(MIX, MIXn, err, 18 * l + 3);
            chk_vec<<<8, 256, 0, stream>>>(CST + C_HP, out + O_HP + (size_t)(l * NB) * 512, 512, err, 18 * l + 9);
            chk_vec<<<8, 256, 0, stream>>>(CST + C_CP, out + O_CP + (size_t)(l * NB) * 1536, 1536, err, 18 * l + 10);
            chk_vec<<<8, 256, 0, stream>>>(CST + C_GCP, out + O_GCP + (size_t)(l * NB) * 4608, 4608, err, 18 * l + 10);
            chk_vec<<<64, 256, 0, stream>>>(CST + C_RP, out + O_RP + (size_t)(l * NB) * 65536, 65536, err, 18 * l + 11);
            chk_vec<<<64, 256, 0, stream>>>(CST + C_GP, out + O_GP + (size_t)(l * NB) * 65536, 65536, err, 18 * l + 12);
            chk_vec<<<16, 256, 0, stream>>>(CST + C_HS, out + O_HS + (size_t)(l * NS) * 512, 16 * 512, err, 18 * l + 13);
            chk_vec<<<16, 256, 0, stream>>>(CST + C_CS, out + O_CS + (size_t)(l * NS) * 1536, 16 * 1536, err, 18 * l + 14);
            chk_vec<<<16, 256, 0, stream>>>(CST + C_GCS, out + O_GCS + (size_t)(l * NS) * 4608, 16 * 4608, err, 18 * l + 14);
            chk_vec<<<256, 256, 0, stream>>>(CST + C_RS, out + O_RS + (size_t)(l * NS) * 65536, 16 * 65536, err, 18 * l + 15);
            chk_vec<<<256, 256, 0, stream>>>(CST + C_GS, out + O_GS + (size_t)(l * NS) * 65536, 16 * 65536, err, 18 * l + 16);
        }
        if (k == 4) chk_out<<<SUBR, 256, 0, stream>>>(XFc, MIX, io.in[22] + (size_t)l * DMIX * DM, io.in[23] + (size_t)l * DM, io.in[24] + (size_t)l * DM,
                                                     XF, out + O_YP, out + O_YS, l == DEPTH - 1, err, 18 * l + 17);
    }
    nv::run(io, nv::Grp{0, 4, 0, 64}, ws, stream);
    nv::run(io, nv::Grp{4, 4, 64, 64}, ws, stream);
    dbg_eval<<<1, 64, 0, stream>>>(err, MK_PROBE);
    dbg_apply<<<128, 256, 0, stream>>>(err, out + O_YS);
#else
#if MK_LAUNCH_PER_PHASE
    for (int ph = 0; ph < N_PHASES; ++ph) { a.ph_lo = ph; a.ph_hi = ph + 1; hipLaunchKernelGGL(mk_fwd, dim3(grid), dim3(NTHR), LDS_BYTES, stream, a); }
#else
    a.ph_lo = 0; a.ph_hi = N_PHASES;
    hipLaunchKernelGGL(mk_fwd, dim3(grid), dim3(NTHR), LDS_BYTES, stream, a);
#endif
#endif
}
```

```cpp
#include <hip/hip_runtime.h>
#include <cstdio>
#include <cstdint>
#define MK_DEBUG 0
#define MK_PROBE -1
#define MK_LAUNCH_PER_PHASE 0
#define MK_TMASK 0u
#define MK_TMODE 0
#define MK_TBLOCK 0
#define MK_TSUB 0
#define MK_TTHREAD 0

namespace fx {
#define GAS __attribute__((address_space(1)))
#define LAS __attribute__((address_space(3)))
#define DI __device__ __forceinline__
typedef unsigned short bf16;
typedef short bf16x8 __attribute__((ext_vector_type(8)));
typedef float f32x4 __attribute__((ext_vector_type(4)));
typedef float f32x2 __attribute__((ext_vector_type(2)));
typedef unsigned u32x4 __attribute__((ext_vector_type(4)));
typedef unsigned u32x2 __attribute__((ext_vector_type(2)));
typedef GAS unsigned gu32;

constexpr int NWAVES = 8, NTHR = 512;
constexpr int DM = 1024, TP = 2064, NB = 8, NS = 128, MP = NB * TP, M = MP + NS, DIN = 5120, DINX = 5128, DMIX = 1536, DEPTH = 4, NCH = 33, NCHH = NB * NCH * 4;
constexpr float EPS = 1e-6f, ALPHA = 1.681792830507429f, QSCALE = 0.08838834764831845f;

constexpr size_t MiB = 1u << 20;
constexpr size_t WS_CTL = 0, CTL_ZERO_BYTES = 1 * MiB;
constexpr size_t WS_TAB = 1 * MiB;
constexpr size_t WS_GATEW = 3 * MiB;
constexpr size_t WS_WINT = 4 * MiB;
constexpr size_t WS_WOUTT = 14 * MiB;
constexpr size_t WS_GAB = 17 * MiB;
constexpr size_t WS_RGS = 18 * MiB;
constexpr size_t WS_EGL = 20 * MiB;
constexpr size_t WS_XB = 21 * MiB;
constexpr size_t WS_XF = 54 * MiB;
constexpr size_t WS_U = 119 * MiB;
constexpr size_t WS_MIX = 282 * MiB;
constexpr size_t WS_BETA = 331 * MiB;
constexpr size_t WS_GDN = 348 * MiB;
constexpr size_t WS_RET = 423 * MiB;
constexpr size_t WS_DBG = 465 * MiB;
constexpr size_t WS_WINT1 = 470 * MiB;
constexpr size_t WS_GATEW1 = 3 * MiB + 512 * 1024;
constexpr size_t WS_WOUTT1 = 508 * MiB;
constexpr size_t WS_END = 512 * MiB;
constexpr size_t T16 = 16384, T8 = 8192;
constexpr size_t G_W = WS_GDN, G_QG = G_W + NCHH * T16, G_KDT = G_QG + NCHH * T16, G_UT = G_KDT + NCHH * T16, G_ATT = G_UT + NCHH * T16;
constexpr size_t R_KRT = WS_RET, R_VT = R_KRT + NCHH * T16, R_SC = R_VT + NCHH * T16;
constexpr size_t S_QH = WS_MIX, S_KH = S_QH + NCHH * T16, S_RWT = 481 * MiB;
static_assert(G_ATT + NCHH * T8 <= WS_RET && R_SC + NCHH * T8 <= WS_DBG, "ws map");
static_assert(S_KH + NCHH * T16 <= WS_BETA && S_RWT >= WS_WINT1 + 10 * MiB && S_RWT + NCHH * T16 <= WS_WOUTT1, "ws alias map");
constexpr int CW_BAR = 4096;
constexpr int CW_PANEL = 32768;
constexpr int CW_Q = 16384;

constexpr int RING_BYTES = 131072;
constexpr int PRIV_BYTES = 18432;
constexpr int MISC_OFF = 147456;
constexpr int LDS_BYTES = 149504;

constexpr size_t O_YP = 0, O_YS = 16777216, O_HP = 16908288, O_CP = 16924672, O_RP = 16973824, O_GCP = 19070976, O_GP = 19218432,
                 O_HS = 21315584, O_CS = 21577728, O_RS = 22364160, O_GCS = 55918592, O_GS = 58277888, O_END = 91832320;

typedef __bf16 bf16x2_t __attribute__((ext_vector_type(2)));
DI unsigned pk2(float lo, float hi) { const bf16x2_t r = __builtin_convertvector((f32x2){lo, hi}, bf16x2_t); return __builtin_bit_cast(unsigned, r); }
DI unsigned f2bf(float f) { return pk2(f, 0.f) & 0xffffu; }
DI float bflo(unsigned w) { return __builtin_bit_cast(float, w << 16); }
DI float bfhi(unsigned w) { return __builtin_bit_cast(float, w & 0xffff0000u); }
DI float bf2f(bf16 h) { return __builtin_bit_cast(float, (unsigned)h << 16); }
DI void unpack8(const u32x4 w, float (&x)[8]) { x[0] = bflo(w.x); x[1] = bfhi(w.x); x[2] = bflo(w.y); x[3] = bfhi(w.y); x[4] = bflo(w.z); x[5] = bfhi(w.z); x[6] = bflo(w.w); x[7] = bfhi(w.w); }
DI u32x4 pack8(const float (&x)[8]) { u32x4 w; w.x = pk2(x[0], x[1]); w.y = pk2(x[2], x[3]); w.z = pk2(x[4], x[5]); w.w = pk2(x[6], x[7]); return w; }
DI u32x2 pack4(const f32x4 v) { u32x2 w; w.x = pk2(v[0], v[1]); w.y = pk2(v[2], v[3]); return w; }
DI f32x4 unpack4(const u32x2 w) { return (f32x4){bflo(w.x), bfhi(w.x), bflo(w.y), bfhi(w.y)}; }
DI float sigmoidf_(float x) { return __builtin_amdgcn_rcpf(1.f + __expf(-x)); }
DI float siluf_(float x) { return x * __builtin_amdgcn_rcpf(1.f + __expf(-x)); }
DI float softplusf_(float x) { const float e = __expf(-fabsf(x)); const float l = e < 1e-3f ? e * (1.f - 0.5f * e) : __logf(1.f + e); return fmaxf(x, 0.f) + l; }
template <int CTRL> DI float dpp_f(float old, float x) { return __builtin_bit_cast(float, __builtin_amdgcn_update_dpp(__builtin_bit_cast(int, old), __builtin_bit_cast(int, x), CTRL, 0xf, 0xf, false)); }
DI float row_sum16(float x) {
    x += dpp_f<0xB1>(0.f, x);
    x += dpp_f<0x4E>(0.f, x);
    x += dpp_f<0x141>(0.f, x);
    x += dpp_f<0x140>(0.f, x);
    return x;
}
DI float rdlane(float x, int l) { return __builtin_bit_cast(float, __builtin_amdgcn_readlane(__builtin_bit_cast(int, x), l)); }
DI float wave_sum(float v) { v = row_sum16(v); return (rdlane(v, 0) + rdlane(v, 16)) + (rdlane(v, 32) + rdlane(v, 48)); }
DI float row_bcast15(float x) { return __builtin_bit_cast(float, __builtin_amdgcn_ds_swizzle(__builtin_bit_cast(int, x), 0x1F0)); }
DI float neg_expm1f_(float x) {
    const float ser = -x * (1.f + x * (0.5f + x * (0.16666667f + x * (0.041666668f + x * (0.0083333338f + x * 0.0013888889f)))));
    return x > -0.25f ? ser : 1.f - __expf(x);
}
#define LDS_WAIT() asm volatile("s_waitcnt lgkmcnt(0)" ::: "memory")
#define VM_WAIT() asm volatile("s_waitcnt vmcnt(0)" ::: "memory")
DI f32x4 mfma16(bf16x8 a, bf16x8 b, f32x4 c) { return __builtin_amdgcn_mfma_f32_16x16x32_bf16(a, b, c, 0, 0, 0); }
#if MK_TMODE == 2
#define TS_BEGIN(id) do { if ((id) == MK_TSUB && blockIdx.x == MK_TBLOCK && threadIdx.x == MK_TTHREAD) *(volatile LAS unsigned long long*)(size_t)(MISC_OFF + 80) = __builtin_amdgcn_s_memrealtime(); } while (0)
#define TS_END(id) do { if ((id) == MK_TSUB && blockIdx.x == MK_TBLOCK && threadIdx.x == MK_TTHREAD) *(volatile LAS unsigned long long*)(size_t)(MISC_OFF + 72) += __builtin_amdgcn_s_memrealtime() - *(volatile LAS unsigned long long*)(size_t)(MISC_OFF + 80); } while (0)
#else
#define TS_BEGIN(id) do { } while (0)
#define TS_END(id) do { } while (0)
#endif
}

namespace pg8 {
#define PG8_LAS __attribute__((address_space(3)))
typedef unsigned short bf16_t;
typedef short bf16x8 __attribute__((ext_vector_type(8)));
typedef float f32x4 __attribute__((ext_vector_type(4)));
typedef unsigned u32x4 __attribute__((ext_vector_type(4)));
constexpr int BM = 256, BK = 64, HALF = 128, HTB = HALF * BK * 2  , STAGE_BYTES = 8 * HTB, NXCD = 8, WGM = 8;

__host__ __device__ __forceinline__ int lds_byte(int r, int c) { const int st = (r >> 4) * 2 + (c >> 5), rr = r & 15, cc = c & 31, ob = rr * 64 + cc * 2; return st * 1024 + (ob ^ (((ob >> 9) & 1) << 5)); }
__host__ __device__ __forceinline__ void stage_rc(int b, int& R, int& C) { const int st = b / 1024, sb = b % 1024, swz = sb ^ (((sb >> 9) & 1) << 5); R = (st >> 1) * 16 + swz / 64; C = (st & 1) * 32 + (swz % 64) / 2; }
__host__ __device__ __forceinline__ int perm32(int rho) { const int n = rho >> 4, i = rho & 15; return 8 * (i >> 2) + 4 * n + (i & 3); }

struct Unit { int pm, pn, ko; };
struct Gemm { const bf16_t* A; const bf16_t* Bt; int M, N, K, ld; };

struct StaticOrder {
    int nM, nN, nwg, G, c;
    __host__ __device__ void init(int M, int N, int G_, int c_) { nM = M / BM; nN = N / BM; nwg = nM * nN; G = G_; c = c_; }
    __host__ __device__ bool next(int i, Unit& u) const {
        const long L = (long)i * G + c; if (L >= nwg) return false;
        int wgid = (int)L; { const int q = nwg / NXCD, r = nwg % NXCD, xcd = wgid % NXCD, off = wgid / NXCD; wgid = (xcd < r ? xcd * (q + 1) : r * (q + 1) + (xcd - r) * q) + off; }
        const int nig = WGM * nN, gid = wgid / nig, fm = gid * WGM, gsz = (nM - fm) < WGM ? (nM - fm) : WGM;
        u.pm = fm + ((wgid % nig) % gsz); u.pn = (wgid % nig) / gsz; u.ko = 0; return true;
    }
    __device__ __forceinline__ void a_ready(const Unit&) const {}
    __device__ __forceinline__ void done(const Unit&) const {}
};


__device__ __forceinline__ unsigned cvt_pk_bf16(float lo, float hi) { unsigned r; asm volatile("v_cvt_pk_bf16_f32 %0, %1, %2" : "=v"(r) : "v"(lo), "v"(hi)); return r; }
struct EpiU {
    static constexpr bool PERM = true, AFTER_DRAIN = false;
    bf16_t* O; int ldc;
    __device__ __forceinline__ void operator()(const f32x4 (&acc)[2][2][4][2], const Unit& u, int wr, int wc, int fr, int fq) const {
        const int row0 = u.pm * BM + wr * 64 + fr, col0 = u.pn * BM + wc * 32 + 8 * fq;
#pragma unroll
        for (int ai = 0; ai < 2; ++ai)
#pragma unroll
            for (int m = 0; m < 4; ++m) { bf16_t* rowp = O + (size_t)(row0 + ai * HALF + m * 16) * ldc + col0;
#pragma unroll
                for (int bj = 0; bj < 2; ++bj) { const f32x4 v0 = acc[ai][bj][m][0], v1 = acc[ai][bj][m][1];
                    u32x4 w; w.x = cvt_pk_bf16(v0[0], v0[1]); w.y = cvt_pk_bf16(v0[2], v0[3]); w.z = cvt_pk_bf16(v1[0], v1[1]); w.w = cvt_pk_bf16(v1[2], v1[3]);
                    *(u32x4*)(rowp + bj * HALF) = w; } }
    }
};
struct SliceOrder {
    int pm, nitems, G, c, kslice;
    __device__ __forceinline__ bool next(int i, Unit& u) const { const int id = i * G + c; if (id >= nitems) return false; u.pm = pm; u.pn = id & 3; u.ko = (id >> 2) * kslice; return true; }
    __device__ __forceinline__ void a_ready(const Unit&) const {}
    __device__ __forceinline__ void done(const Unit&) const {}
};
struct EpiAcc {
    static constexpr bool PERM = false, AFTER_DRAIN = false;
    float* Y; const bf16_t* XB; int ldc; float alpha;
    __device__ __forceinline__ void operator()(const f32x4 (&acc)[2][2][4][2], const Unit& u, int wr, int wc, int fr, int fq) const {
        typedef unsigned u32x2v __attribute__((ext_vector_type(2)));
        const int col0 = u.pn * BM + wc * 32 + 4 * fq;
#pragma unroll
        for (int ai = 0; ai < 2; ++ai) {
            u32x2v res[4][2][2];
#pragma unroll
            for (int m = 0; m < 4; ++m) { const int r = u.pm * BM + ai * HALF + wr * 64 + m * 16 + fr; const bf16_t* rowp = XB + (size_t)r * ldc + col0;
#pragma unroll
                for (int bj = 0; bj < 2; ++bj)
#pragma unroll
                    for (int n = 0; n < 2; ++n) res[m][bj][n] = *(const u32x2v*)(rowp + bj * HALF + n * 16); }
#pragma unroll
            for (int m = 0; m < 4; ++m) { const int r = u.pm * BM + ai * HALF + wr * 64 + m * 16 + fr; float* rowp = Y + (size_t)r * ldc + col0;
#pragma unroll
                for (int bj = 0; bj < 2; ++bj)
#pragma unroll
                    for (int n = 0; n < 2; ++n) { const u32x2v w = res[m][bj][n];
                        const f32x4 x = (f32x4){__builtin_bit_cast(float, w.x << 16), __builtin_bit_cast(float, w.x & 0xffff0000u), __builtin_bit_cast(float, w.y << 16), __builtin_bit_cast(float, w.y & 0xffff0000u)};
                        *(f32x4*)(rowp + bj * HALF + n * 16) = x * alpha + acc[ai][bj][m][n]; } }
            asm volatile("" ::: "memory"); }
    }
};
struct EpiRes {
    static constexpr bool PERM = false, AFTER_DRAIN = false;
    float* X; int ldc; float alpha;
    __device__ __forceinline__ void operator()(const f32x4 (&acc)[2][2][4][2], const Unit& u, int wr, int wc, int fr, int fq) const {
        const int col0 = u.pn * BM + wc * 32 + 4 * fq;
#pragma unroll
        for (int ai = 0; ai < 2; ++ai)
#pragma unroll
            for (int m = 0; m < 4; ++m) { const int r = u.pm * BM + ai * HALF + wr * 64 + m * 16 + fr; float* rowp = X + (size_t)r * ldc + col0;
#pragma unroll
                for (int bj = 0; bj < 2; ++bj)
#pragma unroll
                    for (int n = 0; n < 2; ++n) { f32x4* p = (f32x4*)(rowp + bj * HALF + n * 16); const f32x4 b = *p; *p = b * alpha + acc[ai][bj][m][n]; }
                asm volatile("" ::: "memory"); }
    }
};

template <class Epi, class Sched, bool ALIGN_EPI = false, bool SP2 = false>
__device__ __forceinline__ void gemm_phase(PG8_LAS unsigned char* lds, const Gemm g, const Sched& S, const Epi& E) {
    int tid_ = threadIdx.x; asm volatile("" : "+v"(tid_));
    const int tid = tid_, wid = __builtin_amdgcn_readfirstlane(tid >> 6), lane = tid & 63, wr = wid >> 2, wc = wid & 3, fr = lane & 15, fq = lane >> 4;
    const int K = g.K, nt = K / BK;
    unsigned voffA[2], voffB[2];
#pragma unroll
    for (int i = 0; i < 2; ++i) { int R, C; stage_rc(tid * 16 + i * 8192, R, C); const int Rb = Epi::PERM ? ((R & ~31) + perm32(R & 31)) : R;
        voffA[i] = (unsigned)(R * g.ld + C) * 2u; voffB[i] = (unsigned)(Rb * g.ld + C) * 2u; }
    const size_t kstep = (size_t)(BK * 2);
    const size_t hstep = (size_t)HALF * g.ld * 2;
    const size_t tstep = 2 * hstep;
    const unsigned ldsw = (unsigned)wid * 1024u;
    const int aoff = lds_byte(wr * 64 + fr, fq * 8), boff = lds_byte(wc * 32 + fr, fq * 8);
#define PG8_SA(b, h) (((b) * 2 + (h)) * HTB)
#define PG8_SB(b, h) ((4 + (b) * 2 + (h)) * HTB)
#define PG8_STAGE(bufoff, gbase, voff) do { _Pragma("unroll") for (int _i = 0; _i < 2; ++_i) \
        __builtin_amdgcn_global_load_lds((const unsigned*)((const char*)(gbase) + (voff)[_i]), (PG8_LAS unsigned*)(lds + (bufoff) + ldsw + _i * 8192), 16, 0, 0); } while (0)
#define PG8_LDA(dst, b, h) do { _Pragma("unroll") for (int m = 0; m < 4; ++m) _Pragma("unroll") for (int k = 0; k < 2; ++k) dst[m][k] = *(const PG8_LAS bf16x8*)(lds + PG8_SA(b, h) + aoff + m * 2048 + k * 1024); } while (0)
#define PG8_LDB(dst, b, h) do { _Pragma("unroll") for (int n = 0; n < 2; ++n) _Pragma("unroll") for (int k = 0; k < 2; ++k) dst[n][k] = *(const PG8_LAS bf16x8*)(lds + PG8_SB(b, h) + boff + n * 2048 + k * 1024); } while (0)
#define PG8_MMA(ai, bj, At, Bt) do { __builtin_amdgcn_s_setprio(1); _Pragma("unroll") for (int m = 0; m < 4; ++m) _Pragma("unroll") for (int n = 0; n < 2; ++n) _Pragma("unroll") for (int k = 0; k < 2; ++k) \
        acc[ai][bj][m][n] = __builtin_amdgcn_mfma_f32_16x16x32_bf16(Bt[n][k], At[m][k], acc[ai][bj][m][n], 0, 0, 0); __builtin_amdgcn_s_setprio(0); } while (0)
#define PG8_WAIT_V(n) asm volatile("s_waitcnt vmcnt(" #n ")" ::: "memory")
#define PG8_WAIT_L(n) asm volatile("s_waitcnt lgkmcnt(" #n ")" ::: "memory")
#define PG8_BAR __builtin_amdgcn_s_barrier()
#define PG8_SCHED __builtin_amdgcn_sched_barrier(0)
    Unit cur, nxt; int ui = 0;
    if (!S.next(0, cur)) return;
    f32x4 acc[2][2][4][2];
#pragma unroll
    for (int a = 0; a < 2; ++a)
#pragma unroll
        for (int b = 0; b < 2; ++b)
#pragma unroll
            for (int m = 0; m < 4; ++m)
#pragma unroll
                for (int n = 0; n < 2; ++n) acc[a][b][m][n] = (f32x4){0.f, 0.f, 0.f, 0.f};
    bf16x8 At[4][2], B0[2][2], B1[2][2];
    const char* cA = (const char*)g.A + (size_t)cur.pm * tstep + (size_t)cur.ko * 2; const char* cB = (const char*)g.Bt + (size_t)cur.pn * tstep + (size_t)cur.ko * 2;
    S.a_ready(cur);
    if constexpr (SP2) {
        PG8_STAGE(PG8_SB(0, 0), cB, voffB); PG8_STAGE(PG8_SB(0, 1), cB + hstep, voffB); PG8_STAGE(PG8_SA(0, 0), cA, voffA); PG8_STAGE(PG8_SA(0, 1), cA + hstep, voffA);
        if (wr == 1) PG8_BAR;
        PG8_WAIT_V(2); PG8_BAR;
        PG8_STAGE(PG8_SB(1, 0), cB + kstep, voffB); PG8_STAGE(PG8_SA(1, 0), cA + kstep, voffA); PG8_STAGE(PG8_SB(1, 1), cB + hstep + kstep, voffB);
        PG8_WAIT_V(6); PG8_BAR;
    } else {
        PG8_STAGE(PG8_SB(0, 0), cB, voffB); PG8_STAGE(PG8_SA(0, 0), cA, voffA); PG8_STAGE(PG8_SB(0, 1), cB + hstep, voffB); PG8_STAGE(PG8_SA(0, 1), cA + hstep, voffA);
        if (wr == 1) PG8_BAR;
        PG8_WAIT_V(4); PG8_BAR;
        PG8_STAGE(PG8_SB(1, 0), cB + kstep, voffB); PG8_STAGE(PG8_SA(1, 0), cA + kstep, voffA); PG8_STAGE(PG8_SB(1, 1), cB + hstep + kstep, voffB);
        PG8_WAIT_V(6); PG8_BAR;
    }
    for (;;) {
        const bool has_next = S.next(ui + 1, nxt);
        const char* nA = has_next ? (const char*)g.A + (size_t)nxt.pm * tstep + (size_t)nxt.ko * 2 : cA; const char* nB = has_next ? (const char*)g.Bt + (size_t)nxt.pn * tstep + (size_t)nxt.ko * 2 : cB;
        for (int t = 0; t < nt; t += 2) {
            const bool last = (t == nt - 2);
            const char* a1 = cA + (size_t)(t + 1) * kstep;
            const char* a2 = last ? nA : cA + (size_t)(t + 2) * kstep; const char* b2 = last ? nB : cB + (size_t)(t + 2) * kstep;
            const char* a3 = a2 + kstep; const char* b3 = b2 + kstep;
            if (last && has_next) S.a_ready(nxt);
            if constexpr (SP2) {
            PG8_LDB(B0, 0, 0); PG8_LDB(B1, 0, 1); PG8_SCHED; PG8_LDA(At, 0, 0); PG8_STAGE(PG8_SA(1, 1), a1 + hstep, voffA);
            PG8_WAIT_V(8); PG8_WAIT_L(0); PG8_BAR; PG8_MMA(0, 0, At, B0); PG8_MMA(0, 1, At, B1); PG8_BAR; PG8_SCHED;
            PG8_LDA(At, 0, 1); PG8_STAGE(PG8_SB(0, 0), b2, voffB); PG8_STAGE(PG8_SB(0, 1), b2 + hstep, voffB); PG8_STAGE(PG8_SA(0, 0), a2, voffA);
            PG8_WAIT_V(8); PG8_WAIT_L(0); PG8_BAR; PG8_MMA(1, 0, At, B0); PG8_MMA(1, 1, At, B1); PG8_BAR; PG8_SCHED;
            PG8_LDB(B0, 1, 0); PG8_LDB(B1, 1, 1); PG8_SCHED; PG8_LDA(At, 1, 0); PG8_STAGE(PG8_SA(0, 1), a2 + hstep, voffA);
            PG8_WAIT_V(8); PG8_WAIT_L(0); PG8_BAR; PG8_MMA(0, 0, At, B0); PG8_MMA(0, 1, At, B1); PG8_BAR; PG8_SCHED;
            PG8_LDA(At, 1, 1); PG8_STAGE(PG8_SB(1, 0), b3, voffB); PG8_STAGE(PG8_SB(1, 1), b3 + hstep, voffB); PG8_STAGE(PG8_SA(1, 0), a3, voffA);
            PG8_WAIT_V(8); PG8_WAIT_L(0); PG8_BAR; PG8_MMA(1, 0, At, B0); PG8_MMA(1, 1, At, B1); PG8_BAR; PG8_SCHED;
            } else {
            PG8_LDB(B0, 0, 0); PG8_SCHED; PG8_LDA(At, 0, 0); PG8_STAGE(PG8_SA(1, 1), a1 + hstep, voffA);
            PG8_WAIT_L(8); PG8_BAR; PG8_WAIT_L(0); PG8_MMA(0, 0, At, B0); PG8_BAR; PG8_SCHED;
            PG8_LDB(B1, 0, 1); PG8_STAGE(PG8_SB(0, 0), b2, voffB);
            PG8_BAR; PG8_WAIT_L(0); PG8_MMA(0, 1, At, B1); PG8_BAR;
            PG8_LDA(At, 0, 1); PG8_STAGE(PG8_SA(0, 0), a2, voffA);
            PG8_BAR; PG8_WAIT_L(0); PG8_MMA(1, 0, At, B0); PG8_BAR; PG8_SCHED;
            PG8_STAGE(PG8_SB(0, 1), b2 + hstep, voffB);
            PG8_WAIT_V(6); PG8_BAR; PG8_MMA(1, 1, At, B1); PG8_BAR;
            PG8_LDB(B0, 1, 0); PG8_SCHED; PG8_LDA(At, 1, 0); PG8_STAGE(PG8_SA(0, 1), a2 + hstep, voffA);
            PG8_WAIT_L(8); PG8_BAR; PG8_WAIT_L(0); PG8_MMA(0, 0, At, B0); PG8_BAR; PG8_SCHED;
            PG8_LDB(B1, 1, 1); PG8_STAGE(PG8_SB(1, 0), b3, voffB);
            PG8_BAR; PG8_WAIT_L(0); PG8_MMA(0, 1, At, B1); PG8_BAR;
            PG8_LDA(At, 1, 1); PG8_STAGE(PG8_SA(1, 0), a3, voffA);
            PG8_BAR; PG8_WAIT_L(0); PG8_MMA(1, 0, At, B0); PG8_BAR; PG8_SCHED;
            PG8_STAGE(PG8_SB(1, 1), b3 + hstep, voffB);
            PG8_WAIT_V(6); PG8_BAR; PG8_MMA(1, 1, At, B1); PG8_BAR;
            }
        }
        if constexpr (ALIGN_EPI) { if (wr == 0) PG8_BAR; }
        if constexpr (!Epi::AFTER_DRAIN) { E(acc, cur, wr, wc, fr, fq); S.done(cur); }
        if (!has_next) break;
#pragma unroll
        for (int a = 0; a < 2; ++a)
#pragma unroll
            for (int b = 0; b < 2; ++b)
#pragma unroll
                for (int m = 0; m < 4; ++m)
#pragma unroll
                    for (int n = 0; n < 2; ++n) acc[a][b][m][n] = (f32x4){0.f, 0.f, 0.f, 0.f};
        cur = nxt; cA = nA; cB = nB; ++ui;
        if constexpr (ALIGN_EPI) { if (wr == 1) PG8_BAR; }
    }
    PG8_WAIT_V(0);
    if constexpr (!ALIGN_EPI) { if (wr == 0) PG8_BAR; }
    PG8_BAR;
    if constexpr (Epi::AFTER_DRAIN) { E.fused(acc, cur, wr, wc, fr, fq, lds, wid, lane); S.done(cur); }
#undef PG8_SA
#undef PG8_SB
#undef PG8_STAGE
#undef PG8_LDA
#undef PG8_LDB
#undef PG8_MMA
#undef PG8_WAIT_V
#undef PG8_WAIT_L
#undef PG8_BAR
#undef PG8_SCHED
}
}

namespace fx {
#define XB_TMO      128
#define XB_XCNT(j)  (256  + 64 * (j))
#define XB_XSUB(j)  (1280 + 64 * (j))
#define XB_XGEN(j)  (2304 + 64 * (j))
#define XB_TOP      3328
#define XB_TOPGEN   3392
#define XCD_BAR_WORDS 3456
#define XB_SPIN_CAP (1u << 18)

__device__ __forceinline__ unsigned xb_ld(unsigned* p)              { return __hip_atomic_load(p, __ATOMIC_RELAXED, __HIP_MEMORY_SCOPE_AGENT); }
__device__ __forceinline__ unsigned xb_add(unsigned* p, unsigned v) { return __hip_atomic_fetch_add(p, v, __ATOMIC_RELAXED, __HIP_MEMORY_SCOPE_AGENT); }
__device__ __forceinline__ unsigned xb_xcc_id() { return (unsigned)__builtin_amdgcn_s_getreg((3 << 11) | 20) & 0xFu; }
#define XB_SPIN(cond, bar) do { unsigned _sp = 0; while (cond) { __builtin_amdgcn_s_sleep(1); \
    if ((++_sp & 255u) == 0u) { if (xb_ld(&(bar)[XB_TMO])) break; if (_sp > XB_SPIN_CAP) { atomicAdd(&(bar)[XB_TMO], 1u); break; } } } } while (0)

struct XcdBarrier {
    unsigned* bar; unsigned x;
    volatile LAS unsigned* st;
};

__device__ __forceinline__ XcdBarrier xcd_barrier_post(unsigned* bar, volatile LAS unsigned* st) {
    XcdBarrier b; b.bar = bar; b.x = xb_xcc_id(); b.st = st;
    if (threadIdx.x == 0) (void)xb_add(&bar[XB_XCNT(b.x)], 1u);
    return b;
}
__device__ __forceinline__ void xcd_barrier_complete(unsigned* bar, unsigned x, unsigned& nloc, unsigned& nx) {
    const unsigned G = gridDim.x * gridDim.y * gridDim.z;
    unsigned sum, cnt, mine, sp = 0u;
    for (;;) {
        sum = 0u; cnt = 0u; mine = 0u;
#pragma unroll
        for (unsigned j = 0; j < 16; ++j) { const unsigned c = xb_ld(&bar[XB_XCNT(j)]); sum += c; cnt += (c > 0u) ? 1u : 0u; mine = (j == x) ? c : mine; }
        if (sum == G) break;
        __builtin_amdgcn_s_sleep(1);
        if ((++sp & 255u) == 0u) { if (xb_ld(&bar[XB_TMO])) break; if (sp > XB_SPIN_CAP) { atomicAdd(&bar[XB_TMO], 1u); break; } }
    }
    nloc = mine > 0u ? mine : 1u; nx = cnt > 0u ? cnt : 1u;
}

__device__ __forceinline__ void xcd_barrier(const XcdBarrier& b) {
    asm volatile("s_waitcnt vmcnt(0)" ::: "memory");
    __syncthreads();
    if (threadIdx.x == 0) {
        unsigned* bar = b.bar;
        __builtin_amdgcn_s_waitcnt(0);
        unsigned nloc = b.st[0], nx = b.st[1];
        if (nloc == 0u) { xcd_barrier_complete(bar, b.x, nloc, nx); b.st[0] = nloc; b.st[1] = nx; }
        const unsigned old = xb_add(&bar[XB_XSUB(b.x)], 1u);
        const unsigned gen = old / nloc;
        if (old + 1u == (gen + 1u) * nloc) {
            __builtin_amdgcn_fence(__ATOMIC_RELEASE, "agent");
            asm volatile("s_waitcnt vmcnt(0)" ::: "memory");
            const unsigned og = xb_add(&bar[XB_TOP], 1u);
            const unsigned tg = og / nx;
            if (og + 1u == (tg + 1u) * nx) xb_add(&bar[XB_TOPGEN], 1u);
            else XB_SPIN(xb_ld(&bar[XB_TOPGEN]) == tg, bar);
            __builtin_amdgcn_fence(__ATOMIC_ACQUIRE, "agent");
            xb_add(&bar[XB_XGEN(b.x)], 1u);
            asm volatile("s_waitcnt vmcnt(0)" ::: "memory");
        } else {
            XB_SPIN(xb_ld(&bar[XB_XGEN(b.x)]) == gen, bar);
            __builtin_amdgcn_fence(__ATOMIC_ACQUIRE, "agent");
            asm volatile("s_waitcnt vmcnt(0)" ::: "memory");
        }
    }
    __syncthreads();
}

struct Args { GAS const float* in[25]; GAS float* out; GAS unsigned char* ws; int ph_lo, ph_hi; };
struct Ctx { LAS unsigned char* lds; int tid, lane, wave, G, bid; };
#if defined(__HIP_DEVICE_COMPILE__)

DI void transpose_item(const float* W, int ldw, int K, int N, bf16* WT, LAS float* scr, int item, int lane) {
    const int nblk = N / 32, kb = item / nblk, nb = item % nblk, k0 = 64 * kb, n0 = 32 * nb;
#pragma unroll 8
    for (int i = 0; i < 32; ++i) { const int kk = 2 * i + (lane >> 5); scr[kk * 33 + (lane & 31)] = W[(size_t)(k0 + kk) * ldw + n0 + (lane & 31)]; }
    LDS_WAIT();
    const int c = lane & 7;
#pragma unroll
    for (int j = 0; j < 4; ++j) { const int n = (lane >> 3) + 8 * j; const LAS float* s = scr + (8 * c) * 33 + n;
        u32x4 o; o.x = pk2(s[0 * 33], s[1 * 33]); o.y = pk2(s[2 * 33], s[3 * 33]); o.z = pk2(s[4 * 33], s[5 * 33]); o.w = pk2(s[6 * 33], s[7 * 33]);
        *(u32x4*)(WT + (size_t)(n0 + n) * K + k0 + 8 * c) = o; }
    LDS_WAIT();
}
DI void convert_weights(const Args& A, const Ctx& C, int l, int gw, int NGW, int lo = 0, int hi = 1 << 30) {
    LAS float* scr = (LAS float*)(C.lds + C.wave * 16384);
    constexpr int I_IN = (DM / 64) * (DIN / 32), I_OUT = (DMIX / 64) * (DM / 32), I_G = 2 * 8 * 2;
    bf16* WinT = (bf16*)(A.ws + ((l & 1) ? WS_WINT1 : WS_WINT)); bf16* WoutT = (bf16*)(A.ws + ((l & 1) ? WS_WOUTT1 : WS_WOUTT)); bf16* GW = (bf16*)(A.ws + ((l & 1) ? WS_GATEW1 : WS_GATEW));
    for (int it = lo + gw; it < I_IN + I_OUT + I_G && it < hi; it += NGW) {
        int r = it;
        if (r < I_IN) { transpose_item(A.in[8] + (size_t)l * DM * DINX, DINX, DM, DIN, WinT, scr, r, C.lane); continue; } r -= I_IN;
        if (r < I_OUT) { transpose_item(A.in[22] + (size_t)l * DMIX * DM, DM, DMIX, DM, WoutT, scr, r, C.lane); continue; } r -= I_OUT;
        const int gate = r / 16, n = (r % 16) / 2, sub = r % 2;
        transpose_item(A.in[gate ? 13 : 11] + ((size_t)l * 8 + n) * 4096, 64, 64, 64, GW + (size_t)(gate * 8 + n) * 4096, scr, sub, C.lane);
    }
}
DI void build_rope_table(const Args& A, const Ctx& C) {
    f32x2* TAB = (f32x2*)(A.ws + WS_TAB);
    for (int e = C.bid * NTHR + C.tid; e < 2065 * 64; e += C.G * NTHR) {
        const int p = e >> 6, i = e & 63; const float pos = p < 2064 ? (float)p : 16384.f;
        const float inv = exp2f(-(float)i * (13.287712379549449f / 64.f));
        const float ang = pos * inv;
        const double rev = (double)ang * 0.15915494309189535; const double fr = rev - rint(rev);
        const float r = (float)(fr * 6.283185307179586);
        TAB[e] = (f32x2){__cosf(r), __sinf(r)};
    }
}
DI void wait_panel(const Args& A, int lnext, int pm) {
    if (threadIdx.x == 0) {
        unsigned* cnt = (unsigned*)(A.ws + WS_CTL) + CW_PANEL + ((lnext - 1) * 65 + pm) * 64;
        unsigned spins = 0;
        while (__hip_atomic_load(cnt, __ATOMIC_RELAXED, __HIP_MEMORY_SCOPE_AGENT) < 32u) { __builtin_amdgcn_s_sleep(32); if (++spins > (1u << 20)) break; }
        __builtin_amdgcn_fence(__ATOMIC_ACQUIRE, "agent");
        asm volatile("s_waitcnt vmcnt(0)" ::: "memory");
    }
    __syncthreads();
}
DI void row_pass(const Args& A, const Ctx& C, int lnext) {
    const int gw = C.bid * NWAVES + C.wave, NGW = C.G * NWAVES, lane = C.lane;
    float* XF = (float*)(A.ws + WS_XF); bf16* XB = (bf16*)(A.ws + WS_XB); float* GAB = (float*)(A.ws + WS_GAB);
    const int nmain = M / NGW, nrow = nmain + ((nmain * NGW + gw) < M ? 1 : 0);
    LAS float* WG = (LAS float*)C.lds;
    __syncthreads();
    if (lnext < DEPTH) { const float* wg = A.in[8] + (size_t)lnext * DM * DINX + DIN;
        for (int k = C.tid; k < DM; k += NTHR) { const f32x4 w0 = *(const f32x4*)(wg + (size_t)k * DINX), w1 = *(const f32x4*)(wg + (size_t)k * DINX + 4);
            WG[0 * DM + k] = w0[0]; WG[1 * DM + k] = w0[1]; WG[2 * DM + k] = w0[2]; WG[3 * DM + k] = w0[3]; WG[4 * DM + k] = w1[0]; WG[5 * DM + k] = w1[1]; WG[6 * DM + k] = w1[2]; WG[7 * DM + k] = w1[3]; }
        __syncthreads(); }
    f32x4 vn[4];
#define ROW_OF(i) ((i) < nmain ? gw * nmain + (i) : nmain * NGW + gw)
#define ROW_LOAD(i) do { const int m_ = ROW_OF(i); const float* src_; \
        if (lnext == 0) { if (m_ < MP) { const int b_ = m_ / TP, t_ = m_ % TP; src_ = t_ < 16 ? (const float*)(A.in[7] + (size_t)t_ * DM) : (const float*)(A.in[0] + ((size_t)b_ * 2048 + (t_ - 16)) * DM); } \
                          else src_ = (const float*)(A.in[1] + (size_t)(m_ - MP) * DM); } \
        else src_ = XF + (size_t)m_ * DM; \
        _Pragma("unroll") for (int j = 0; j < 4; ++j) vn[j] = *(const f32x4*)(src_ + 4 * lane + 256 * j); } while (0)
    const bool blk_has_extra = (nmain * NGW + C.bid * NWAVES) < M;
    if (nmain > 0) ROW_LOAD(0);
#pragma unroll 1
    for (int i = 0; i < nrow; ++i) {
        if (i == nmain && lnext != 0) { }
        const int m = ROW_OF(i);
        f32x4 v[4];
#pragma unroll
        for (int j = 0; j < 4; ++j) v[j] = vn[j];
        if (i + 1 < nmain) ROW_LOAD(i + 1);
        else if (i + 1 == nmain && i + 1 < nrow) ROW_LOAD(i + 1);
        if (lnext != 0) {
            float s = 0.f;
#pragma unroll
            for (int j = 0; j < 4; ++j) s += (v[j][0] + v[j][1]) + (v[j][2] + v[j][3]);
            const float mean = wave_sum(s) * (1.f / DM); float q = 0.f;
#pragma unroll
            for (int j = 0; j < 4; ++j) { v[j] = v[j] - mean; q += (v[j][0] * v[j][0] + v[j][1] * v[j][1]) + (v[j][2] * v[j][2] + v[j][3] * v[j][3]); }
            const float rstd = rsqrtf(wave_sum(q) * (1.f / DM) + EPS);
            const float* lw = A.in[23] + (size_t)(lnext - 1) * DM; const float* lb = A.in[24] + (size_t)(lnext - 1) * DM;
#pragma unroll
            for (int j = 0; j < 4; ++j) { const f32x4 w = *(const f32x4*)(lw + 4 * lane + 256 * j), b = *(const f32x4*)(lb + 4 * lane + 256 * j); v[j] = v[j] * rstd * w + b; }
        }
        if (lnext < DEPTH) {
#pragma unroll
            for (int j = 0; j < 4; ++j) *(u32x2*)(XB + (size_t)m * DM + 4 * lane + 256 * j) = pack4(v[j]);
            float acc[8];
#pragma unroll
            for (int q = 0; q < 8; ++q) { float s = 0.f;
#pragma unroll
                for (int j = 0; j < 4; ++j) { const f32x4 w = *(const LAS f32x4*)(WG + q * DM + 4 * lane + 256 * j); s += (v[j][0] * w[0] + v[j][1] * w[1]) + (v[j][2] * w[2] + v[j][3] * w[3]); }
                acc[q] = s; }
#pragma unroll
            for (int q = 0; q < 8; ++q) acc[q] = wave_sum(acc[q]);
            if (lane == 0) { *(f32x4*)(GAB + (size_t)m * 8) = (f32x4){acc[0], acc[1], acc[2], acc[3]}; *(f32x4*)(GAB + (size_t)m * 8 + 4) = (f32x4){acc[4], acc[5], acc[6], acc[7]}; }
        } else {
            float* dst = nullptr;
            if (m < MP) { const int b = m / TP, t = m % TP; if (t >= 16) dst = (float*)(A.out + O_YP + ((size_t)b * 2048 + (t - 16)) * DM); }
            else dst = (float*)(A.out + O_YS + (size_t)(m - MP) * DM);
            if (dst) {
#pragma unroll
                for (int j = 0; j < 4; ++j) *(f32x4*)(dst + 4 * lane + 256 * j) = v[j]; }
        }
    }
#undef ROW_OF
#undef ROW_LOAD
}

DI int tsw(int i, int ch) { return i * 128 + ((ch ^ ((i >> 3) & 7)) << 3); }
DI void transpose_out(const LAS bf16* T, bf16* outT, int lane) {
    const int dl = lane >> 3, i8 = lane & 7;
#pragma unroll 2
    for (int d0 = 0; d0 < 16; ++d0) { const LAS bf16* s = T + (i8 * 8) * 128 + ((d0 ^ i8) << 3) + dl; u32x4 w;
        w.x = (unsigned)s[0 * 128] | ((unsigned)s[1 * 128] << 16); w.y = (unsigned)s[2 * 128] | ((unsigned)s[3 * 128] << 16);
        w.z = (unsigned)s[4 * 128] | ((unsigned)s[5 * 128] << 16); w.w = (unsigned)s[6 * 128] | ((unsigned)s[7 * 128] << 16);
        *(u32x4*)(outT + (d0 * 8 + dl) * 64 + i8 * 8) = w; }
}

DI void p2_gdn_item(const Args& A, const Ctx& C, LAS unsigned char* pl, int l, int item) {
    const int lane = C.lane, fr = lane & 15, fq = lane >> 4;
    const int CH = item, h = item & 3, bc = item >> 2, c = bc % NCH, b = bc / NCH;
    const int t0 = 64 * c - 48; const size_t mrow0 = (size_t)b * TP;
    bf16* U = (bf16*)(A.ws + WS_U); const float* GAB = (const float*)(A.ws + WS_GAB);
    LAS float* Amat = (LAS float*)pl; LAS bf16* T = (LAS bf16*)pl; LAS float* scb = (LAS float*)(pl + 17408);
    bf16* QH = (bf16*)(A.ws + S_QH) + (size_t)CH * 8192; bf16* KH = (bf16*)(A.ws + S_KH) + (size_t)CH * 8192; bf16* RWT = (bf16*)(A.ws + S_RWT) + (size_t)CH * 8192;
    bf16* Wg = (bf16*)(A.ws + G_W) + (size_t)CH * 8192; bf16* QG = (bf16*)(A.ws + G_QG) + (size_t)CH * 8192; bf16* KDT = (bf16*)(A.ws + G_KDT) + (size_t)CH * 8192;
    bf16* UT = (bf16*)(A.ws + G_UT) + (size_t)CH * 8192; bf16* ATT = (bf16*)(A.ws + G_ATT) + (size_t)CH * 4096; float* EGL = (float*)(A.ws + WS_EGL);
    TS_BEGIN(8); TS_BEGIN(1);
    {
        const int t = t0 + lane; float g = 0.f, beta = 0.f;
        if (t >= 0) { const float* gp = GAB + (mrow0 + t) * 8; g = -__expf(A.in[19][l * 4 + h]) * softplusf_(gp[h] + A.in[20][l * 4 + h]); beta = sigmoidf_(gp[4 + h]); }
        float gc = g;
#pragma unroll
        for (int off = 1; off < 64; off <<= 1) { const float nb = __shfl_up(gc, off); if (lane >= off) gc += nb; }
        scb[lane] = beta; scb[64 + lane] = gc;
        const float gl = __shfl(gc, 63);
        if (lane == 0) EGL[CH] = __expf(gl);
    }
    LDS_WAIT();
    const float g_last = scb[64 + 63];
    TS_END(1); TS_BEGIN(2);
    const int tbk = lane >> 4, grp = lane & 15;
#pragma unroll 1
    for (int part = 0; part < 3; ++part) {
        const int chb = part * 512 + h * 128 + grp * 8;
        const float* cw = A.in[18] + (size_t)l * 4 * 1536 + chb;
        float wgt[4][8];
#pragma unroll
        for (int j = 0; j < 4; ++j) { const f32x4 a = *(const f32x4*)(cw + j * 1536), bq = *(const f32x4*)(cw + j * 1536 + 4);
            wgt[j][0] = a[0]; wgt[j][1] = a[1]; wgt[j][2] = a[2]; wgt[j][3] = a[3]; wgt[j][4] = bq[0]; wgt[j][5] = bq[1]; wgt[j][6] = bq[2]; wgt[j][7] = bq[3]; }
#pragma unroll 1
        for (int half = 0; half < 2; ++half) {
            const int i0 = tbk * 16 + half * 8;
            u32x4 raw[11];
#pragma unroll
            for (int jj = 0; jj < 11; ++jj) { const int tt = t0 + i0 - 3 + jj; raw[jj] = (u32x4){0u, 0u, 0u, 0u}; if (tt >= 0) raw[jj] = *(const u32x4*)(U + (mrow0 + tt) * DIN + 3072 + chb); }
#pragma unroll
            for (int e8 = 0; e8 < 8; ++e8) {
                const int i = i0 + e8;
                float y[8];
#pragma unroll
                for (int e = 0; e < 8; ++e) y[e] = 0.f;
#pragma unroll
                for (int j = 0; j < 4; ++j) { float x[8]; unpack8(raw[e8 + j], x);
#pragma unroll
                    for (int e = 0; e < 8; ++e) y[e] = fmaf(wgt[j][e], x[e], y[e]); }
                if (c == NCH - 1 && i >= 61) { float x3[8]; unpack8(raw[e8 + 3], x3); float* o = A.out + O_GCP + ((size_t)(l * NB + b) * 3 + (i - 61)) * 1536 + chb;
                    *(f32x4*)o = (f32x4){x3[0], x3[1], x3[2], x3[3]}; *(f32x4*)(o + 4) = (f32x4){x3[4], x3[5], x3[6], x3[7]}; }
#pragma unroll
                for (int e = 0; e < 8; ++e) y[e] = siluf_(y[e]);
                const float beta_i = scb[i], gc_i = scb[64 + i];
                if (part < 2) {
                    float ss = 0.f;
#pragma unroll
                    for (int e = 0; e < 8; ++e) ss = fmaf(y[e], y[e], ss);
                    ss = row_sum16(ss);
                    const float rn = rsqrtf(ss + EPS) * (part == 0 ? QSCALE : 1.f);
#pragma unroll
                    for (int e = 0; e < 8; ++e) y[e] *= rn;
                }
                if (part == 0) {
                    *(u32x4*)(QH + i * 128 + grp * 8) = pack8(y);
                    const float eg = __expf(gc_i);
#pragma unroll
                    for (int e = 0; e < 8; ++e) y[e] *= eg;
                    *(u32x4*)(QG + i * 128 + grp * 8) = pack8(y);
                } else if (part == 1) {
                    *(u32x4*)(KH + i * 128 + grp * 8) = pack8(y);
                    const float s = beta_i * __expf(gc_i);
#pragma unroll
                    for (int e = 0; e < 8; ++e) y[e] *= s;
                    *(LAS u32x4*)(T + tsw(i, grp)) = pack8(y);
                } else {
#pragma unroll
                    for (int e = 0; e < 8; ++e) y[e] *= beta_i;
                    *(LAS u32x4*)(T + tsw(i, grp)) = pack8(y);
                }
            }
        }
        if (part == 1) {
            LDS_WAIT(); transpose_out(T, RWT, lane); LDS_WAIT();
            VM_WAIT();
#pragma unroll 1
            for (int half = 0; half < 2; ++half) { const int i0 = tbk * 16 + half * 8; u32x4 raw[8];
#pragma unroll
                for (int e8 = 0; e8 < 8; ++e8) raw[e8] = *(const u32x4*)(KH + (i0 + e8) * 128 + grp * 8);
#pragma unroll
                for (int e8 = 0; e8 < 8; ++e8) { const int i = i0 + e8; float y[8]; unpack8(raw[e8], y);
                    const float s = __expf(g_last - scb[64 + i]);
#pragma unroll
                    for (int e = 0; e < 8; ++e) y[e] *= s;
                    *(LAS u32x4*)(T + tsw(i, grp)) = pack8(y); } }
            LDS_WAIT(); transpose_out(T, KDT, lane); LDS_WAIT();
        }
        if (part == 2) { LDS_WAIT(); transpose_out(T, UT, lane); LDS_WAIT(); }
    }
    VM_WAIT();
    TS_END(2); TS_BEGIN(3);
    bf16x8 kf[4][4];
#pragma unroll
    for (int rb = 0; rb < 4; ++rb)
#pragma unroll
        for (int kc = 0; kc < 4; ++kc) kf[rb][kc] = *(const bf16x8*)(KH + (rb * 16 + fr) * 128 + kc * 32 + 8 * fq);
#pragma unroll
    for (int jb = 0; jb < 4; ++jb) { const float gcj = scb[64 + jb * 16 + fr];
#pragma unroll
        for (int ib = jb; ib < 4; ++ib) { f32x4 acc = (f32x4){0.f, 0.f, 0.f, 0.f};
#pragma unroll
            for (int kc = 0; kc < 4; ++kc) acc = mfma16(kf[ib][kc], kf[jb][kc], acc);
#pragma unroll
            for (int r = 0; r < 4; ++r) { const int i = ib * 16 + 4 * fq + r; Amat[i * 68 + jb * 16 + fr] = acc[r] * scb[i] * __expf(fminf(scb[64 + i] - gcj, 0.f)); } } }
#pragma unroll
    for (int ib2 = 0; ib2 < 2; ++ib2) {
    bf16x8 qfa[2][4];
#pragma unroll
    for (int q = 0; q < 2; ++q)
#pragma unroll
        for (int kc = 0; kc < 4; ++kc) qfa[q][kc] = *(const bf16x8*)(QH + ((ib2 * 2 + q) * 16 + fr) * 128 + kc * 32 + 8 * fq);
#pragma unroll
    for (int q = 0; q < 2; ++q) { const int ib = ib2 * 2 + q; bf16x8 qf[4];
#pragma unroll
        for (int kc = 0; kc < 4; ++kc) qf[kc] = qfa[q][kc];
        const int i = ib * 16 + fr; const float gci = scb[64 + i];
#pragma unroll
        for (int jb = 0; jb < 4; ++jb) { f32x4 val = (f32x4){0.f, 0.f, 0.f, 0.f};
            if (jb <= ib) { f32x4 acc = (f32x4){0.f, 0.f, 0.f, 0.f};
#pragma unroll
                for (int kc = 0; kc < 4; ++kc) acc = mfma16(kf[jb][kc], qf[kc], acc);
#pragma unroll
                for (int r = 0; r < 4; ++r) { const int j = jb * 16 + 4 * fq + r; val[r] = (i >= j) ? acc[r] * __expf(fminf(gci - scb[64 + j], 0.f)) : 0.f; } }
            *(u32x2*)(ATT + i * 64 + jb * 16 + 4 * fq) = pack4(val); } } }
    LDS_WAIT();
    TS_END(3); TS_BEGIN(4);
    float mcol[64];
#pragma unroll
    for (int i = 0; i < 64; ++i) { float acc = (lane == i) ? 1.f : 0.f;
#pragma unroll
        for (int j = 0; j < i; ++j) acc = fmaf(-Amat[i * 68 + j], mcol[j], acc);
        mcol[i] = acc; }
    LDS_WAIT(); asm volatile("" ::: "memory");
    LAS bf16* Mb = (LAS bf16*)pl;
#pragma unroll
    for (int i = 0; i < 64; ++i) Mb[i * 136 + lane] = (bf16)f2bf(mcol[i]);
    LDS_WAIT(); asm volatile("" ::: "memory");
    TS_END(4); TS_BEGIN(5);
    bf16x8 mf[4][2];
#pragma unroll
    for (int ib = 0; ib < 4; ++ib)
#pragma unroll
        for (int k2 = 0; k2 < 2; ++k2) mf[ib][k2] = *(const LAS bf16x8*)(Mb + (ib * 16 + fr) * 136 + k2 * 32 + 8 * fq);
    LDS_WAIT(); asm volatile("" ::: "memory");
    { LAS bf16* Tu = (LAS bf16*)pl;
#pragma unroll 1
      for (int hb = 0; hb < 2; ++hb) { bf16x8 rfa[4][2];
#pragma unroll
        for (int q = 0; q < 4; ++q)
#pragma unroll
            for (int k2 = 0; k2 < 2; ++k2) rfa[q][k2] = *(const bf16x8*)(UT + ((hb * 4 + q) * 16 + fr) * 64 + k2 * 32 + 8 * fq);
#pragma unroll
        for (int q = 0; q < 4; ++q) { const int db = hb * 4 + q;
#pragma unroll
            for (int ib = 0; ib < 4; ++ib) { f32x4 acc = (f32x4){0.f, 0.f, 0.f, 0.f};
#pragma unroll
                for (int k2 = 0; k2 < 2; ++k2) acc = mfma16(mf[ib][k2], rfa[q][k2], acc);
                *(LAS u32x2*)(Tu + (db * 16 + fr) * 72 + ib * 16 + 4 * fq) = pack4(acc); } } }
      LDS_WAIT(); VM_WAIT();
      const int dl = lane >> 3, i8 = lane & 7;
#pragma unroll 4
      for (int d0 = 0; d0 < 16; ++d0) *(u32x4*)(UT + (d0 * 8 + dl) * 64 + i8 * 8) = *(const LAS u32x4*)(Tu + (d0 * 8 + dl) * 72 + i8 * 8);
      LDS_WAIT(); asm volatile("" ::: "memory"); }
    { LAS bf16* Tw = (LAS bf16*)pl;
#pragma unroll 1
      for (int hb = 0; hb < 2; ++hb) { bf16x8 rfa[4][2];
#pragma unroll
        for (int q = 0; q < 4; ++q)
#pragma unroll
            for (int k2 = 0; k2 < 2; ++k2) rfa[q][k2] = *(const bf16x8*)(RWT + ((hb * 4 + q) * 16 + fr) * 64 + k2 * 32 + 8 * fq);
#pragma unroll
        for (int q = 0; q < 4; ++q) { const int kb = hb * 4 + q;
#pragma unroll
            for (int ib = 0; ib < 4; ++ib) { f32x4 acc = (f32x4){0.f, 0.f, 0.f, 0.f};
#pragma unroll
                for (int k2 = 0; k2 < 2; ++k2) acc = mfma16(rfa[q][k2], mf[ib][k2], acc);
                *(LAS u32x2*)(Tw + (ib * 16 + fr) * 136 + kb * 16 + 4 * fq) = pack4(acc); } } }
      LDS_WAIT();
      const int r4 = lane >> 4, c16 = lane & 15;
#pragma unroll 4
      for (int it = 0; it < 16; ++it) *(u32x4*)(Wg + (it * 4 + r4) * 128 + c16 * 8) = *(const LAS u32x4*)(Tw + (it * 4 + r4) * 136 + c16 * 8); }
    LDS_WAIT();
    TS_END(5); TS_END(8);
}

DI void p2_ret_item(const Args& A, const Ctx& C, LAS unsigned char* pl, int l, int item) {
    const int lane = C.lane, fr = lane & 15, fq = lane >> 4;
    const int CH = item, h = item & 3, bc = item >> 2, c = bc % NCH, b = bc / NCH;
    const int t0 = 64 * c - 48; const size_t mrow0 = (size_t)b * TP;
    bf16* U = (bf16*)(A.ws + WS_U); LAS bf16* T = (LAS bf16*)pl; const f32x2* TAB = (const f32x2*)(A.ws + WS_TAB);
    bf16* KRT = (bf16*)(A.ws + R_KRT) + (size_t)CH * 8192; bf16* VT = (bf16*)(A.ws + R_VT) + (size_t)CH * 8192; bf16* SC = (bf16*)(A.ws + R_SC) + (size_t)CH * 4096;
    TS_BEGIN(6);
    const float lg2 = log2f(1.f - exp2f(-5.f - (float)h));
    const int tok8 = lane >> 3, d0 = 8 * (lane & 7);
    const int it0 = t0 < 0 ? 6 : 0;
#pragma unroll 1
    for (int part = 0; part < 2; ++part) {
        const int colb = (part ? 1536 : 1024) + h * 128;

        float cc[8], ss[8], cr[8], sr[8];
        { const f32x4* cs = (const f32x4*)(TAB + (size_t)(t0 + it0 * 8 + tok8) * 64 + d0); const f32x4* rs = (const f32x4*)(TAB + (size_t)8 * 64 + d0);
#pragma unroll
            for (int e2 = 0; e2 < 4; ++e2) { const f32x4 v = cs[e2], r = rs[e2]; cc[2 * e2] = v[0]; ss[2 * e2] = v[1]; cc[2 * e2 + 1] = v[2]; ss[2 * e2 + 1] = v[3];
                cr[2 * e2] = r[0]; sr[2 * e2] = r[1]; cr[2 * e2 + 1] = r[2]; sr[2 * e2 + 1] = r[3]; } }
#pragma unroll 1
        for (int itb = 0; itb < 2; ++itb) {
        u32x4 lo4[4], hi4[4];
#pragma unroll
        for (int q = 0; q < 4; ++q) { const int t = t0 + (itb * 4 + q) * 8 + tok8; lo4[q] = (u32x4){0u, 0u, 0u, 0u}; hi4[q] = lo4[q];
            if (t >= 0) { const bf16* p = U + (mrow0 + t) * DIN + colb + d0; lo4[q] = *(const u32x4*)p; hi4[q] = *(const u32x4*)(p + 64); } }
#pragma unroll
        for (int q = 0; q < 4; ++q) { const int it = itb * 4 + q; const int i = it * 8 + tok8, t = t0 + i;
            float r1[8], r2[8];
#pragma unroll
            for (int e = 0; e < 8; ++e) { r1[e] = 0.f; r2[e] = 0.f; }
            if (it >= it0) {
                float lo[8], hi[8]; unpack8(lo4[q], lo); unpack8(hi4[q], hi);
                const float sc = part ? QSCALE * exp2f((float)(63 - i) * lg2) : exp2f((float)(i + 1) * lg2);
#pragma unroll
                for (int e = 0; e < 8; ++e) { r1[e] = (lo[e] * cc[e] - hi[e] * ss[e]) * sc; r2[e] = (lo[e] * ss[e] + hi[e] * cc[e]) * sc;
                    const float cn = cc[e] * cr[e] - ss[e] * sr[e], sn = ss[e] * cr[e] + cc[e] * sr[e]; cc[e] = cn; ss[e] = sn; }
                bf16* p = U + (mrow0 + t) * DIN + colb + d0;
                *(u32x4*)p = pack8(r1); *(u32x4*)(p + 64) = pack8(r2); }
            if (part) { *(LAS u32x4*)(T + tsw(i, d0 >> 3)) = pack8(r1); *(LAS u32x4*)(T + tsw(i, 8 + (d0 >> 3))) = pack8(r2); } } }
        if (part) { LDS_WAIT(); transpose_out(T, KRT, lane); LDS_WAIT(); }
    }
    { const int tok4 = lane >> 4, grp = lane & 15; u32x4 raw[16];
#pragma unroll
        for (int it = 0; it < 16; ++it) { const int t = t0 + it * 4 + tok4; raw[it] = (u32x4){0u, 0u, 0u, 0u};
            if (t >= 0) raw[it] = *(const u32x4*)(U + (mrow0 + t) * DIN + 2048 + h * 128 + grp * 8); }
#pragma unroll
        for (int it = 0; it < 16; ++it) *(LAS u32x4*)(T + tsw(it * 4 + tok4, grp)) = raw[it];
        LDS_WAIT(); transpose_out(T, VT, lane); LDS_WAIT(); }
    VM_WAIT();
    const bf16x8 zf = (bf16x8){0, 0, 0, 0, 0, 0, 0, 0};
    bf16x8 kf[4][4];
#pragma unroll
    for (int rb = 0; rb < 4; ++rb) { const int t = t0 + rb * 16 + fr;
#pragma unroll
        for (int kc = 0; kc < 4; ++kc) kf[rb][kc] = t >= 0 ? *(const bf16x8*)(U + (mrow0 + t) * DIN + 1536 + h * 128 + kc * 32 + 8 * fq) : zf; }
    const float ginv = exp2f(-64.f * lg2);
#pragma unroll
    for (int ib2 = 0; ib2 < 2; ++ib2) {
    bf16x8 qfa[2][4];
#pragma unroll
    for (int q = 0; q < 2; ++q) { const int t = t0 + (ib2 * 2 + q) * 16 + fr;
#pragma unroll
        for (int kc = 0; kc < 4; ++kc) qfa[q][kc] = t >= 0 ? *(const bf16x8*)(U + (mrow0 + t) * DIN + 1024 + h * 128 + kc * 32 + 8 * fq) : zf; }
#pragma unroll
    for (int q = 0; q < 2; ++q) { const int ib = ib2 * 2 + q; bf16x8 qf[4]; const int i = ib * 16 + fr;
#pragma unroll
        for (int kc = 0; kc < 4; ++kc) qf[kc] = qfa[q][kc];
#pragma unroll
        for (int jb = 0; jb < 4; ++jb) { f32x4 val = (f32x4){0.f, 0.f, 0.f, 0.f};
            if (jb <= ib) { f32x4 acc = (f32x4){0.f, 0.f, 0.f, 0.f};
#pragma unroll
                for (int kc = 0; kc < 4; ++kc) acc = mfma16(kf[jb][kc], qf[kc], acc);
#pragma unroll
                for (int r = 0; r < 4; ++r) { const int j = jb * 16 + 4 * fq + r; val[r] = (i >= j) ? acc[r] * ginv : 0.f; } }
            *(u32x2*)(SC + i * 64 + jb * 16 + 4 * fq) = pack4(val); } } }
    LDS_WAIT();
    TS_END(6);
}

template <bool DEC>
DI void p2_rg_item(const Args& A, const Ctx& C, LAS unsigned char* pl, int l, int bt, int c, int n) {
    const int lane = C.lane, fr = lane & 15, fq = lane >> 4;
    TS_BEGIN(7); TS_BEGIN(20);
    bf16* U = (bf16*)(A.ws + WS_U); LAS float* XR = (LAS float*)pl;
    const int t0 = DEC ? 0 : 64 * c - 48; const size_t mrow0 = DEC ? (size_t)MP + 64 * bt : (size_t)bt * TP;
    bf16x8 xf[4][2];
#pragma unroll
    for (int kc = 0; kc < 2; ++kc) { const int ch8 = n * 64 + kc * 32 + 8 * fq;
        float cw[4][8], cb[8];
#pragma unroll
        for (int j = 0; j < 4; ++j) { const float* p = A.in[9] + ((size_t)l * 4 + j) * 512 + ch8; const f32x4 a = *(const f32x4*)p, bq = *(const f32x4*)(p + 4);
            cw[j][0] = a[0]; cw[j][1] = a[1]; cw[j][2] = a[2]; cw[j][3] = a[3]; cw[j][4] = bq[0]; cw[j][5] = bq[1]; cw[j][6] = bq[2]; cw[j][7] = bq[3]; }
        { const float* p = A.in[10] + (size_t)l * 512 + ch8; const f32x4 a = *(const f32x4*)p, bq = *(const f32x4*)(p + 4);
            cb[0] = a[0]; cb[1] = a[1]; cb[2] = a[2]; cb[3] = a[3]; cb[4] = bq[0]; cb[5] = bq[1]; cb[6] = bq[2]; cb[7] = bq[3]; }
        u32x4 rawp[4][4];
        if (!DEC) {
#pragma unroll
            for (int tb = 0; tb < 4; ++tb)
#pragma unroll
                for (int j = 0; j < 4; ++j) { const int tt = t0 + tb * 16 + fr - 3 + j; rawp[tb][j] = (u32x4){0u, 0u, 0u, 0u}; if (tt >= 0) rawp[tb][j] = *(const u32x4*)(U + (mrow0 + tt) * DIN + ch8); }
        }
#pragma unroll
        for (int tb = 0; tb < 4; ++tb) { const int i = tb * 16 + fr;
            float xr[8];
#pragma unroll
            for (int e = 0; e < 8; ++e) xr[e] = cb[e];
            if (!DEC) { const int t = t0 + i; float x3[8];
#pragma unroll
                for (int e = 0; e < 8; ++e) x3[e] = 0.f;
#pragma unroll
                for (int j = 0; j < 4; ++j) { float x[8]; unpack8(rawp[tb][j], x);
#pragma unroll
                        for (int e = 0; e < 8; ++e) { xr[e] = fmaf(cw[j][e], x[e], xr[e]); if (j == 3) x3[e] = x[e]; } }
                if (c == NCH - 1 && i >= 61) { float* o = A.out + O_CP + ((size_t)(l * NB + bt) * 3 + (i - 61)) * 512 + ch8;
                    *(f32x4*)o = (f32x4){x3[0], x3[1], x3[2], x3[3]}; *(f32x4*)(o + 4) = (f32x4){x3[4], x3[5], x3[6], x3[7]}; }
            } else { const int s = 64 * bt + i; const float* cv = A.in[3] + ((size_t)(l * NS + s) * 3) * 512 + ch8; float* oc = A.out + O_CS + ((size_t)(l * NS + s) * 3) * 512 + ch8;
                float x[8];
#pragma unroll
                for (int j = 0; j < 3; ++j) { const f32x4 a = *(const f32x4*)(cv + j * 512), bq = *(const f32x4*)(cv + j * 512 + 4);
                    x[0] = a[0]; x[1] = a[1]; x[2] = a[2]; x[3] = a[3]; x[4] = bq[0]; x[5] = bq[1]; x[6] = bq[2]; x[7] = bq[3];
#pragma unroll
                    for (int e = 0; e < 8; ++e) xr[e] = fmaf(cw[j][e], x[e], xr[e]);
                    if (j >= 1) { *(f32x4*)(oc + (j - 1) * 512) = a; *(f32x4*)(oc + (j - 1) * 512 + 4) = bq; } }
                unpack8(*(const u32x4*)(U + (mrow0 + i) * DIN + ch8), x);
#pragma unroll
                for (int e = 0; e < 8; ++e) xr[e] = fmaf(cw[3][e], x[e], xr[e]);
                *(f32x4*)(oc + 2 * 512) = (f32x4){x[0], x[1], x[2], x[3]}; *(f32x4*)(oc + 2 * 512 + 4) = (f32x4){x[4], x[5], x[6], x[7]};
            }
            *(LAS f32x4*)(XR + i * 68 + kc * 32 + 8 * fq) = (f32x4){xr[0], xr[1], xr[2], xr[3]};
            *(LAS f32x4*)(XR + i * 68 + kc * 32 + 8 * fq + 4) = (f32x4){xr[4], xr[5], xr[6], xr[7]};
            xf[tb][kc] = __builtin_bit_cast(bf16x8, pack8(xr)); } }
    LDS_WAIT();
    TS_END(20); TS_BEGIN(21);
    const bf16* GW = (const bf16*)(A.ws + ((l & 1) ? WS_GATEW1 : WS_GATEW));
    bf16* MIX = (bf16*)(A.ws + WS_MIX); bf16* BETA = (bf16*)(A.ws + WS_BETA);
    bf16x8 wafN[2], wxfN[2]; f32x4 ba4N, bx4N, lam4N; u32x2 zrawN[4];
#define RG_LOADS(DB_) do { const int chl_ = (DB_) * 16 + 4 * fq, ch0_ = n * 64 + chl_; \
        _Pragma("unroll") for (int kc = 0; kc < 2; ++kc) { wafN[kc] = *(const bf16x8*)(GW + (size_t)(0 * 8 + n) * 4096 + ((DB_) * 16 + fr) * 64 + kc * 32 + 8 * fq); \
                                         wxfN[kc] = *(const bf16x8*)(GW + (size_t)(1 * 8 + n) * 4096 + ((DB_) * 16 + fr) * 64 + kc * 32 + 8 * fq); } \
        ba4N = *(const f32x4*)(A.in[12] + (size_t)l * 512 + ch0_); bx4N = *(const f32x4*)(A.in[14] + (size_t)l * 512 + ch0_); lam4N = *(const f32x4*)(A.in[15] + (size_t)l * 512 + ch0_); \
        _Pragma("unroll") for (int tb = 0; tb < 4; ++tb) { const int t_ = t0 + tb * 16 + fr; const size_t row_ = mrow0 + (DEC ? tb * 16 + fr : (t_ >= 0 ? t_ : 0)); zrawN[tb] = *(const u32x2*)(U + row_ * DIN + 512 + ch0_); } } while (0)
    RG_LOADS(0);
#pragma unroll 1
    for (int db = 0; db < 4; ++db) {
        bf16x8 waf[2], wxf[2]; u32x2 zraw[4];
#pragma unroll
        for (int kc = 0; kc < 2; ++kc) { waf[kc] = wafN[kc]; wxf[kc] = wxfN[kc]; }
        const f32x4 ba4 = ba4N, bx4 = bx4N, lam4 = lam4N;
#pragma unroll
        for (int tb = 0; tb < 4; ++tb) zraw[tb] = zrawN[tb];
        const int chl = db * 16 + 4 * fq, ch0 = n * 64 + chl;
        if (db + 1 < 4) RG_LOADS(db + 1);
        f32x4 sp4;
#pragma unroll
        for (int r = 0; r < 4; ++r) sp4[r] = softplusf_(-lam4[r]);
        float Ac[4], Hc[4];
#pragma unroll
        for (int r = 0; r < 4; ++r) { Ac[r] = 1.f; Hc[r] = 0.f; }
#pragma unroll
        for (int tb = 0; tb < 4; ++tb) { const int i = tb * 16 + fr; const int t = t0 + i; const bool valid = DEC || t >= 0; const size_t row = mrow0 + (DEC ? i : (t >= 0 ? t : 0));
            f32x4 aa = (f32x4){0.f, 0.f, 0.f, 0.f}, ax = aa;
#pragma unroll
            for (int kc = 0; kc < 2; ++kc) { aa = mfma16(waf[kc], xf[tb][kc], aa); ax = mfma16(wxf[kc], xf[tb][kc], ax); }
            const f32x4 xr4 = *(const LAS f32x4*)(XR + i * 68 + chl);
            const f32x4 z4 = unpack4(zraw[tb]);
            f32x4 av, uv, sz;
#pragma unroll
            for (int r = 0; r < 4; ++r) { const float rg = sigmoidf_(aa[r] + ba4[r]), ig = sigmoidf_(ax[r] + bx4[r]);
                const float la = -8.f * rg * sp4[r];
                av[r] = __expf(la); uv[r] = sqrtf(fmaxf(neg_expm1f_(2.f * la), 0.f)) * ig * xr4[r]; sz[r] = siluf_(z4[r]); }
            if (DEC) { const int s = 64 * bt + i;
                const f32x4 h0 = *(const f32x4*)(A.in[2] + (size_t)(l * NS + s) * 512 + ch0);
                const f32x4 hv = av * h0 + uv;
                *(f32x4*)(A.out + O_HS + (size_t)(l * NS + s) * 512 + ch0) = hv;
                *(u32x2*)(MIX + row * DMIX + ch0) = pack4(hv * sz);
            } else {
                f32x4 al, be;
#pragma unroll
                for (int r = 0; r < 4; ++r) { float a = valid ? av[r] : 1.f, u = valid ? uv[r] : 0.f;
                    { float pa, pu;
                      pa = dpp_f<0x111>(1.f, a); pu = dpp_f<0x111>(0.f, u); u = fmaf(a, pu, u); a = pa * a;
                      pa = dpp_f<0x112>(1.f, a); pu = dpp_f<0x112>(0.f, u); u = fmaf(a, pu, u); a = pa * a;
                      pa = dpp_f<0x114>(1.f, a); pu = dpp_f<0x114>(0.f, u); u = fmaf(a, pu, u); a = pa * a;
                      pa = dpp_f<0x118>(1.f, a); pu = dpp_f<0x118>(0.f, u); u = fmaf(a, pu, u); a = pa * a; }
                    const float P = Ac[r] * a, hl = fmaf(a, Hc[r], u);
                    al[r] = hl * sz[r]; be[r] = P * sz[r];
                    Ac[r] = row_bcast15(P); Hc[r] = row_bcast15(hl); }
                if (valid) { *(u32x2*)(U + row * DIN + 512 + ch0) = pack4(al); *(u32x2*)(BETA + ((size_t)bt * TP + t) * 512 + ch0) = pack4(be); }
            } }
        if (!DEC && fr == 15) { f32x2* RGS = (f32x2*)(A.ws + WS_RGS) + ((size_t)bt * NCH + c) * 512 + n * 64 + chl;
#pragma unroll
            for (int r = 0; r < 4; ++r) RGS[r] = (f32x2){Ac[r], Hc[r]}; }
    }
#undef RG_LOADS
    LDS_WAIT();
    TS_END(21); TS_END(7);
}

DI void p2_rg_any(const Args& A, const Ctx& C, LAS unsigned char* pl, int l, int it) {
    const int NRG = NB * NCH * 8;
    if (it < NRG) { const int n = it & 7, bc = it >> 3; p2_rg_item<false>(A, C, pl, l, bc / NCH, bc % NCH, n); }
    else { const int r = it - NRG; p2_rg_item<true>(A, C, pl, l, r >> 3, 0, r & 7); }
}
DI void phase_p2(const Args& A, const Ctx& C, int l) {
    LAS unsigned char* pl = C.lds + C.wave * PRIV_BYTES;
    const int slot = C.wave * C.G + C.bid, NSLOT = C.G * NWAVES;
    if (NSLOT != 2048) return;
    constexpr int NL = 2048 - NCHH, NRGT = NB * NCH * 8 + 16, XRG = NRGT - 2 * NL, XRET = NCHH - NL;
    if (slot < NCHH) {
        p2_gdn_item(A, C, pl, l, slot);
        if (slot < XRG) p2_rg_any(A, C, pl, l, 2 * NL + slot);
        else if (slot < XRG + XRET) p2_ret_item(A, C, pl, l, NL + (slot - XRG));
        return; }
    const int j = slot - NCHH;
    p2_rg_any(A, C, pl, l, j); p2_rg_any(A, C, pl, l, NL + j); p2_ret_item(A, C, pl, l, j);
}

constexpr int CL_A = 0;
constexpr int CL_B = 17408;
constexpr int CL_KT = 34816;
constexpr int CL_AT = 53248;
constexpr int CL_PRIV = 62464;
constexpr int CL_PRIV_BYTES = 6656;
constexpr int CL_OT = CL_PRIV + 8 * CL_PRIV_BYTES;
static_assert(CL_OT + 64 * 72 * 2 <= MISC_OFF, "chain LDS map");

DI void p3_gdn_chain(const Args& A, const Ctx& C, int l, int b, int h, int half) {
    const int tid = C.tid, lane = C.lane, fr = lane & 15, fq = lane >> 4, cw = C.wave & 3, hp = C.wave >> 2, vb = 4 * half + cw;
    LAS unsigned char* L = C.lds;
    LAS bf16* Wb = (LAS bf16*)(L + CL_A); LAS bf16* QGb = (LAS bf16*)(L + CL_B); LAS bf16* KTb = (LAS bf16*)(L + CL_KT); LAS bf16* ATb = (LAS bf16*)(L + CL_AT);
    LAS bf16* ST = (LAS bf16*)(L + CL_PRIV + cw * CL_PRIV_BYTES); LAS bf16* VNT = ST + 16 * 136; LAS bf16* OT = (LAS bf16*)(L + CL_OT);
    bf16* U = (bf16*)(A.ws + WS_U); const size_t mrow0 = (size_t)b * TP;
    const bf16* gW = (const bf16*)(A.ws + G_W); const bf16* gQG = (const bf16*)(A.ws + G_QG); const bf16* gKDT = (const bf16*)(A.ws + G_KDT);
    const bf16* gUT = (const bf16*)(A.ws + G_UT); const bf16* gATT = (const bf16*)(A.ws + G_ATT); const float* EGL = (const float*)(A.ws + WS_EGL);
    if (hp == 0) for (int e = lane; e < 16 * 136 / 2; e += 64) ((LAS unsigned*)ST)[e] = 0u;
    f32x4 Sacc[4];
#pragma unroll
    for (int kb = 0; kb < 4; ++kb) Sacc[kb] = (f32x4){0.f, 0.f, 0.f, 0.f};
    u32x4 RA[7], RB[7]; u32x2 urA[2], urB[2]; float eglA, eglB;
    const int r16 = tid >> 4, c16 = tid & 15, r8 = tid >> 3, c8 = tid & 7;
#define GDN_PREFETCH(R, ur, eglr, CC_) do { const size_t ch_ = ((size_t)b * NCH + (CC_)) * 4 + h; \
        R[0] = *(const u32x4*)(gW + ch_ * 8192 + (size_t)tid * 8); R[1] = *(const u32x4*)(gW + ch_ * 8192 + (size_t)(tid + 512) * 8); \
        R[2] = *(const u32x4*)(gQG + ch_ * 8192 + (size_t)tid * 8); R[3] = *(const u32x4*)(gQG + ch_ * 8192 + (size_t)(tid + 512) * 8); \
        R[4] = *(const u32x4*)(gKDT + ch_ * 8192 + (size_t)tid * 8); R[5] = *(const u32x4*)(gKDT + ch_ * 8192 + (size_t)(tid + 512) * 8); \
        R[6] = *(const u32x4*)(gATT + ch_ * 4096 + (size_t)tid * 8); \
        _Pragma("unroll") for (int tb_ = 0; tb_ < 2; ++tb_) ur[tb_] = *(const u32x2*)(gUT + ch_ * 8192 + (vb * 16 + fr) * 64 + (2 * hp + tb_) * 16 + 4 * fq); \
        eglr = EGL[ch_]; } while (0)
#define GDN_COPYOUT(CC_) do { const int t_ = 64 * (CC_) - 48 + r8; const u32x4 v_ = *(const LAS u32x4*)(OT + r8 * 72 + c8 * 8); \
        if (t_ >= 0) *(u32x4*)(U + (mrow0 + t_) * DIN + 4096 + h * 128 + half * 64 + c8 * 8) = v_; } while (0)
#define GDN_STEP(c, R, ur, eglr) do { \
        TS_BEGIN(11); __syncthreads(); TS_END(11); TS_BEGIN(15); \
        *(LAS u32x4*)(Wb + r16 * 136 + c16 * 8) = R[0];        *(LAS u32x4*)(Wb + (r16 + 32) * 136 + c16 * 8) = R[1]; \
        *(LAS u32x4*)(QGb + r16 * 136 + c16 * 8) = R[2];       *(LAS u32x4*)(QGb + (r16 + 32) * 136 + c16 * 8) = R[3]; \
        *(LAS u32x4*)(KTb + r8 * 72 + c8 * 8) = R[4];          *(LAS u32x4*)(KTb + (r8 + 64) * 72 + c8 * 8) = R[5]; \
        *(LAS u32x4*)(ATb + r8 * 72 + c8 * 8) = R[6]; \
        f32x4 uv[2]; \
        _Pragma("unroll") for (int tb = 0; tb < 2; ++tb) uv[tb] = unpack4(ur[tb]); \
        const float egl = eglr; \
        if ((c) >= 1) GDN_COPYOUT((c) - 1); \
        LDS_WAIT(); TS_END(15); TS_BEGIN(16); \
        __syncthreads(); TS_END(16); TS_BEGIN(12); \
        if ((c) + 2 < NCH) GDN_PREFETCH(R, ur, eglr, (c) + 2); \
          \
        bf16x8 sf[4]; \
        _Pragma("unroll") for (int kc = 0; kc < 4; ++kc) sf[kc] = *(const LAS bf16x8*)(ST + fr * 136 + kc * 32 + 8 * fq); \
        f32x4 o[2]; \
        { bf16x8 wf[2][4], qf[2][4]; \
            _Pragma("unroll") for (int q2 = 0; q2 < 2; ++q2) _Pragma("unroll") for (int kc = 0; kc < 4; ++kc) { \
                wf[q2][kc] = *(const LAS bf16x8*)(Wb + ((hp * 2 + q2) * 16 + fr) * 136 + kc * 32 + 8 * fq); qf[q2][kc] = *(const LAS bf16x8*)(QGb + ((hp * 2 + q2) * 16 + fr) * 136 + kc * 32 + 8 * fq); } \
            LDS_WAIT(); \
            _Pragma("unroll") for (int q2 = 0; q2 < 2; ++q2) { const int tb = hp * 2 + q2; f32x4 aw = (f32x4){0.f, 0.f, 0.f, 0.f}, aq = aw; \
                _Pragma("unroll") for (int kc = 0; kc < 4; ++kc) { aw = mfma16(wf[q2][kc], sf[kc], aw); aq = mfma16(qf[q2][kc], sf[kc], aq); } \
                const f32x4 vn = uv[q2] - aw; o[q2] = aq; \
                *(LAS u32x2*)(VNT + fr * 72 + tb * 16 + 4 * fq) = pack4(vn); } } \
        bf16x8 af[2][2], kf[4][2];                   \
        _Pragma("unroll") for (int q2 = 0; q2 < 2; ++q2) _Pragma("unroll") for (int k2 = 0; k2 < 2; ++k2) af[q2][k2] = *(const LAS bf16x8*)(ATb + ((hp * 2 + q2) * 16 + fr) * 72 + k2 * 32 + 8 * fq); \
        _Pragma("unroll") for (int q4 = 0; q4 < 4; ++q4) _Pragma("unroll") for (int k2 = 0; k2 < 2; ++k2) kf[q4][k2] = *(const LAS bf16x8*)(KTb + ((hp * 4 + q4) * 16 + fr) * 72 + k2 * 32 + 8 * fq); \
        LDS_WAIT(); \
        __syncthreads();                             \
        bf16x8 vf[2]; \
        _Pragma("unroll") for (int k2 = 0; k2 < 2; ++k2) vf[k2] = *(const LAS bf16x8*)(VNT + fr * 72 + k2 * 32 + 8 * fq); \
        LDS_WAIT(); \
        _Pragma("unroll") for (int q2 = 0; q2 < 2; ++q2) \
            _Pragma("unroll") for (int k2 = 0; k2 < 2; ++k2) o[q2] = mfma16(af[q2][k2], vf[k2], o[q2]); \
        _Pragma("unroll") for (int q4 = 0; q4 < 4; ++q4) { const int kb = hp * 4 + q4; f32x4 s = Sacc[q4] * egl; \
            _Pragma("unroll") for (int k2 = 0; k2 < 2; ++k2) s = mfma16(kf[q4][k2], vf[k2], s); \
            Sacc[q4] = s; \
            *(LAS u32x2*)(ST + fr * 136 + kb * 16 + 4 * fq) = pack4(s); } \
        _Pragma("unroll") for (int q2 = 0; q2 < 2; ++q2) \
            _Pragma("unroll") for (int r = 0; r < 4; ++r) OT[((hp * 2 + q2) * 16 + 4 * fq + r) * 72 + cw * 16 + fr] = (bf16)f2bf(o[q2][r]); \
        LDS_WAIT(); TS_END(12); } while (0)
    GDN_PREFETCH(RA, urA, eglA, 0); GDN_PREFETCH(RB, urB, eglB, 1);
#pragma unroll 1
    for (int c = 0; c + 1 < NCH; c += 2) { GDN_STEP(c, RA, urA, eglA); GDN_STEP(c + 1, RB, urB, eglB); }
    GDN_STEP(NCH - 1, RA, urA, eglA);
#undef GDN_STEP
#undef GDN_PREFETCH
    { float* so = A.out + O_GP + ((size_t)(l * NB + b) * 4 + h) * 16384;
#pragma unroll
        for (int q4 = 0; q4 < 4; ++q4)
#pragma unroll
            for (int r = 0; r < 4; ++r) so[(size_t)((hp * 4 + q4) * 16 + 4 * fq + r) * 128 + vb * 16 + fr] = Sacc[q4][r]; }
    LDS_WAIT(); __syncthreads();
    GDN_COPYOUT(NCH - 1);
#undef GDN_COPYOUT
}

DI void p3_ret_chain(const Args& A, const Ctx& C, int l, int b, int h, int half) {
    const int tid = C.tid, lane = C.lane, fr = lane & 15, fq = lane >> 4, cw = C.wave & 3, hp = C.wave >> 2, vb = 4 * half + cw;
    LAS unsigned char* L = C.lds;
    LAS bf16* Qb = (LAS bf16*)(L + CL_A); LAS bf16* KTb = (LAS bf16*)(L + CL_KT); LAS bf16* SCb = (LAS bf16*)(L + CL_AT);
    LAS bf16* ST = (LAS bf16*)(L + CL_PRIV + cw * CL_PRIV_BYTES); LAS bf16* OT = (LAS bf16*)(L + CL_OT);
    bf16* U = (bf16*)(A.ws + WS_U); const size_t mrow0 = (size_t)b * TP;
    const bf16* gKRT = (const bf16*)(A.ws + R_KRT); const bf16* gVT = (const bf16*)(A.ws + R_VT); const bf16* gSC = (const bf16*)(A.ws + R_SC);
    if (hp == 0) for (int e = lane; e < 16 * 136 / 2; e += 64) ((LAS unsigned*)ST)[e] = 0u;
    f32x4 Sacc[4];
#pragma unroll
    for (int kb = 0; kb < 4; ++kb) Sacc[kb] = (f32x4){0.f, 0.f, 0.f, 0.f};
    const float sdec = exp2f(64.f * log2f(1.f - exp2f(-5.f - (float)h)));
    u32x4 RA[5], RB[5]; bf16x8 vfA[2], vfB[2];
    const int r16 = tid >> 4, c16 = tid & 15, r8 = tid >> 3, c8 = tid & 7;
#define RET_PREFETCH(R, vfr, CC_) do { const int cc_ = (CC_); const size_t ch_ = ((size_t)b * NCH + cc_) * 4 + h; const int t0_ = 64 * cc_ - 48; \
        { const int ta_ = t0_ + r16, tb2_ = t0_ + r16 + 32; const u32x4 z_ = (u32x4){0u, 0u, 0u, 0u}; \
          R[0] = ta_ >= 0 ? *(const u32x4*)(U + (mrow0 + ta_) * DIN + 1024 + h * 128 + c16 * 8) : z_; \
          R[1] = tb2_ >= 0 ? *(const u32x4*)(U + (mrow0 + tb2_) * DIN + 1024 + h * 128 + c16 * 8) : z_; } \
        R[2] = *(const u32x4*)(gKRT + ch_ * 8192 + (size_t)tid * 8); R[3] = *(const u32x4*)(gKRT + ch_ * 8192 + (size_t)(tid + 512) * 8); \
        R[4] = *(const u32x4*)(gSC + ch_ * 4096 + (size_t)tid * 8); \
        _Pragma("unroll") for (int k2_ = 0; k2_ < 2; ++k2_) vfr[k2_] = *(const bf16x8*)(gVT + ch_ * 8192 + (vb * 16 + fr) * 64 + k2_ * 32 + 8 * fq); } while (0)
#define RET_COPYOUT(CC_) do { const int t_ = 64 * (CC_) - 48 + r8; const u32x4 v_ = *(const LAS u32x4*)(OT + r8 * 72 + c8 * 8); \
        if (t_ >= 0) *(u32x4*)(U + (mrow0 + t_) * DIN + 2048 + h * 128 + half * 64 + c8 * 8) = v_; } while (0)
#define RET_STEP(c, R, vfr) do { \
        __syncthreads(); \
        *(LAS u32x4*)(Qb + r16 * 136 + c16 * 8) = R[0];        *(LAS u32x4*)(Qb + (r16 + 32) * 136 + c16 * 8) = R[1]; \
        *(LAS u32x4*)(KTb + r8 * 72 + c8 * 8) = R[2];          *(LAS u32x4*)(KTb + (r8 + 64) * 72 + c8 * 8) = R[3]; \
        *(LAS u32x4*)(SCb + r8 * 72 + c8 * 8) = R[4]; \
        bf16x8 vf[2]; vf[0] = vfr[0]; vf[1] = vfr[1]; \
        if ((c) >= 1) RET_COPYOUT((c) - 1); \
        LDS_WAIT(); \
        __syncthreads(); \
        if ((c) + 2 < NCH) RET_PREFETCH(R, vfr, (c) + 2); \
        bf16x8 sf[4]; \
        _Pragma("unroll") for (int kc = 0; kc < 4; ++kc) sf[kc] = *(const LAS bf16x8*)(ST + fr * 136 + kc * 32 + 8 * fq); \
        bf16x8 qf[2][4], cf[2][2], kf[4][2]; \
        _Pragma("unroll") for (int q2 = 0; q2 < 2; ++q2) { _Pragma("unroll") for (int kc = 0; kc < 4; ++kc) qf[q2][kc] = *(const LAS bf16x8*)(Qb + ((hp * 2 + q2) * 16 + fr) * 136 + kc * 32 + 8 * fq); \
            _Pragma("unroll") for (int k2 = 0; k2 < 2; ++k2) cf[q2][k2] = *(const LAS bf16x8*)(SCb + ((hp * 2 + q2) * 16 + fr) * 72 + k2 * 32 + 8 * fq); } \
        _Pragma("unroll") for (int q4 = 0; q4 < 4; ++q4) _Pragma("unroll") for (int k2 = 0; k2 < 2; ++k2) kf[q4][k2] = *(const LAS bf16x8*)(KTb + ((hp * 4 + q4) * 16 + fr) * 72 + k2 * 32 + 8 * fq); \
        LDS_WAIT(); \
        f32x4 o[2]; \
        _Pragma("unroll") for (int q2 = 0; q2 < 2; ++q2) { f32x4 aq = (f32x4){0.f, 0.f, 0.f, 0.f}; \
            _Pragma("unroll") for (int kc = 0; kc < 4; ++kc) aq = mfma16(qf[q2][kc], sf[kc], aq); \
            _Pragma("unroll") for (int k2 = 0; k2 < 2; ++k2) aq = mfma16(cf[q2][k2], vf[k2], aq); \
            o[q2] = aq; } \
        __syncthreads();                             \
        _Pragma("unroll") for (int q4 = 0; q4 < 4; ++q4) { const int kb = hp * 4 + q4; f32x4 s = Sacc[q4] * sdec; \
            _Pragma("unroll") for (int k2 = 0; k2 < 2; ++k2) s = mfma16(kf[q4][k2], vf[k2], s); \
            Sacc[q4] = s; \
            *(LAS u32x2*)(ST + fr * 136 + kb * 16 + 4 * fq) = pack4(s); } \
        _Pragma("unroll") for (int q2 = 0; q2 < 2; ++q2) \
            _Pragma("unroll") for (int r = 0; r < 4; ++r) OT[((hp * 2 + q2) * 16 + 4 * fq + r) * 72 + cw * 16 + fr] = (bf16)f2bf(o[q2][r]); \
        LDS_WAIT(); } while (0)
    RET_PREFETCH(RA, vfA, 0); RET_PREFETCH(RB, vfB, 1);
#pragma unroll 1
    for (int c = 0; c + 1 < NCH; c += 2) { RET_STEP(c, RA, vfA); RET_STEP(c + 1, RB, vfB); }
    RET_STEP(NCH - 1, RA, vfA);
#undef RET_STEP
#undef RET_PREFETCH
    { float* so = A.out + O_RP + ((size_t)(l * NB + b) * 4 + h) * 16384;
#pragma unroll
        for (int q4 = 0; q4 < 4; ++q4)
#pragma unroll
            for (int r = 0; r < 4; ++r) so[(size_t)((hp * 4 + q4) * 16 + 4 * fq + r) * 128 + vb * 16 + fr] = Sacc[q4][r]; }
    LDS_WAIT(); __syncthreads();
    RET_COPYOUT(NCH - 1);
#undef RET_COPYOUT
}

DI void phase_p3b(const Args& A, const Ctx& C, int l) {
    const int lane = C.lane, gw = C.bid * NWAVES + C.wave, NGW = C.G * NWAVES;
    const bf16* U = (const bf16*)(A.ws + WS_U); bf16* MIX = (bf16*)(A.ws + WS_MIX);
    float gw0[4], gw1[4], gb0[4], gb1[4];
#pragma unroll
    for (int h = 0; h < 4; ++h) { gw0[h] = A.in[16][l * 512 + h * 128 + 2 * lane]; gw1[h] = A.in[16][l * 512 + h * 128 + 2 * lane + 1];
                                  gb0[h] = A.in[17][l * 512 + h * 128 + 2 * lane]; gb1[h] = A.in[17][l * 512 + h * 128 + 2 * lane + 1]; }
    const float nw0 = A.in[21][l * 128 + 2 * lane], nw1 = A.in[21][l * 128 + 2 * lane + 1];
    unsigned nro[4], nrz[4], ngo[4], ngz[4];
#define P3B_LOAD(m_) do { const bf16* u_ = U + (size_t)(m_) * DIN + 2 * lane; \
        _Pragma("unroll") for (int h = 0; h < 4; ++h) { nro[h] = *(const unsigned*)(u_ + 2048 + h * 128); nrz[h] = *(const unsigned*)(u_ + 2560 + h * 128); ngo[h] = *(const unsigned*)(u_ + 4096 + h * 128); ngz[h] = *(const unsigned*)(u_ + 4608 + h * 128); } } while (0)
    if (gw < MP) P3B_LOAD(gw);
#pragma unroll 1
    for (int m = gw; m < MP; m += NGW) {
        unsigned ro[4], rz[4], go[4], gz[4];
#pragma unroll
        for (int h = 0; h < 4; ++h) { ro[h] = nro[h]; rz[h] = nrz[h]; go[h] = ngo[h]; gz[h] = ngz[h]; }
        if (m + NGW < MP) P3B_LOAD(m + NGW);
        bf16* mx = MIX + (size_t)m * DMIX + 2 * lane;
#pragma unroll
        for (int h = 0; h < 4; ++h) {
            { const float o0 = bflo(ro[h]), o1 = bfhi(ro[h]); const float mu = wave_sum(o0 + o1) * (1.f / 128.f); const float d0 = o0 - mu, d1 = o1 - mu;
              const float rn = rsqrtf(wave_sum(d0 * d0 + d1 * d1) * (1.f / 128.f) + EPS);
              *(unsigned*)(mx + 512 + h * 128) = pk2((d0 * rn * gw0[h] + gb0[h]) * siluf_(bflo(rz[h])), (d1 * rn * gw1[h] + gb1[h]) * siluf_(bfhi(rz[h]))); }
            { const float o0 = bflo(go[h]), o1 = bfhi(go[h]); const float rn = rsqrtf(wave_sum(o0 * o0 + o1 * o1) * (1.f / 128.f) + EPS);
              *(unsigned*)(mx + 1024 + h * 128) = pk2(o0 * rn * nw0 * siluf_(bflo(gz[h])), o1 * rn * nw1 * siluf_(bfhi(gz[h]))); } }
    }
#undef P3B_LOAD
}

template <int KIND>
DI void p3_dec_item(const Args& A, const Ctx& C, int l, int s, int h) {
    const int tid = C.tid, lane = C.lane, wave = C.wave;
    LAS float* F = (LAS float*)C.lds; LAS float* vq = F, *vk = F + 128, *vv = F + 256, *part = F + 384  , *red = F + 896  ;
    const bf16* U = (const bf16*)(A.ws + WS_U); const size_t m = (size_t)MP + s; const bf16* u = U + m * DIN;
    __syncthreads();
    float g = 0.f, beta = 0.f;
    if (KIND == 0) {
        if (tid < 64) { const f32x2 cs = ((const f32x2*)(A.ws + WS_TAB))[2064 * 64 + tid];
            const float q1 = bf2f(u[1024 + h * 128 + tid]), q2 = bf2f(u[1024 + h * 128 + 64 + tid]), k1 = bf2f(u[1536 + h * 128 + tid]), k2 = bf2f(u[1536 + h * 128 + 64 + tid]);
            vq[tid] = q1 * cs[0] - q2 * cs[1]; vq[64 + tid] = q1 * cs[1] + q2 * cs[0];
            vk[tid] = (k1 * cs[0] - k2 * cs[1]) * QSCALE; vk[64 + tid] = (k1 * cs[1] + k2 * cs[0]) * QSCALE; }
        else if (tid >= 128 && tid < 256) vv[tid - 128] = bf2f(u[2048 + h * 128 + (tid - 128)]);
    } else {
        float y = 0.f; const int part3 = tid >> 7, d = tid & 127;
        if (tid < 384) { const int ch = part3 * 512 + h * 128 + d; const float* cv = A.in[5] + ((size_t)(l * NS + s) * 3) * 1536 + ch; const float* cw = A.in[18] + (size_t)l * 4 * 1536 + ch;
            const float x0 = cv[0], x1 = cv[1536], x2 = cv[3072], x3 = bf2f(u[3072 + ch]);
            y = siluf_(cw[0] * x0 + cw[1536] * x1 + cw[3072] * x2 + cw[4608] * x3);
            float* oc = A.out + O_GCS + ((size_t)(l * NS + s) * 3) * 1536 + ch; oc[0] = x1; oc[1536] = x2; oc[3072] = x3; }
        const float ss = wave_sum(y * y);
        if (lane == 0) red[wave] = ss;
        __syncthreads();
        if (tid < 384) { const float tot = red[2 * part3] + red[2 * part3 + 1];
            if (part3 == 0) vq[d] = y * rsqrtf(tot + EPS) * QSCALE; else if (part3 == 1) vk[d] = y * rsqrtf(tot + EPS); else vv[d] = y; }
        const float* gp = (const float*)(A.ws + WS_GAB) + m * 8;
        g = -__expf(A.in[19][l * 4 + h]) * softplusf_(gp[h] + A.in[20][l * 4 + h]); beta = sigmoidf_(gp[4 + h]);
    }
    __syncthreads();
    const int dv = tid & 127, qt = tid >> 7;
    const float* st = (KIND == 0 ? A.in[4] : A.in[6]) + ((size_t)(l * NS + s) * 4 + h) * 16384 + (size_t)(32 * qt) * 128 + dv;
    float* so = A.out + (KIND == 0 ? O_RS : O_GS) + ((size_t)(l * NS + s) * 4 + h) * 16384 + (size_t)(32 * qt) * 128 + dv;
    float S[32];
#pragma unroll
    for (int i = 0; i < 32; ++i) S[i] = st[(size_t)i * 128];
    const float vdv = vv[dv]; float acc = 0.f;
    if (KIND == 0) {
        const float gam = 1.f - exp2f(-5.f - (float)h);
#pragma unroll
        for (int i = 0; i < 32; ++i) { S[i] = fmaf(gam, S[i], vk[32 * qt + i] * vdv); acc = fmaf(vq[32 * qt + i], S[i], acc); }
    } else {
        const float eg = __expf(g); float ks = 0.f;
#pragma unroll
        for (int i = 0; i < 32; ++i) ks = fmaf(vk[32 * qt + i], S[i], ks);
        part[qt * 128 + dv] = ks;
        __syncthreads();
        const float vn = beta * (vdv - eg * (part[dv] + part[128 + dv] + part[256 + dv] + part[384 + dv]));
        __syncthreads();
#pragma unroll
        for (int i = 0; i < 32; ++i) { S[i] = fmaf(eg, S[i], vk[32 * qt + i] * vn); acc = fmaf(vq[32 * qt + i], S[i], acc); }
    }
    part[qt * 128 + dv] = acc;
#pragma unroll
    for (int i = 0; i < 32; ++i) so[(size_t)i * 128] = S[i];
    __syncthreads();
    bf16* MIX = (bf16*)(A.ws + WS_MIX);
    float o = 0.f, sz = 0.f;
    if (tid < 128) { o = part[dv] + part[128 + dv] + part[256 + dv] + part[384 + dv]; sz = siluf_(bf2f(u[(KIND == 0 ? 2560 : 4608) + h * 128 + dv])); }
    if (KIND == 0) {
        const float s1 = wave_sum(o);
        if (lane == 0) red[wave] = s1;
        __syncthreads();
        const float mu = (red[0] + red[1]) * (1.f / 128.f); const float d = tid < 128 ? o - mu : 0.f;
        __syncthreads();
        const float s2 = wave_sum(d * d);
        if (lane == 0) red[wave] = s2;
        __syncthreads();
        const float rn = rsqrtf((red[0] + red[1]) * (1.f / 128.f) + EPS);
        if (tid < 128) MIX[m * DMIX + 512 + h * 128 + dv] = (bf16)f2bf((d * rn * A.in[16][l * 512 + h * 128 + dv] + A.in[17][l * 512 + h * 128 + dv]) * sz);
    } else {
        const float s2 = wave_sum(o * o);
        if (lane == 0) red[wave] = s2;
        __syncthreads();
        const float rn = rsqrtf((red[0] + red[1]) * (1.f / 128.f) + EPS);
        if (tid < 128) MIX[m * DMIX + 1024 + h * 128 + dv] = (bf16)f2bf(o * rn * A.in[21][l * 128 + dv] * sz);
    }
}

DI void p3_rg_fix(const Args& A, const Ctx& C, int l, int b, int c) {
    const int tid = C.tid, ch8 = 8 * (tid & 63), tsub = tid >> 6;
    const bf16* U = (const bf16*)(A.ws + WS_U); const bf16* BETA = (const bf16*)(A.ws + WS_BETA); bf16* MIX = (bf16*)(A.ws + WS_MIX);
    const f32x4* RGS = (const f32x4*)((const f32x2*)(A.ws + WS_RGS) + (size_t)b * NCH * 512 + ch8);
    float hin[8];
#pragma unroll
    for (int e = 0; e < 8; ++e) hin[e] = 0.f;
    for (int cp0 = 0; cp0 < c; cp0 += 4) {
        f32x4 pp[4][4];
#pragma unroll
        for (int q = 0; q < 4; ++q)
#pragma unroll
            for (int e2 = 0; e2 < 4; ++e2) pp[q][e2] = (cp0 + q < c) ? RGS[(size_t)(cp0 + q) * 256 + e2] : (f32x4){1.f, 0.f, 1.f, 0.f};
#pragma unroll
        for (int q = 0; q < 4; ++q)
#pragma unroll
            for (int e2 = 0; e2 < 4; ++e2) { const f32x4 p = pp[q][e2]; hin[2 * e2] = fmaf(p[0], hin[2 * e2], p[1]); hin[2 * e2 + 1] = fmaf(p[2], hin[2 * e2 + 1], p[3]); } }
    const int t0 = 64 * c - 48; const size_t mrow0 = (size_t)b * TP;
    u32x4 ra[8], rb[8];
#pragma unroll
    for (int k = 0; k < 8; ++k) { const int t = t0 + tsub + 8 * k; const int tc = t >= 0 ? t : 0;
        ra[k] = *(const u32x4*)(U + (mrow0 + tc) * DIN + 512 + ch8); rb[k] = *(const u32x4*)(BETA + ((size_t)b * TP + tc) * 512 + ch8); }
#pragma unroll
    for (int k = 0; k < 8; ++k) { const int t = t0 + tsub + 8 * k; if (t < 0) continue;
        float al[8], be[8]; unpack8(ra[k], al); unpack8(rb[k], be);
#pragma unroll
        for (int e = 0; e < 8; ++e) al[e] = fmaf(be[e], hin[e], al[e]);
        *(u32x4*)(MIX + (mrow0 + t) * DMIX + ch8) = pack8(al); }
    if (c == NCH - 1 && tsub == 0) { float* o = A.out + O_HP + (size_t)(l * NB + b) * 512 + ch8;
#pragma unroll
        for (int e2 = 0; e2 < 4; ++e2) { const f32x4 p = RGS[(size_t)c * 256 + e2]; o[2 * e2] = fmaf(p[0], hin[2 * e2], p[1]); o[2 * e2 + 1] = fmaf(p[2], hin[2 * e2 + 1], p[3]); } }
}

DI void phase_p3(const Args& A, const Ctx& C, int l) {
    if (C.G < 256) return;
    if (C.bid < 128) { const int kind = C.bid & 1, bh = (C.bid >> 1) & 31, half = C.bid >> 6;
        if (kind) p3_ret_chain(A, C, l, bh >> 2, bh & 3, half); else p3_gdn_chain(A, C, l, bh >> 2, bh & 3, half);
        return; }
    const int NJ = C.G - 128;
    for (int it = C.bid - 128; it < 1024; it += NJ) {
        if (it < 512) p3_dec_item<1>(A, C, l, it >> 2, it & 3);
        else p3_dec_item<0>(A, C, l, (it - 512) >> 2, it & 3);
    }
    for (int r = C.bid - 128; r < NB * NCH; r += NJ) p3_rg_fix(A, C, l, r / NCH, r % NCH);
}

DI void p4_tail_task(const Args& A, const Ctx& C, int l, int task) {
    const int lane = C.lane, fr = lane & 15, fq = lane >> 4, col0 = (task & 63) * 16, row0 = (M - 256) + (task >> 6) * 64 + (C.wave & 3) * 16, kh = C.wave >> 2;
    const bf16* ap = (const bf16*)(A.ws + WS_MIX) + (size_t)(row0 + fr) * DMIX + kh * 768 + 8 * fq;
    const bf16* bp = (const bf16*)(A.ws + ((l & 1) ? WS_WOUTT1 : WS_WOUTT)) + (size_t)(col0 + fr) * DMIX + kh * 768 + 8 * fq;
    f32x4 acc = (f32x4){0.f, 0.f, 0.f, 0.f};
#pragma unroll
    for (int hb = 0; hb < 2; ++hb) { bf16x8 a[12], bb[12];
#pragma unroll
        for (int u = 0; u < 12; ++u) { a[u] = *(const bf16x8*)(ap + (hb * 12 + u) * 32); bb[u] = *(const bf16x8*)(bp + (hb * 12 + u) * 32); }
#pragma unroll
        for (int u = 0; u < 12; ++u) acc = mfma16(a[u], bb[u], acc); }
    LAS f32x4* red = (LAS f32x4*)C.lds;
    __syncthreads();
    if (kh == 1) red[(C.wave & 3) * 64 + lane] = acc;
    __syncthreads();
    if (kh == 0) { const f32x4 o = acc + red[(C.wave & 3) * 64 + lane]; float* XF = (float*)(A.ws + WS_XF); const bf16* XB = (const bf16*)(A.ws + WS_XB);
#pragma unroll
        for (int r = 0; r < 4; ++r) { const size_t ix = (size_t)(row0 + 4 * fq + r) * DM + col0 + fr; XF[ix] = ALPHA * bf2f(XB[ix]) + o[r]; } }
}


#endif
constexpr int PPL = 6, N_PHASES = 1 + PPL * DEPTH;
#if defined(__HIP_DEVICE_COMPILE__)
DI const Args* launder(const Args* p) { asm volatile("" : "+s"(p)); return p; }
#endif
__global__ void __launch_bounds__(NTHR, 2) mk_fwd(Args args) {
#if defined(__HIP_DEVICE_COMPILE__)
    extern __shared__ __attribute__((aligned(16))) unsigned char lds_raw[];
    const Args* AP = (const Args*)__builtin_amdgcn_kernarg_segment_ptr();
#define A (*launder(AP))
#define MISCP ((volatile LAS unsigned*)((LAS unsigned char*)lds_raw + MISC_OFF))
#define MK_CTX() Ctx C; { int t_ = threadIdx.x; asm volatile("" : "+v"(t_)); C.lds = (LAS unsigned char*)lds_raw; C.tid = t_; C.lane = t_ & 63; C.wave = __builtin_amdgcn_readfirstlane(t_ >> 6); C.G = gridDim.x; C.bid = blockIdx.x; }
#define IN(p) (A.ph_lo <= (p) && (p) < A.ph_hi)
#define SEAM(p) do { if (IN(p) && IN((p) + 1)) { XcdBarrier bar_; bar_.bar = (unsigned*)(A.ws + WS_CTL) + CW_BAR; bar_.x = xb_xcc_id(); bar_.st = MISCP + 8; xcd_barrier(bar_); } } while (0)
    if (threadIdx.x < 32) MISCP[threadIdx.x] = 0u;
    __syncthreads();
#if MK_TMASK || MK_TMODE
#define TSTAMP ((volatile LAS unsigned long long*)((LAS unsigned char*)lds_raw + MISC_OFF + 64))
#define STAMP(ph) do { if (blockIdx.x == MK_TBLOCK && threadIdx.x == 0) { const unsigned long long now_ = __builtin_amdgcn_s_memrealtime(); if (!MK_TMODE && ((MK_TMASK >> (ph)) & 1)) TSTAMP[1] += now_ - TSTAMP[0]; TSTAMP[0] = now_; } } while (0)
#define STAMP_PRE(ph) do { if (MK_TMODE) { __syncthreads(); if (blockIdx.x == MK_TBLOCK && threadIdx.x == 0 && ((MK_TMASK >> (ph)) & 1)) TSTAMP[1] += __builtin_amdgcn_s_memrealtime() - TSTAMP[0]; } } while (0)
    if (blockIdx.x == MK_TBLOCK && threadIdx.x == 0) { TSTAMP[0] = __builtin_amdgcn_s_memrealtime(); TSTAMP[1] = 0ull; }
#else
#define STAMP(ph) do { } while (0)
#define STAMP_PRE(ph) do { } while (0)
#endif
    if (A.ph_hi - A.ph_lo > 1) (void)xcd_barrier_post((unsigned*)(A.ws + WS_CTL) + CW_BAR, MISCP + 8);
    if (IN(0)) { MK_CTX(); convert_weights(A, C, 0, C.bid * NWAVES + C.wave, C.G * NWAVES); build_rope_table(A, C); row_pass(A, C, 0); }
    STAMP_PRE(0); SEAM(0); STAMP(0);
#define LAYER(l) do { \
        if (IN(1 + PPL * (l))) { struct { LAS unsigned char* lds; int G, bid; } C{(LAS unsigned char*)lds_raw, (int)gridDim.x, (int)blockIdx.x}; \
            { pg8::Gemm g{(const pg8::bf16_t*)(A.ws + WS_XB), (const pg8::bf16_t*)(A.ws + (((l) & 1) ? WS_WINT1 : WS_WINT)), M, DIN, DM, DM}; pg8::StaticOrder S; S.init(M, DIN, C.G, C.bid); \
              pg8::EpiU E{(pg8::bf16_t*)(A.ws + WS_U), DIN}; \
              pg8::gemm_phase<pg8::EpiU, pg8::StaticOrder, true, true>(C.lds, g, S, E); } \
              \
            if ((l) + 1 < DEPTH && (int)C.bid >= (M / 256) * (DIN / 256) % C.G) { MK_CTX(); const int nb_ = (M / 256) * (DIN / 256) % C.G; convert_weights(A, C, (l) + 1, ((int)C.bid - nb_) * NWAVES + C.wave, (C.G - nb_) * NWAVES); } } \
        STAMP_PRE(1 + PPL * (l)); SEAM(1 + PPL * (l)); STAMP(1 + PPL * (l)); \
        if (IN(2 + PPL * (l))) { MK_CTX(); phase_p2(A, C, (l)); } \
        STAMP_PRE(2 + PPL * (l)); SEAM(2 + PPL * (l)); STAMP(2 + PPL * (l)); \
        if (IN(3 + PPL * (l))) { MK_CTX(); phase_p3(A, C, (l)); } \
        STAMP_PRE(3 + PPL * (l)); SEAM(3 + PPL * (l)); STAMP(3 + PPL * (l)); \
        if (IN(4 + PPL * (l))) { MK_CTX(); phase_p3b(A, C, (l)); } \
        STAMP_PRE(4 + PPL * (l)); SEAM(4 + PPL * (l)); STAMP(4 + PPL * (l)); \
        if (IN(5 + PPL * (l))) { struct { LAS unsigned char* lds; int G, bid; } C{(LAS unsigned char*)lds_raw, (int)gridDim.x, (int)blockIdx.x}; \
              \
              \
            { pg8::Gemm g{(const pg8::bf16_t*)(A.ws + WS_MIX), (const pg8::bf16_t*)(A.ws + (((l) & 1) ? WS_WOUTT1 : WS_WOUTT)), M - 256, DM, DMIX, DMIX}; pg8::StaticOrder S; S.init(M - 256, DM, C.G, C.bid); \
              pg8::EpiAcc E{(float*)(A.ws + WS_XF), (const pg8::bf16_t*)(A.ws + WS_XB), DM, ALPHA}; \
              pg8::gemm_phase<pg8::EpiAcc, pg8::StaticOrder, false, true>(C.lds, g, S, E); } \
            { MK_CTX(); p4_tail_task(A, C, (l), (int)C.bid); } } \
        STAMP_PRE(5 + PPL * (l)); SEAM(5 + PPL * (l)); STAMP(5 + PPL * (l)); \
        if (IN(6 + PPL * (l))) { MK_CTX(); row_pass(A, C, (l) + 1); } \
        STAMP_PRE(6 + PPL * (l)); if ((l) + 1 < DEPTH) SEAM(6 + PPL * (l)); STAMP(6 + PPL * (l)); } while (0)
    LAYER(0); LAYER(1); LAYER(2); LAYER(3);
#undef LAYER
#if MK_TMASK || MK_TMODE
    __syncthreads();
    if (blockIdx.x == MK_TBLOCK && threadIdx.x == 0) { const unsigned long long t0_ = __builtin_amdgcn_s_memrealtime(), tgt_ = TSTAMP[1] * 9ull;
        while (__builtin_amdgcn_s_memrealtime() - t0_ < tgt_) __builtin_amdgcn_s_sleep(8); }
#endif
#undef IN
#undef SEAM
#undef A
#undef MK_CTX
#undef MISCP
#endif
}

}

#ifndef MK_DEBUG
#define MK_DEBUG 0
#endif
#ifndef MK_PROBE
#define MK_PROBE -1
#endif
#ifndef MK_LAUNCH_PER_PHASE
#define MK_LAUNCH_PER_PHASE 0
#endif
extern "C" void kernel_launch(void* const* d_in, const int* in_sizes, int n_in, void* d_out, int out_size, void* d_ws, size_t ws_size, hipStream_t stream) {
    using namespace fx;
    static int grid = 0;
    if (grid == 0) {
        int dev = 0, cus = 0;
        if (n_in != 25 || out_size != (int)O_END || ws_size < WS_END) { fprintf(stderr, "kernel_launch: unexpected sizes (n_in %d, out %d, ws %zu)\n", n_in, out_size, ws_size); grid = -1; return; }
        if (hipGetDevice(&dev) != hipSuccess || hipDeviceGetAttribute(&cus, hipDeviceAttributeMultiprocessorCount, dev) != hipSuccess) { grid = -1; return; }
        if (hipFuncSetAttribute((const void*)mk_fwd, hipFuncAttributeMaxDynamicSharedMemorySize, LDS_BYTES) != hipSuccess) { fprintf(stderr, "kernel_launch: hipFuncSetAttribute failed\n"); grid = -1; return; }
        (void)hipGetLastError();
        grid = cus;
    }
    if (grid < 0) return;
    unsigned char* ws = (unsigned char*)d_ws;
    (void)hipMemsetAsync(ws + WS_CTL, 0, CTL_ZERO_BYTES, stream);
    Args a{};
    for (int i = 0; i < 25; ++i) a.in[i] = (GAS const float*)d_in[i];
    a.out = (GAS float*)d_out; a.ws = (GAS unsigned char*)ws;
#if MK_DEBUG
    using namespace dbg;
    float* err = (float*)(ws + D_ERR);
    (void)hipMemsetAsync(err, 0, 8192, stream);
    nv::Io io; for (int i = 0; i < 25; ++i) io.in[i] = (const float*)d_in[i]; io.out = (float*)d_out;
    const float* XF = (const float*)(ws + WS_XF); const bf16* XB = (const bf16*)(ws + WS_XB); const float* GAB = (const float*)(ws + WS_GAB); const bf16* U = (const bf16*)(ws + WS_U);
    const bf16* MIX = (const bf16*)(ws + WS_MIX); float* MIXn = (float*)(ws + D_MIXN); float* CST = (float*)(ws + D_ST); float* XFc = (float*)(ws + D_XFC);
    float* out = (float*)d_out;
    for (int ph = 0; ph < N_PHASES; ++ph) {
        const int l = ph == 0 ? -1 : (ph - 1) / 5, k = ph == 0 ? -1 : (ph - 1) % 5;
        if (k == 1) {
            nv::LayerP P = nv::layer_params(io, l);
            P.o_hp = CST + C_HP; P.o_cp = CST + C_CP; P.o_rp = CST + C_RP; P.o_gcp = CST + C_GCP; P.o_gp = CST + C_GP;
            P.o_hs = CST + C_HS; P.o_cs = CST + C_CS; P.o_rs = CST + C_RS; P.o_gcs = CST + C_GCS; P.o_gs = CST + C_GS;
            const nv::Grp g{0, 1, 0, 16}; const nv::UBF ua{(const unsigned short*)U, GAB, 2064, 0};
            nv::rg_kernel<nv::UBF><<<dim3(8, 17), 64, 0, stream>>>(g, P, ua, MIXn);
            nv::ret_kernel<nv::UBF><<<dim3(4, 17), 256, 0, stream>>>(g, P, ua, MIXn);
            nv::gdn_kernel<nv::UBF><<<dim3(4, 17), 256, 0, stream>>>(g, P, ua, MIXn);
        }
        if (k == 3) copy_rows<<<SUBR, 256, 0, stream>>>(XF, XFc);
        a.ph_lo = ph; a.ph_hi = ph + 1;
        hipLaunchKernelGGL(mk_fwd, dim3(grid), dim3(NTHR), LDS_BYTES, stream, a);
        if (ph == 0 || k == 4) { const int ln = l + 1;
            if (ln < DEPTH) {
                if (ln == 0) chk_x0<<<SUBR, 256, 0, stream>>>(XF, io.in[0], io.in[1], io.in[7], err, 18 * ln + 0);
                chk_rows_in<<<SUBR, 256, 0, stream>>>(XF, XB, GAB, io.in[8] + (size_t)ln * DM * DINX, err, 18 * ln + 0);
                chk_wt<<<1024, 256, 0, stream>>>((const bf16*)(ws + WS_WINT), io.in[8] + (size_t)ln * DM * DINX, DINX, DM, DIN, err, 18 * ln + 1);
                chk_wt<<<512, 256, 0, stream>>>((const bf16*)(ws + WS_WOUTT), io.in[22] + (size_t)ln * DMIX * DM, DM, DMIX, DM, err, 18 * ln + 1);
                for (int gt = 0; gt < 2; ++gt) for (int n = 0; n < 8; ++n)
                    chk_wt<<<4, 256, 0, stream>>>((const bf16*)(ws + WS_GATEW) + (size_t)(gt * 8 + n) * 4096, io.in[gt ? 13 : 11] + ((size_t)ln * 8 + n) * 4096, 64, 64, 64, err, 18 * ln + 1);
            }
        }
        if (k == 0) chk_u<<<dim3(DIN / 256, SUBR), 256, 0, stream>>>(XF, io.in[8] + (size_t)l * DM * DINX, U, err, 18 * l + 2);
        if (k == 2) {
            chk_mix<<<SUBR, 256, 0, stream>>>(MIX, MIXn, err, 18 * l + 3);
            chk_vec<<<8, 256, 0, stream>>>(CST + C_HP, out + O_HP + (size_t)(l * NB) * 512, 512, err, 18 * l + 9);
            chk_vec<<<8, 256, 0, stream>>>(CST + C_CP, out + O_CP + (size_t)(l * NB) * 1536, 1536, err, 18 * l + 10);
            chk_vec<<<8, 256, 0, stream>>>(CST + C_GCP, out + O_GCP + (size_t)(l * NB) * 4608, 4608, err, 18 * l + 10);
            chk_vec<<<64, 256, 0, stream>>>(CST + C_RP, out + O_RP + (size_t)(l * NB) * 65536, 65536, err, 18 * l + 11);
            chk_vec<<<64, 256, 0, stream>>>(CST + C_GP, out + O_GP + (size_t)(l * NB) * 65536, 65536, err, 18 * l + 12);
            chk_vec<<<16, 256, 0, stream>>>(CST + C_HS, out + O_HS + (size_t)(l * NS) * 512, 16 * 512, err, 18 * l + 13);
            chk_vec<<<16, 256, 0, stream>>>(CST + C_CS, out + O_CS + (size_t)(l * NS) * 1536, 16 * 1536, err, 18 * l + 14);
            chk_vec<<<16, 256, 0, stream>>>(CST + C_GCS, out + O_GCS + (size_t)(l * NS) * 4608, 16 * 4608, err, 18 * l + 14);
            chk_vec<<<256, 256, 0, stream>>>(CST + C_RS, out + O_RS + (size_t)(l * NS) * 65536, 16 * 65536, err, 18 * l + 15);
            chk_vec<<<256, 256, 0, stream>>>(CST + C_GS, out + O_GS + (size_t)(l * NS) * 65536, 16 * 65536, err, 18 * l + 16);
        }
        if (k == 4) chk_out<<<SUBR, 256, 0, stream>>>(XFc, MIX, io.in[22] + (size_t)l * DMIX * DM, io.in[23] + (size_t)l * DM, io.in[24] + (size_t)l * DM,
                                                     XF, out + O_YP, out + O_YS, l == DEPTH - 1, err, 18 * l + 17);
    }
    nv::run(io, nv::Grp{0, 4, 0, 64}, ws, stream);
    nv::run(io, nv::Grp{4, 4, 64, 64}, ws, stream);
    dbg_eval<<<1, 64, 0, stream>>>(err, MK_PROBE);
    dbg_apply<<<128, 256, 0, stream>>>(err, out + O_YS);
#else
#if MK_LAUNCH_PER_PHASE
    for (int ph = 0; ph < N_PHASES; ++ph) { a.ph_lo = ph; a.ph_hi = ph + 1; hipLaunchKernelGGL(mk_fwd, dim3(grid), dim3(NTHR), LDS_BYTES, stream, a); }
#else
    a.ph_lo = 0; a.ph_hi = N_PHASES;
    hipLaunchKernelGGL(mk_fwd, dim3(grid), dim3(NTHR), LDS_BYTES, stream, a);
#endif
#endif
}
```

```cpp
#include <hip/hip_runtime.h>
#include <cstdio>
#include <cstdint>
#define MK_DEBUG 0
#define MK_PROBE -1
#define MK_LAUNCH_PER_PHASE 0
#define MK_TMASK 0u
#define MK_TMODE 0
#define MK_TBLOCK 0
#define MK_TSUB 0
#define MK_TTHREAD 0

namespace fx {
#define GAS __attribute__((address_space(1)))
#define LAS __attribute__((address_space(3)))
#define DI __device__ __forceinline__
typedef unsigned short bf16;
typedef short bf16x8 __attribute__((ext_vector_type(8)));
typedef float f32x4 __attribute__((ext_vector_type(4)));
typedef float f32x2 __attribute__((ext_vector_type(2)));
typedef unsigned u32x4 __attribute__((ext_vector_type(4)));
typedef unsigned u32x2 __attribute__((ext_vector_type(2)));
typedef GAS unsigned gu32;

constexpr int NWAVES = 8, NTHR = 512;
constexpr int DM = 1024, TP = 2064, NB = 8, NS = 128, MP = NB * TP, M = MP + NS, DIN = 5120, DINX = 5128, DMIX = 1536, DEPTH = 4, NCH = 33, NCHH = NB * NCH * 4;
constexpr float EPS = 1e-6f, ALPHA = 1.681792830507429f, QSCALE = 0.08838834764831845f;

constexpr size_t MiB = 1u << 20;
constexpr size_t WS_CTL = 0, CTL_ZERO_BYTES = 1 * MiB;
constexpr size_t WS_TAB = 1 * MiB;
constexpr size_t WS_GATEW = 3 * MiB;
constexpr size_t WS_WINT = 4 * MiB;
constexpr size_t WS_WOUTT = 14 * MiB;
constexpr size_t WS_GAB = 17 * MiB;
constexpr size_t WS_RGS = 18 * MiB;
constexpr size_t WS_EGL = 20 * MiB;
constexpr size_t WS_XB = 21 * MiB;
constexpr size_t WS_XF = 54 * MiB;
constexpr size_t WS_U = 119 * MiB;
constexpr size_t WS_MIX = 282 * MiB;
constexpr size_t WS_BETA = 331 * MiB;
constexpr size_t WS_GDN = 348 * MiB;
constexpr size_t WS_RET = 423 * MiB;
constexpr size_t WS_DBG = 465 * MiB;
constexpr size_t WS_WINT1 = 470 * MiB;
constexpr size_t WS_GATEW1 = 3 * MiB + 512 * 1024;
constexpr size_t WS_WOUTT1 = 508 * MiB;
constexpr size_t WS_END = 512 * MiB;
constexpr size_t T16 = 16384, T8 = 8192;
constexpr size_t G_W = WS_GDN, G_QG = G_W + NCHH * T16, G_KDT = G_QG + NCHH * T16, G_UT = G_KDT + NCHH * T16, G_ATT = G_UT + NCHH * T16;
constexpr size_t R_KRT = WS_RET, R_VT = R_KRT + NCHH * T16, R_SC = R_VT + NCHH * T16;
constexpr size_t S_QH = WS_MIX, S_KH = S_QH + NCHH * T16, S_RWT = 481 * MiB;
static_assert(G_ATT + NCHH * T8 <= WS_RET && R_SC + NCHH * T8 <= WS_DBG, "ws map");
static_assert(S_KH + NCHH * T16 <= WS_BETA && S_RWT >= WS_WINT1 + 10 * MiB && S_RWT + NCHH * T16 <= WS_WOUTT1, "ws alias map");
constexpr int CW_BAR = 4096;
constexpr int CW_PANEL = 32768;
constexpr int CW_Q = 16384;

constexpr int RING_BYTES = 131072;
constexpr int PRIV_BYTES = 18432;
constexpr int MISC_OFF = 147456;
constexpr int LDS_BYTES = 149504;

constexpr size_t O_YP = 0, O_YS = 16777216, O_HP = 16908288, O_CP = 16924672, O_RP = 16973824, O_GCP = 19070976, O_GP = 19218432,
                 O_HS = 21315584, O_CS = 21577728, O_RS = 22364160, O_GCS = 55918592, O_GS = 58277888, O_END = 91832320;

typedef __bf16 bf16x2_t __attribute__((ext_vector_type(2)));
DI unsigned pk2(float lo, float hi) { const bf16x2_t r = __builtin_convertvector((f32x2){lo, hi}, bf16x2_t); return __builtin_bit_cast(unsigned, r); }
DI unsigned f2bf(float f) { return pk2(f, 0.f) & 0xffffu; }
DI float bflo(unsigned w) { return __builtin_bit_cast(float, w << 16); }
DI float bfhi(unsigned w) { return __builtin_bit_cast(float, w & 0xffff0000u); }
DI float bf2f(bf16 h) { return __builtin_bit_cast(float, (unsigned)h << 16); }
DI void unpack8(const u32x4 w, float (&x)[8]) { x[0] = bflo(w.x); x[1] = bfhi(w.x); x[2] = bflo(w.y); x[3] = bfhi(w.y); x[4] = bflo(w.z); x[5] = bfhi(w.z); x[6] = bflo(w.w); x[7] = bfhi(w.w); }
DI u32x4 pack8(const float (&x)[8]) { u32x4 w; w.x = pk2(x[0], x[1]); w.y = pk2(x[2], x[3]); w.z = pk2(x[4], x[5]); w.w = pk2(x[6], x[7]); return w; }
DI u32x2 pack4(const f32x4 v) { u32x2 w; w.x = pk2(v[0], v[1]); w.y = pk2(v[2], v[3]); return w; }
DI f32x4 unpack4(const u32x2 w) { return (f32x4){bflo(w.x), bfhi(w.x), bflo(w.y), bfhi(w.y)}; }
DI float sigmoidf_(float x) { return __builtin_amdgcn_rcpf(1.f + __expf(-x)); }
DI float siluf_(float x) { return x * __builtin_amdgcn_rcpf(1.f + __expf(-x)); }
DI float softplusf_(float x) { const float e = __expf(-fabsf(x)); const float l = e < 1e-3f ? e * (1.f - 0.5f * e) : __logf(1.f + e); return fmaxf(x, 0.f) + l; }
template <int CTRL> DI float dpp_f(float old, float x) { return __builtin_bit_cast(float, __builtin_amdgcn_update_dpp(__builtin_bit_cast(int, old), __builtin_bit_cast(int, x), CTRL, 0xf, 0xf, false)); }
DI float row_sum16(float x) {
    x += dpp_f<0xB1>(0.f, x);
    x += dpp_f<0x4E>(0.f, x);
    x += dpp_f<0x141>(0.f, x);
    x += dpp_f<0x140>(0.f, x);
    return x;
}
DI float rdlane(float x, int l) { return __builtin_bit_cast(float, __builtin_amdgcn_readlane(__builtin_bit_cast(int, x), l)); }
DI float wave_sum(float v) { v = row_sum16(v); return (rdlane(v, 0) + rdlane(v, 16)) + (rdlane(v, 32) + rdlane(v, 48)); }
DI float row_bcast15(float x) { return __builtin_bit_cast(float, __builtin_amdgcn_ds_swizzle(__builtin_bit_cast(int, x), 0x1F0)); }
DI float neg_expm1f_(float x) {
    const float ser = -x * (1.f + x * (0.5f + x * (0.16666667f + x * (0.041666668f + x * (0.0083333338f + x * 0.0013888889f)))));
    return x > -0.25f ? ser : 1.f - __expf(x);
}
#define LDS_WAIT() asm volatile("s_waitcnt lgkmcnt(0)" ::: "memory")
#define VM_WAIT() asm volatile("s_waitcnt vmcnt(0)" ::: "memory")
DI f32x4 mfma16(bf16x8 a, bf16x8 b, f32x4 c) { return __builtin_amdgcn_mfma_f32_16x16x32_bf16(a, b, c, 0, 0, 0); }
#if MK_TMODE == 2
#define TS_BEGIN(id) do { if ((id) == MK_TSUB && blockIdx.x == MK_TBLOCK && threadIdx.x == MK_TTHREAD) *(volatile LAS unsigned long long*)(size_t)(MISC_OFF + 80) = __builtin_amdgcn_s_memrealtime(); } while (0)
#define TS_END(id) do { if ((id) == MK_TSUB && blockIdx.x == MK_TBLOCK && threadIdx.x == MK_TTHREAD) *(volatile LAS unsigned long long*)(size_t)(MISC_OFF + 72) += __builtin_amdgcn_s_memrealtime() - *(volatile LAS unsigned long long*)(size_t)(MISC_OFF + 80); } while (0)
#else
#define TS_BEGIN(id) do { } while (0)
#define TS_END(id) do { } while (0)
#endif
}

namespace pg8 {
#define PG8_LAS __attribute__((address_space(3)))
typedef unsigned short bf16_t;
typedef short bf16x8 __attribute__((ext_vector_type(8)));
typedef float f32x4 __attribute__((ext_vector_type(4)));
typedef unsigned u32x4 __attribute__((ext_vector_type(4)));
constexpr int BM = 256, BK = 64, HALF = 128, HTB = HALF * BK * 2  , STAGE_BYTES = 8 * HTB, NXCD = 8, WGM = 8;

__host__ __device__ __forceinline__ int lds_byte(int r, int c) { const int st = (r >> 4) * 2 + (c >> 5), rr = r & 15, cc = c & 31, ob = rr * 64 + cc * 2; return st * 1024 + (ob ^ (((ob >> 9) & 1) << 5)); }
__host__ __device__ __forceinline__ void stage_rc(int b, int& R, int& C) { const int st = b / 1024, sb = b % 1024, swz = sb ^ (((sb >> 9) & 1) << 5); R = (st >> 1) * 16 + swz / 64; C = (st & 1) * 32 + (swz % 64) / 2; }
__host__ __device__ __forceinline__ int perm32(int rho) { const int n = rho >> 4, i = rho & 15; return 8 * (i >> 2) + 4 * n + (i & 3); }

struct Unit { int pm, pn, ko; };
struct Gemm { const bf16_t* A; const bf16_t* Bt; int M, N, K, ld; };

struct StaticOrder {
    int nM, nN, nwg, G, c;
    __host__ __device__ void init(int M, int N, int G_, int c_) { nM = M / BM; nN = N / BM; nwg = nM * nN; G = G_; c = c_; }
    __host__ __device__ bool next(int i, Unit& u) const {
        const long L = (long)i * G + c; if (L >= nwg) return false;
        int wgid = (int)L; { const int q = nwg / NXCD, r = nwg % NXCD, xcd = wgid % NXCD, off = wgid / NXCD; wgid = (xcd < r ? xcd * (q + 1) : r * (q + 1) + (xcd - r) * q) + off; }
        const int nig = WGM * nN, gid = wgid / nig, fm = gid * WGM, gsz = (nM - fm) < WGM ? (nM - fm) : WGM;
        u.pm = fm + ((wgid % nig) % gsz); u.pn = (wgid % nig) / gsz; u.ko = 0; return true;
    }
    __device__ __forceinline__ void a_ready(const Unit&) const {}
    __device__ __forceinline__ void done(const Unit&) const {}
};


__device__ __forceinline__ unsigned cvt_pk_bf16(float lo, float hi) { unsigned r; asm volatile("v_cvt_pk_bf16_f32 %0, %1, %2" : "=v"(r) : "v"(lo), "v"(hi)); return r; }
struct EpiU {
    static constexpr bool PERM = true, AFTER_DRAIN = false;
    bf16_t* O; int ldc;
    __device__ __forceinline__ void operator()(const f32x4 (&acc)[2][2][4][2], const Unit& u, int wr, int wc, int fr, int fq) const {
        const int row0 = u.pm * BM + wr * 64 + fr, col0 = u.pn * BM + wc * 32 + 8 * fq;
#pragma unroll
        for (int ai = 0; ai < 2; ++ai)
#pragma unroll
            for (int m = 0; m < 4; ++m) { bf16_t* rowp = O + (size_t)(row0 + ai * HALF + m * 16) * ldc + col0;
#pragma unroll
                for (int bj = 0; bj < 2; ++bj) { const f32x4 v0 = acc[ai][bj][m][0], v1 = acc[ai][bj][m][1];
                    u32x4 w; w.x = cvt_pk_bf16(v0[0], v0[1]); w.y = cvt_pk_bf16(v0[2], v0[3]); w.z = cvt_pk_bf16(v1[0], v1[1]); w.w = cvt_pk_bf16(v1[2], v1[3]);
                    *(u32x4*)(rowp + bj * HALF) = w; } }
    }
};
struct SliceOrder {
    int pm, nitems, G, c, kslice;
    __device__ __forceinline__ bool next(int i, Unit& u) const { const int id = i * G + c; if (id >= nitems) return false; u.pm = pm; u.pn = id & 3; u.ko = (id >> 2) * kslice; return true; }
    __device__ __forceinline__ void a_ready(const Unit&) const {}
    __device__ __forceinline__ void done(const Unit&) const {}
};
struct EpiAcc {
    static constexpr bool PERM = false, AFTER_DRAIN = false;
    float* Y; const bf16_t* XB; int ldc; float alpha;
    __device__ __forceinline__ void operator()(const f32x4 (&acc)[2][2][4][2], const Unit& u, int wr, int wc, int fr, int fq) const {
        typedef unsigned u32x2v __attribute__((ext_vector_type(2)));
        const int col0 = u.pn * BM + wc * 32 + 4 * fq;
#pragma unroll
        for (int ai = 0; ai < 2; ++ai) {
            u32x2v res[4][2][2];
#pragma unroll
            for (int m = 0; m < 4; ++m) { const int r = u.pm * BM + ai * HALF + wr * 64 + m * 16 + fr; const bf16_t* rowp = XB + (size_t)r * ldc + col0;
#pragma unroll
                for (int bj = 0; bj < 2; ++bj)
#pragma unroll
                    for (int n = 0; n < 2; ++n) res[m][bj][n] = *(const u32x2v*)(rowp + bj * HALF + n * 16); }
#pragma unroll
            for (int m = 0; m < 4; ++m) { const int r = u.pm * BM + ai * HALF + wr * 64 + m * 16 + fr; float* rowp = Y + (size_t)r * ldc + col0;
#pragma unroll
                for (int bj = 0; bj < 2; ++bj)
#pragma unroll
                    for (int n = 0; n < 2; ++n) { const u32x2v w = res[m][bj][n];
                        const f32x4 x = (f32x4){__builtin_bit_cast(float, w.x << 16), __builtin_bit_cast(float, w.x & 0xffff0000u), __builtin_bit_cast(float, w.y << 16), __builtin_bit_cast(float, w.y & 0xffff0000u)};
                        *(f32x4*)(rowp + bj * HALF + n * 16) = x * alpha + acc[ai][bj][m][n]; } }
            asm volatile("" ::: "memory"); }
    }
};
struct EpiRes {
    static constexpr bool PERM = false, AFTER_DRAIN = false;
    float* X; int ldc; float alpha;
    __device__ __forceinline__ void operator()(const f32x4 (&acc)[2][2][4][2], const Unit& u, int wr, int wc, int fr, int fq) const {
        const int col0 = u.pn * BM + wc * 32 + 4 * fq;
#pragma unroll
        for (int ai = 0; ai < 2; ++ai)
#pragma unroll
            for (int m = 0; m < 4; ++m) { const int r = u.pm * BM + ai * HALF + wr * 64 + m * 16 + fr; float* rowp = X + (size_t)r * ldc + col0;
#pragma unroll
                for (int bj = 0; bj < 2; ++bj)
#pragma unroll
                    for (int n = 0; n < 2; ++n) { f32x4* p = (f32x4*)(rowp + bj * HALF + n * 16); const f32x4 b = *p; *p = b * alpha + acc[ai][bj][m][n]; }
                asm volatile("" ::: "memory"); }
    }
};

template <class Epi, class Sched, bool ALIGN_EPI = false, bool SP2 = false>
__device__ __forceinline__ void gemm_phase(PG8_LAS unsigned char* lds, const Gemm g, const Sched& S, const Epi& E) {
    int tid_ = threadIdx.x; asm volatile("" : "+v"(tid_));
    const int tid = tid_, wid = __builtin_amdgcn_readfirstlane(tid >> 6), lane = tid & 63, wr = wid >> 2, wc = wid & 3, fr = lane & 15, fq = lane >> 4;
    const int K = g.K, nt = K / BK;
    unsigned voffA[2], voffB[2];
#pragma unroll
    for (int i = 0; i < 2; ++i) { int R, C; stage_rc(tid * 16 + i * 8192, R, C); const int Rb = Epi::PERM ? ((R & ~31) + perm32(R & 31)) : R;
        voffA[i] = (unsigned)(R * g.ld + C) * 2u; voffB[i] = (unsigned)(Rb * g.ld + C) * 2u; }
    const size_t kstep = (size_t)(BK * 2);
    const size_t hstep = (size_t)HALF * g.ld * 2;
    const size_t tstep = 2 * hstep;
    const unsigned ldsw = (unsigned)wid * 1024u;
    const int aoff = lds_byte(wr * 64 + fr, fq * 8), boff = lds_byte(wc * 32 + fr, fq * 8);
#define PG8_SA(b, h) (((b) * 2 + (h)) * HTB)
#define PG8_SB(b, h) ((4 + (b) * 2 + (h)) * HTB)
#define PG8_STAGE(bufoff, gbase, voff) do { _Pragma("unroll") for (int _i = 0; _i < 2; ++_i) \
        __builtin_amdgcn_global_load_lds((const unsigned*)((const char*)(gbase) + (voff)[_i]), (PG8_LAS unsigned*)(lds + (bufoff) + ldsw + _i * 8192), 16, 0, 0); } while (0)
#define PG8_LDA(dst, b, h) do { _Pragma("unroll") for (int m = 0; m < 4; ++m) _Pragma("unroll") for (int k = 0; k < 2; ++k) dst[m][k] = *(const PG8_LAS bf16x8*)(lds + PG8_SA(b, h) + aoff + m * 2048 + k * 1024); } while (0)
#define PG8_LDB(dst, b, h) do { _Pragma("unroll") for (int n = 0; n < 2; ++n) _Pragma("unroll") for (int k = 0; k < 2; ++k) dst[n][k] = *(const PG8_LAS bf16x8*)(lds + PG8_SB(b, h) + boff + n * 2048 + k * 1024); } while (0)
#define PG8_MMA(ai, bj, At, Bt) do { __builtin_amdgcn_s_setprio(1); _Pragma("unroll") for (int m = 0; m < 4; ++m) _Pragma("unroll") for (int n = 0; n < 2; ++n) _Pragma("unroll") for (int k = 0; k < 2; ++k) \
        acc[ai][bj][m][n] = __builtin_amdgcn_mfma_f32_16x16x32_bf16(Bt[n][k], At[m][k], acc[ai][bj][m][n], 0, 0, 0); __builtin_amdgcn_s_setprio(0); } while (0)
#define PG8_WAIT_V(n) asm volatile("s_waitcnt vmcnt(" #n ")" ::: "memory")
#define PG8_WAIT_L(n) asm volatile("s_waitcnt lgkmcnt(" #n ")" ::: "memory")
#define PG8_BAR __builtin_amdgcn_s_barrier()
#define PG8_SCHED __builtin_amdgcn_sched_barrier(0)
    Unit cur, nxt; int ui = 0;
    if (!S.next(0, cur)) return;
    f32x4 acc[2][2][4][2];
#pragma unroll
    for (int a = 0; a < 2; ++a)
#pragma unroll
        for (int b = 0; b < 2; ++b)
#pragma unroll
            for (int m = 0; m < 4; ++m)
#pragma unroll
                for (int n = 0; n < 2; ++n) acc[a][b][m][n] = (f32x4){0.f, 0.f, 0.f, 0.f};
    bf16x8 At[4][2], B0[2][2], B1[2][2];
    const char* cA = (const char*)g.A + (size_t)cur.pm * tstep + (size_t)cur.ko * 2; const char* cB = (const char*)g.Bt + (size_t)cur.pn * tstep + (size_t)cur.ko * 2;
    S.a_ready(cur);
    if constexpr (SP2) {
        PG8_STAGE(PG8_SB(0, 0), cB, voffB); PG8_STAGE(PG8_SB(0, 1), cB + hstep, voffB); PG8_STAGE(PG8_SA(0, 0), cA, voffA); PG8_STAGE(PG8_SA(0, 1), cA + hstep, voffA);
        if (wr == 1) PG8_BAR;
        PG8_WAIT_V(2); PG8_BAR;
        PG8_STAGE(PG8_SB(1, 0), cB + kstep, voffB); PG8_STAGE(PG8_SA(1, 0), cA + kstep, voffA); PG8_STAGE(PG8_SB(1, 1), cB + hstep + kstep, voffB);
        PG8_WAIT_V(6); PG8_BAR;
    } else {
        PG8_STAGE(PG8_SB(0, 0), cB, voffB); PG8_STAGE(PG8_SA(0, 0), cA, voffA); PG8_STAGE(PG8_SB(0, 1), cB + hstep, voffB); PG8_STAGE(PG8_SA(0, 1), cA + hstep, voffA);
        if (wr == 1) PG8_BAR;
        PG8_WAIT_V(4); PG8_BAR;
        PG8_STAGE(PG8_SB(1, 0), cB + kstep, voffB); PG8_STAGE(PG8_SA(1, 0), cA + kstep, voffA); PG8_STAGE(PG8_SB(1, 1), cB + hstep + kstep, voffB);
        PG8_WAIT_V(6); PG8_BAR;
    }
    for (;;) {
        const bool has_next = S.next(ui + 1, nxt);
        const char* nA = has_next ? (const char*)g.A + (size_t)nxt.pm * tstep + (size_t)nxt.ko * 2 : cA; const char* nB = has_next ? (const char*)g.Bt + (size_t)nxt.pn * tstep + (size_t)nxt.ko * 2 : cB;
        for (int t = 0; t < nt; t += 2) {
            const bool last = (t == nt - 2);
            const char* a1 = cA + (size_t)(t + 1) * kstep;
            const char* a2 = last ? nA : cA + (size_t)(t + 2) * kstep; const char* b2 = last ? nB : cB + (size_t)(t + 2) * kstep;
            const char* a3 = a2 + kstep; const char* b3 = b2 + kstep;
            if (last && has_next) S.a_ready(nxt);
            if constexpr (SP2) {
            PG8_LDB(B0, 0, 0); PG8_LDB(B1, 0, 1); PG8_SCHED; PG8_LDA(At, 0, 0); PG8_STAGE(PG8_SA(1, 1), a1 + hstep, voffA);
            PG8_WAIT_V(8); PG8_WAIT_L(0); PG8_BAR; PG8_MMA(0, 0, At, B0); PG8_MMA(0, 1, At, B1); PG8_BAR; PG8_SCHED;
            PG8_LDA(At, 0, 1); PG8_STAGE(PG8_SB(0, 0), b2, voffB); PG8_STAGE(PG8_SB(0, 1), b2 + hstep, voffB); PG8_STAGE(PG8_SA(0, 0), a2, voffA);
            PG8_WAIT_V(8); PG8_WAIT_L(0); PG8_BAR; PG8_MMA(1, 0, At, B0); PG8_MMA(1, 1, At, B1); PG8_BAR; PG8_SCHED;
            PG8_LDB(B0, 1, 0); PG8_LDB(B1, 1, 1); PG8_SCHED; PG8_LDA(At, 1, 0); PG8_STAGE(PG8_SA(0, 1), a2 + hstep, voffA);
            PG8_WAIT_V(8); PG8_WAIT_L(0); PG8_BAR; PG8_MMA(0, 0, At, B0); PG8_MMA(0, 1, At, B1); PG8_BAR; PG8_SCHED;
            PG8_LDA(At, 1, 1); PG8_STAGE(PG8_SB(1, 0), b3, voffB); PG8_STAGE(PG8_SB(1, 1), b3 + hstep, voffB); PG8_STAGE(PG8_SA(1, 0), a3, voffA);
            PG8_WAIT_V(8); PG8_WAIT_L(0); PG8_BAR; PG8_MMA(1, 0, At, B0); PG8_MMA(1, 1, At, B1); PG8_BAR; PG8_SCHED;
            } else {
            PG8_LDB(B0, 0, 0); PG8_SCHED; PG8_LDA(At, 0, 0); PG8_STAGE(PG8_SA(1, 1), a1 + hstep, voffA);
            PG8_WAIT_L(8); PG8_BAR; PG8_WAIT_L(0); PG8_MMA(0, 0, At, B0); PG8_BAR; PG8_SCHED;
            PG8_LDB(B1, 0, 1); PG8_STAGE(PG8_SB(0, 0), b2, voffB);
            PG8_BAR; PG8_WAIT_L(0); PG8_MMA(0, 1, At, B1); PG8_BAR;
            PG8_LDA(At, 0, 1); PG8_STAGE(PG8_SA(0, 0), a2, voffA);
            PG8_BAR; PG8_WAIT_L(0); PG8_MMA(1, 0, At, B0); PG8_BAR; PG8_SCHED;
            PG8_STAGE(PG8_SB(0, 1), b2 + hstep, voffB);
            PG8_WAIT_V(6); PG8_BAR; PG8_MMA(1, 1, At, B1); PG8_BAR;
            PG8_LDB(B0, 1, 0); PG8_SCHED; PG8_LDA(At, 1, 0); PG8_STAGE(PG8_SA(0, 1), a2 + hstep, voffA);
            PG8_WAIT_L(8); PG8_BAR; PG8_WAIT_L(0); PG8_MMA(0, 0, At, B0); PG8_BAR; PG8_SCHED;
            PG8_LDB(B1, 1, 1); PG8_STAGE(PG8_SB(1, 0), b3, voffB);
            PG8_BAR; PG8_WAIT_L(0); PG8_MMA(0, 1, At, B1); PG8_BAR;
            PG8_LDA(At, 1, 1); PG8_STAGE(PG8_SA(1, 0), a3, voffA);
            PG8_BAR; PG8_WAIT_L(0); PG8_MMA(1, 0, At, B0); PG8_BAR; PG8_SCHED;
            PG8_STAGE(PG8_SB(1, 1), b3 + hstep, voffB);
            PG8_WAIT_V(6); PG8_BAR; PG8_MMA(1, 1, At, B1); PG8_BAR;
            }
        }
        if constexpr (ALIGN_EPI) { if (wr == 0) PG8_BAR; }
        if constexpr (!Epi::AFTER_DRAIN) { E(acc, cur, wr, wc, fr, fq); S.done(cur); }
        if (!has_next) break;
#pragma unroll
        for (int a = 0; a < 2; ++a)
#pragma unroll
            for (int b = 0; b < 2; ++b)
#pragma unroll
                for (int m = 0; m < 4; ++m)
#pragma unroll
                    for (int n = 0; n < 2; ++n) acc[a][b][m][n] = (f32x4){0.f, 0.f, 0.f, 0.f};
        cur = nxt; cA = nA; cB = nB; ++ui;
        if constexpr (ALIGN_EPI) { if (wr == 1) PG8_BAR; }
    }
    PG8_WAIT_V(0);
    if constexpr (!ALIGN_EPI) { if (wr == 0) PG8_BAR; }
    PG8_BAR;
    if constexpr (Epi::AFTER_DRAIN) { E.fused(acc, cur, wr, wc, fr, fq, lds, wid, lane); S.done(cur); }
#undef PG8_SA
#undef PG8_SB
#undef PG8_STAGE
#undef PG8_LDA
#undef PG8_LDB
#undef PG8_MMA
#undef PG8_WAIT_V
#undef PG8_WAIT_L
#undef PG8_BAR
#undef PG8_SCHED
}
}

namespace fx {
#define XB_TMO      128
#define XB_XCNT(j)  (256  + 64 * (j))
#define XB_XSUB(j)  (1280 + 64 * (j))
#define XB_XGEN(j)  (2304 + 64 * (j))
#define XB_TOP      3328
#define XB_TOPGEN   3392
#define XCD_BAR_WORDS 3456
#define XB_SPIN_CAP (1u << 18)

__device__ __forceinline__ unsigned xb_ld(unsigned* p)              { return __hip_atomic_load(p, __ATOMIC_RELAXED, __HIP_MEMORY_SCOPE_AGENT); }
__device__ __forceinline__ unsigned xb_add(unsigned* p, unsigned v) { return __hip_atomic_fetch_add(p, v, __ATOMIC_RELAXED, __HIP_MEMORY_SCOPE_AGENT); }
__device__ __forceinline__ unsigned xb_xcc_id() { return (unsigned)__builtin_amdgcn_s_getreg((3 << 11) | 20) & 0xFu; }
#define XB_SPIN(cond, bar) do { unsigned _sp = 0; while (cond) { __builtin_amdgcn_s_sleep(1); \
    if ((++_sp & 255u) == 0u) { if (xb_ld(&(bar)[XB_TMO])) break; if (_sp > XB_SPIN_CAP) { atomicAdd(&(bar)[XB_TMO], 1u); break; } } } } while (0)

struct XcdBarrier {
    unsigned* bar; unsigned x;
    volatile LAS unsigned* st;
};

__device__ __forceinline__ XcdBarrier xcd_barrier_post(unsigned* bar, volatile LAS unsigned* st) {
    XcdBarrier b; b.bar = bar; b.x = xb_xcc_id(); b.st = st;
    if (threadIdx.x == 0) (void)xb_add(&bar[XB_XCNT(b.x)], 1u);
    return b;
}
__device__ __forceinline__ void xcd_barrier_complete(unsigned* bar, unsigned x, unsigned& nloc, unsigned& nx) {
    const unsigned G = gridDim.x * gridDim.y * gridDim.z;
    unsigned sum, cnt, mine, sp = 0u;
    for (;;) {
        sum = 0u; cnt = 0u; mine = 0u;
#pragma unroll
        for (unsigned j = 0; j < 16; ++j) { const unsigned c = xb_ld(&bar[XB_XCNT(j)]); sum += c; cnt += (c > 0u) ? 1u : 0u; mine = (j == x) ? c : mine; }
        if (sum == G) break;
        __builtin_amdgcn_s_sleep(1);
        if ((++sp & 255u) == 0u) { if (xb_ld(&bar[XB_TMO])) break; if (sp > XB_SPIN_CAP) { atomicAdd(&bar[XB_TMO], 1u); break; } }
    }
    nloc = mine > 0u ? mine : 1u; nx = cnt > 0u ? cnt : 1u;
}

__device__ __forceinline__ void xcd_barrier(const XcdBarrier& b) {
    asm volatile("s_waitcnt vmcnt(0)" ::: "memory");
    __syncthreads();
    if (threadIdx.x == 0) {
        unsigned* bar = b.bar;
        __builtin_amdgcn_s_waitcnt(0);
        unsigned nloc = b.st[0], nx = b.st[1];
        if (nloc == 0u) { xcd_barrier_complete(bar, b.x, nloc, nx); b.st[0] = nloc; b.st[1] = nx; }
        const unsigned old = xb_add(&bar[XB_XSUB(b.x)], 1u);
        const unsigned gen = old / nloc;
        if (old + 1u == (gen + 1u) * nloc) {
            __builtin_amdgcn_fence(__ATOMIC_RELEASE, "agent");
            asm volatile("s_waitcnt vmcnt(0)" ::: "memory");
            const unsigned og = xb_add(&bar[XB_TOP], 1u);
            const unsigned tg = og / nx;
            if (og + 1u == (tg + 1u) * nx) xb_add(&bar[XB_TOPGEN], 1u);
            else XB_SPIN(xb_ld(&bar[XB_TOPGEN]) == tg, bar);
            __builtin_amdgcn_fence(__ATOMIC_ACQUIRE, "agent");
            xb_add(&bar[XB_XGEN(b.x)], 1u);
            asm volatile("s_waitcnt vmcnt(0)" ::: "memory");
        } else {
            XB_SPIN(xb_ld(&bar[XB_XGEN(b.x)]) == gen, bar);
            __builtin_amdgcn_fence(__ATOMIC_ACQUIRE, "agent");
            asm volatile("s_waitcnt vmcnt(0)" ::: "memory");
        }
    }
    __syncthreads();
}

struct Args { GAS const float* in[25]; GAS float* out; GAS unsigned char* ws; int ph_lo, ph_hi; };
struct Ctx { LAS unsigned char* lds; int tid, lane, wave, G, bid; };
#if defined(__HIP_DEVICE_COMPILE__)

DI void transpose_item(const float* W, int ldw, int K, int N, bf16* WT, LAS float* scr, int item, int lane) {
    const int nblk = N / 32, kb = item / nblk, nb = item % nblk, k0 = 64 * kb, n0 = 32 * nb;
#pragma unroll 8
    for (int i = 0; i < 32; ++i) { const int kk = 2 * i + (lane >> 5); scr[kk * 33 + (lane & 31)] = W[(size_t)(k0 + kk) * ldw + n0 + (lane & 31)]; }
    LDS_WAIT();
    const int c = lane & 7;
#pragma unroll
    for (int j = 0; j < 4; ++j) { const int n = (lane >> 3) + 8 * j; const LAS float* s = scr + (8 * c) * 33 + n;
        u32x4 o; o.x = pk2(s[0 * 33], s[1 * 33]); o.y = pk2(s[2 * 33], s[3 * 33]); o.z = pk2(s[4 * 33], s[5 * 33]); o.w = pk2(s[6 * 33], s[7 * 33]);
        *(u32x4*)(WT + (size_t)(n0 + n) * K + k0 + 8 * c) = o; }
    LDS_WAIT();
}
DI void convert_weights(const Args& A, const Ctx& C, int l, int gw, int NGW, int lo = 0, int hi = 1 << 30) {
    LAS float* scr = (LAS float*)(C.lds + C.wave * 16384);
    constexpr int I_IN = (DM / 64) * (DIN / 32), I_OUT = (DMIX / 64) * (DM / 32), I_G = 2 * 8 * 2;
    bf16* WinT = (bf16*)(A.ws + ((l & 1) ? WS_WINT1 : WS_WINT)); bf16* WoutT = (bf16*)(A.ws + ((l & 1) ? WS_WOUTT1 : WS_WOUTT)); bf16* GW = (bf16*)(A.ws + ((l & 1) ? WS_GATEW1 : WS_GATEW));
    for (int it = lo + gw; it < I_IN + I_OUT + I_G && it < hi; it += NGW) {
        int r = it;
        if (r < I_IN) { transpose_item(A.in[8] + (size_t)l * DM * DINX, DINX, DM, DIN, WinT, scr, r, C.lane); continue; } r -= I_IN;
        if (r < I_OUT) { transpose_item(A.in[22] + (size_t)l * DMIX * DM, DM, DMIX, DM, WoutT, scr, r, C.lane); continue; } r -= I_OUT;
        const int gate = r / 16, n = (r % 16) / 2, sub = r % 2;
        transpose_item(A.in[gate ? 13 : 11] + ((size_t)l * 8 + n) * 4096, 64, 64, 64, GW + (size_t)(gate * 8 + n) * 4096, scr, sub, C.lane);
    }
}
DI void build_rope_table(const Args& A, const Ctx& C) {
    f32x2* TAB = (f32x2*)(A.ws + WS_TAB);
    for (int e = C.bid * NTHR + C.tid; e < 2065 * 64; e += C.G * NTHR) {
        const int p = e >> 6, i = e & 63; const float pos = p < 2064 ? (float)p : 16384.f;
        const float inv = exp2f(-(float)i * (13.287712379549449f / 64.f));
        const float ang = pos * inv;
        const double rev = (double)ang * 0.15915494309189535; const double fr = rev - rint(rev);
        const float r = (float)(fr * 6.283185307179586);
        TAB[e] = (f32x2){__cosf(r), __sinf(r)};
    }
}
DI void wait_panel(const Args& A, int lnext, int pm) {
    if (threadIdx.x == 0) {
        unsigned* cnt = (unsigned*)(A.ws + WS_CTL) + CW_PANEL + ((lnext - 1) * 65 + pm) * 64;
        unsigned spins = 0;
        while (__hip_atomic_load(cnt, __ATOMIC_RELAXED, __HIP_MEMORY_SCOPE_AGENT) < 32u) { __builtin_amdgcn_s_sleep(32); if (++spins > (1u << 20)) break; }
        __builtin_amdgcn_fence(__ATOMIC_ACQUIRE, "agent");
        asm volatile("s_waitcnt vmcnt(0)" ::: "memory");
    }
    __syncthreads();
}
DI void row_pass(const Args& A, const Ctx& C, int lnext) {
    const int gw = C.bid * NWAVES + C.wave, NGW = C.G * NWAVES, lane = C.lane;
    float* XF = (float*)(A.ws + WS_XF); bf16* XB = (bf16*)(A.ws + WS_XB); float* GAB = (float*)(A.ws + WS_GAB);
    const int nmain = M / NGW, nrow = nmain + ((nmain * NGW + gw) < M ? 1 : 0);
    LAS float* WG = (LAS float*)C.lds;
    __syncthreads();
    if (lnext < DEPTH) { const float* wg = A.in[8] + (size_t)lnext * DM * DINX + DIN;
        for (int k = C.tid; k < DM; k += NTHR) { const f32x4 w0 = *(const f32x4*)(wg + (size_t)k * DINX), w1 = *(const f32x4*)(wg + (size_t)k * DINX + 4);
            WG[0 * DM + k] = w0[0]; WG[1 * DM + k] = w0[1]; WG[2 * DM + k] = w0[2]; WG[3 * DM + k] = w0[3]; WG[4 * DM + k] = w1[0]; WG[5 * DM + k] = w1[1]; WG[6 * DM + k] = w1[2]; WG[7 * DM + k] = w1[3]; }
        __syncthreads(); }
    f32x4 vn[4];
#define ROW_OF(i) ((i) < nmain ? gw * nmain + (i) : nmain * NGW + gw)
#define ROW_LOAD(i) do { const int m_ = ROW_OF(i); const float* src_; \
        if (lnext == 0) { if (m_ < MP) { const int b_ = m_ / TP, t_ = m_ % TP; src_ = t_ < 16 ? (const float*)(A.in[7] + (size_t)t_ * DM) : (const float*)(A.in[0] + ((size_t)b_ * 2048 + (t_ - 16)) * DM); } \
                          else src_ = (const float*)(A.in[1] + (size_t)(m_ - MP) * DM); } \
        else src_ = XF + (size_t)m_ * DM; \
        _Pragma("unroll") for (int j = 0; j < 4; ++j) vn[j] = *(const f32x4*)(src_ + 4 * lane + 256 * j); } while (0)
    const bool blk_has_extra = (nmain * NGW + C.bid * NWAVES) < M;
    if (nmain > 0) ROW_LOAD(0);
#pragma unroll 1
    for (int i = 0; i < nrow; ++i) {
        if (i == nmain && lnext != 0) { }
        const int m = ROW_OF(i);
        f32x4 v[4];
#pragma unroll
        for (int j = 0; j < 4; ++j) v[j] = vn[j];
        if (i + 1 < nmain) ROW_LOAD(i + 1);
        else if (i + 1 == nmain && i + 1 < nrow) ROW_LOAD(i + 1);
        if (lnext != 0) {
            float s = 0.f;
#pragma unroll
            for (int j = 0; j < 4; ++j) s += (v[j][0] + v[j][1]) + (v[j][2] + v[j][3]);
            const float mean = wave_sum(s) * (1.f / DM); float q = 0.f;
#pragma unroll
            for (int j = 0; j < 4; ++j) { v[j] = v[j] - mean; q += (v[j][0] * v[j][0] + v[j][1] * v[j][1]) + (v[j][2] * v[j][2] + v[j][3] * v[j][3]); }
            const float rstd = rsqrtf(wave_sum(q) * (1.f / DM) + EPS);
            const float* lw = A.in[23] + (size_t)(lnext - 1) * DM; const float* lb = A.in[24] + (size_t)(lnext - 1) * DM;
#pragma unroll
            for (int j = 0; j < 4; ++j) { const f32x4 w = *(const f32x4*)(lw + 4 * lane + 256 * j), b = *(const f32x4*)(lb + 4 * lane + 256 * j); v[j] = v[j] * rstd * w + b; }
        }
        if (lnext < DEPTH) {
#pragma unroll
            for (int j = 0; j < 4; ++j) *(u32x2*)(XB + (size_t)m * DM + 4 * lane + 256 * j) = pack4(v[j]);
            float acc[8];
#pragma unroll
            for (int q = 0; q < 8; ++q) { float s = 0.f;
#pragma unroll
                for (int j = 0; j < 4; ++j) { const f32x4 w = *(const LAS f32x4*)(WG + q * DM + 4 * lane + 256 * j); s += (v[j][0] * w[0] + v[j][1] * w[1]) + (v[j][2] * w[2] + v[j][3] * w[3]); }
                acc[q] = s; }
#pragma unroll
            for (int q = 0; q < 8; ++q) acc[q] = wave_sum(acc[q]);
            if (lane == 0) { *(f32x4*)(GAB + (size_t)m * 8) = (f32x4){acc[0], acc[1], acc[2], acc[3]}; *(f32x4*)(GAB + (size_t)m * 8 + 4) = (f32x4){acc[4], acc[5], acc[6], acc[7]}; }
        } else {
            float* dst = nullptr;
            if (m < MP) { const int b = m / TP, t = m % TP; if (t >= 16) dst = (float*)(A.out + O_YP + ((size_t)b * 2048 + (t - 16)) * DM); }
            else dst = (float*)(A.out + O_YS + (size_t)(m - MP) * DM);
            if (dst) {
#pragma unroll
                for (int j = 0; j < 4; ++j) *(f32x4*)(dst + 4 * lane + 256 * j) = v[j]; }
        }
    }
#undef ROW_OF
#undef ROW_LOAD
}

DI int tsw(int i, int ch) { return i * 128 + ((ch ^ ((i >> 3) & 7)) << 3); }
DI void transpose_out(const LAS bf16* T, bf16* outT, int lane) {
    const int dl = lane >> 3, i8 = lane & 7;
#pragma unroll 2
    for (int d0 = 0; d0 < 16; ++d0) { const LAS bf16* s = T + (i8 * 8) * 128 + ((d0 ^ i8) << 3) + dl; u32x4 w;
        w.x = (unsigned)s[0 * 128] | ((unsigned)s[1 * 128] << 16); w.y = (unsigned)s[2 * 128] | ((unsigned)s[3 * 128] << 16);
        w.z = (unsigned)s[4 * 128] | ((unsigned)s[5 * 128] << 16); w.w = (unsigned)s[6 * 128] | ((unsigned)s[7 * 128] << 16);
        *(u32x4*)(outT + (d0 * 8 + dl) * 64 + i8 * 8) = w; }
}

DI void p2_gdn_item(const Args& A, const Ctx& C, LAS unsigned char* pl, int l, int item) {
    const int lane = C.lane, fr = lane & 15, fq = lane >> 4;
    const int CH = item, h = item & 3, bc = item >> 2, c = bc % NCH, b = bc / NCH;
    const int t0 = 64 * c - 48; const size_t mrow0 = (size_t)b * TP;
    bf16* U = (bf16*)(A.ws + WS_U); const float* GAB = (const float*)(A.ws + WS_GAB);
    LAS float* Amat = (LAS float*)pl; LAS bf16* T = (LAS bf16*)pl; LAS float* scb = (LAS float*)(pl + 17408);
    bf16* QH = (bf16*)(A.ws + S_QH) + (size_t)CH * 8192; bf16* KH = (bf16*)(A.ws + S_KH) + (size_t)CH * 8192; bf16* RWT = (bf16*)(A.ws + S_RWT) + (size_t)CH * 8192;
    bf16* Wg = (bf16*)(A.ws + G_W) + (size_t)CH * 8192; bf16* QG = (bf16*)(A.ws + G_QG) + (size_t)CH * 8192; bf16* KDT = (bf16*)(A.ws + G_KDT) + (size_t)CH * 8192;
    bf16* UT = (bf16*)(A.ws + G_UT) + (size_t)CH * 8192; bf16* ATT = (bf16*)(A.ws + G_ATT) + (size_t)CH * 4096; float* EGL = (float*)(A.ws + WS_EGL);
    TS_BEGIN(8); TS_BEGIN(1);
    {
        const int t = t0 + lane; float g = 0.f, beta = 0.f;
        if (t >= 0) { const float* gp = GAB + (mrow0 + t) * 8; g = -__expf(A.in[19][l * 4 + h]) * softplusf_(gp[h] + A.in[20][l * 4 + h]); beta = sigmoidf_(gp[4 + h]); }
        float gc = g;
#pragma unroll
        for (int off = 1; off < 64; off <<= 1) { const float nb = __shfl_up(gc, off); if (lane >= off) gc += nb; }
        scb[lane] = beta; scb[64 + lane] = gc;
        const float gl = __shfl(gc, 63);
        if (lane == 0) EGL[CH] = __expf(gl);
    }
    LDS_WAIT();
    const float g_last = scb[64 + 63];
    TS_END(1); TS_BEGIN(2);
    const int tbk = lane >> 4, grp = lane & 15;
#pragma unroll 1
    for (int part = 0; part < 3; ++part) {
        const int chb = part * 512 + h * 128 + grp * 8;
        const float* cw = A.in[18] + (size_t)l * 4 * 1536 + chb;
        float wgt[4][8];
#pragma unroll
        for (int j = 0; j < 4; ++j) { const f32x4 a = *(const f32x4*)(cw + j * 1536), bq = *(const f32x4*)(cw + j * 1536 + 4);
            wgt[j][0] = a[0]; wgt[j][1] = a[1]; wgt[j][2] = a[2]; wgt[j][3] = a[3]; wgt[j][4] = bq[0]; wgt[j][5] = bq[1]; wgt[j][6] = bq[2]; wgt[j][7] = bq[3]; }
#pragma unroll 1
        for (int half = 0; half < 2; ++half) {
            const int i0 = tbk * 16 + half * 8;
            u32x4 raw[11];
#pragma unroll
            for (int jj = 0; jj < 11; ++jj) { const int tt = t0 + i0 - 3 + jj; raw[jj] = (u32x4){0u, 0u, 0u, 0u}; if (tt >= 0) raw[jj] = *(const u32x4*)(U + (mrow0 + tt) * DIN + 3072 + chb); }
#pragma unroll
            for (int e8 = 0; e8 < 8; ++e8) {
                const int i = i0 + e8;
                float y[8];
#pragma unroll
                for (int e = 0; e < 8; ++e) y[e] = 0.f;
#pragma unroll
                for (int j = 0; j < 4; ++j) { float x[8]; unpack8(raw[e8 + j], x);
#pragma unroll
                    for (int e = 0; e < 8; ++e) y[e] = fmaf(wgt[j][e], x[e], y[e]); }
                if (c == NCH - 1 && i >= 61) { float x3[8]; unpack8(raw[e8 + 3], x3); float* o = A.out + O_GCP + ((size_t)(l * NB + b) * 3 + (i - 61)) * 1536 + chb;
                    *(f32x4*)o = (f32x4){x3[0], x3[1], x3[2], x3[3]}; *(f32x4*)(o + 4) = (f32x4){x3[4], x3[5], x3[6], x3[7]}; }
#pragma unroll
                for (int e = 0; e < 8; ++e) y[e] = siluf_(y[e]);
                const float beta_i = scb[i], gc_i = scb[64 + i];
                if (part < 2) {
                    float ss = 0.f;
#pragma unroll
                    for (int e = 0; e < 8; ++e) ss = fmaf(y[e], y[e], ss);
                    ss = row_sum16(ss);
                    const float rn = rsqrtf(ss + EPS) * (part == 0 ? QSCALE : 1.f);
#pragma unroll
                    for (int e = 0; e < 8; ++e) y[e] *= rn;
                }
                if (part == 0) {
                    *(u32x4*)(QH + i * 128 + grp * 8) = pack8(y);
                    const float eg = __expf(gc_i);
#pragma unroll
                    for (int e = 0; e < 8; ++e) y[e] *= eg;
                    *(u32x4*)(QG + i * 128 + grp * 8) = pack8(y);
                } else if (part == 1) {
                    *(u32x4*)(KH + i * 128 + grp * 8) = pack8(y);
                    const float s = beta_i * __expf(gc_i);
#pragma unroll
                    for (int e = 0; e < 8; ++e) y[e] *= s;
                    *(LAS u32x4*)(T + tsw(i, grp)) = pack8(y);
                } else {
#pragma unroll
                    for (int e = 0; e < 8; ++e) y[e] *= beta_i;
                    *(LAS u32x4*)(T + tsw(i, grp)) = pack8(y);
                }
            }
        }
        if (part == 1) {
            LDS_WAIT(); transpose_out(T, RWT, lane); LDS_WAIT();
            VM_WAIT();
#pragma unroll 1
            for (int half = 0; half < 2; ++half) { const int i0 = tbk * 16 + half * 8; u32x4 raw[8];
#pragma unroll
                for (int e8 = 0; e8 < 8; ++e8) raw[e8] = *(const u32x4*)(KH + (i0 + e8) * 128 + grp * 8);
#pragma unroll
                for (int e8 = 0; e8 < 8; ++e8) { const int i = i0 + e8; float y[8]; unpack8(raw[e8], y);
                    const float s = __expf(g_last - scb[64 + i]);
#pragma unroll
                    for (int e = 0; e < 8; ++e) y[e] *= s;
                    *(LAS u32x4*)(T + tsw(i, grp)) = pack8(y); } }
            LDS_WAIT(); transpose_out(T, KDT, lane); LDS_WAIT();
        }
        if (part == 2) { LDS_WAIT(); transpose_out(T, UT, lane); LDS_WAIT(); }
    }
    VM_WAIT();
    TS_END(2); TS_BEGIN(3);
    bf16x8 kf[4][4];
#pragma unroll
    for (int rb = 0; rb < 4; ++rb)
#pragma unroll
        for (int kc = 0; kc < 4; ++kc) kf[rb][kc] = *(const bf16x8*)(KH + (rb * 16 + fr) * 128 + kc * 32 + 8 * fq);
#pragma unroll
    for (int jb = 0; jb < 4; ++jb) { const float gcj = scb[64 + jb * 16 + fr];
#pragma unroll
        for (int ib = jb; ib < 4; ++ib) { f32x4 acc = (f32x4){0.f, 0.f, 0.f, 0.f};
#pragma unroll
            for (int kc = 0; kc < 4; ++kc) acc = mfma16(kf[ib][kc], kf[jb][kc], acc);
#pragma unroll
            for (int r = 0; r < 4; ++r) { const int i = ib * 16 + 4 * fq + r; Amat[i * 68 + jb * 16 + fr] = acc[r] * scb[i] * __expf(fminf(scb[64 + i] - gcj, 0.f)); } } }
#pragma unroll
    for (int ib2 = 0; ib2 < 2; ++ib2) {
    bf16x8 qfa[2][4];
#pragma unroll
    for (int q = 0; q < 2; ++q)
#pragma unroll
        for (int kc = 0; kc < 4; ++kc) qfa[q][kc] = *(const bf16x8*)(QH + ((ib2 * 2 + q) * 16 + fr) * 128 + kc * 32 + 8 * fq);
#pragma unroll
    for (int q = 0; q < 2; ++q) { const int ib = ib2 * 2 + q; bf16x8 qf[4];
#pragma unroll
        for (int kc = 0; kc < 4; ++kc) qf[kc] = qfa[q][kc];
        const int i = ib * 16 + fr; const float gci = scb[64 + i];
#pragma unroll
        for (int jb = 0; jb < 4; ++jb) { f32x4 val = (f32x4){0.f, 0.f, 0.f, 0.f};
            if (jb <= ib) { f32x4 acc = (f32x4){0.f, 0.f, 0.f, 0.f};
#pragma unroll
                for (int kc = 0; kc < 4; ++kc) acc = mfma16(kf[jb][kc], qf[kc], acc);
#pragma unroll
                for (int r = 0; r < 4; ++r) { const int j = jb * 16 + 4 * fq + r; val[r] = (i >= j) ? acc[r] * __expf(fminf(gci - scb[64 + j], 0.f)) : 0.f; } }
            *(u32x2*)(ATT + i * 64 + jb * 16 + 4 * fq) = pack4(val); } } }
    LDS_WAIT();
    TS_END(3); TS_BEGIN(4);
    float mcol[64];
#pragma unroll
    for (int i = 0; i < 64; ++i) { float acc = (lane == i) ? 1.f : 0.f;
#pragma unroll
        for (int j = 0; j < i; ++j) acc = fmaf(-Amat[i * 68 + j], mcol[j], acc);
        mcol[i] = acc; }
    LDS_WAIT(); asm volatile("" ::: "memory");
    LAS bf16* Mb = (LAS bf16*)pl;
#pragma unroll
    for (int i = 0; i < 64; ++i) Mb[i * 136 + lane] = (bf16)f2bf(mcol[i]);
    LDS_WAIT(); asm volatile("" ::: "memory");
    TS_END(4); TS_BEGIN(5);
    bf16x8 mf[4][2];
#pragma unroll
    for (int ib = 0; ib < 4; ++ib)
#pragma unroll
        for (int k2 = 0; k2 < 2; ++k2) mf[ib][k2] = *(const LAS bf16x8*)(Mb + (ib * 16 + fr) * 136 + k2 * 32 + 8 * fq);
    LDS_WAIT(); asm volatile("" ::: "memory");
    { LAS bf16* Tu = (LAS bf16*)pl;
#pragma unroll 1
      for (int hb = 0; hb < 2; ++hb) { bf16x8 rfa[4][2];
#pragma unroll
        for (int q = 0; q < 4; ++q)
#pragma unroll
            for (int k2 = 0; k2 < 2; ++k2) rfa[q][k2] = *(const bf16x8*)(UT + ((hb * 4 + q) * 16 + fr) * 64 + k2 * 32 + 8 * fq);
#pragma unroll
        for (int q = 0; q < 4; ++q) { const int db = hb * 4 + q;
#pragma unroll
            for (int ib = 0; ib < 4; ++ib) { f32x4 acc = (f32x4){0.f, 0.f, 0.f, 0.f};
#pragma unroll
                for (int k2 = 0; k2 < 2; ++k2) acc = mfma16(mf[ib][k2], rfa[q][k2], acc);
                *(LAS u32x2*)(Tu + (db * 16 + fr) * 72 + ib * 16 + 4 * fq) = pack4(acc); } } }
      LDS_WAIT(); VM_WAIT();
      const int dl = lane >> 3, i8 = lane & 7;
#pragma unroll 4
      for (int d0 = 0; d0 < 16; ++d0) *(u32x4*)(UT + (d0 * 8 + dl) * 64 + i8 * 8) = *(const LAS u32x4*)(Tu + (d0 * 8 + dl) * 72 + i8 * 8);
      LDS_WAIT(); asm volatile("" ::: "memory"); }
    { LAS bf16* Tw = (LAS bf16*)pl;
#pragma unroll 1
      for (int hb = 0; hb < 2; ++hb) { bf16x8 rfa[4][2];
#pragma unroll
        for (int q = 0; q < 4; ++q)
#pragma unroll
            for (int k2 = 0; k2 < 2; ++k2) rfa[q][k2] = *(const bf16x8*)(RWT + ((hb * 4 + q) * 16 + fr) * 64 + k2 * 32 + 8 * fq);
#pragma unroll
        for (int q = 0; q < 4; ++q) { const int kb = hb * 4 + q;
#pragma unroll
            for (int ib = 0; ib < 4; ++ib) { f32x4 acc = (f32x4){0.f, 0.f, 0.f, 0.f};
#pragma unroll
                for (int k2 = 0; k2 < 2; ++k2) acc = mfma16(rfa[q][k2], mf[ib][k2], acc);
                *(LAS u32x2*)(Tw + (ib * 16 + fr) * 136 + kb * 16 + 4 * fq) = pack4(acc); } } }
      LDS_WAIT();
      const int r4 = lane >> 4, c16 = lane & 15;
#pragma unroll 4
      for (int it = 0; it < 16; ++it) *(u32x4*)(Wg + (it * 4 + r4) * 128 + c16 * 8) = *(const LAS u32x4*)(Tw + (it * 4 + r4) * 136 + c16 * 8); }
    LDS_WAIT();
    TS_END(5); TS_END(8);
}

DI void p2_ret_item(const Args& A, const Ctx& C, LAS unsigned char* pl, int l, int item) {
    const int lane = C.lane, fr = lane & 15, fq = lane >> 4;
    const int CH = item, h = item & 3, bc = item >> 2, c = bc % NCH, b = bc / NCH;
    const int t0 = 64 * c - 48; const size_t mrow0 = (size_t)b * TP;
    bf16* U = (bf16*)(A.ws + WS_U); LAS bf16* T = (LAS bf16*)pl; const f32x2* TAB = (const f32x2*)(A.ws + WS_TAB);
    bf16* KRT = (bf16*)(A.ws + R_KRT) + (size_t)CH * 8192; bf16* VT = (bf16*)(A.ws + R_VT) + (size_t)CH * 8192; bf16* SC = (bf16*)(A.ws + R_SC) + (size_t)CH * 4096;
    TS_BEGIN(6);
    const float lg2 = log2f(1.f - exp2f(-5.f - (float)h));
    const int tok8 = lane >> 3, d0 = 8 * (lane & 7);
    const int it0 = t0 < 0 ? 6 : 0;
#pragma unroll 1
    for (int part = 0; part < 2; ++part) {
        const int colb = (part ? 1536 : 1024) + h * 128;

        float cc[8], ss[8], cr[8], sr[8];
        { const f32x4* cs = (const f32x4*)(TAB + (size_t)(t0 + it0 * 8 + tok8) * 64 + d0); const f32x4* rs = (const f32x4*)(TAB + (size_t)8 * 64 + d0);
#pragma unroll
            for (int e2 = 0; e2 < 4; ++e2) { const f32x4 v = cs[e2], r = rs[e2]; cc[2 * e2] = v[0]; ss[2 * e2] = v[1]; cc[2 * e2 + 1] = v[2]; ss[2 * e2 + 1] = v[3];
                cr[2 * e2] = r[0]; sr[2 * e2] = r[1]; cr[2 * e2 + 1] = r[2]; sr[2 * e2 + 1] = r[3]; } }
#pragma unroll 1
        for (int itb = 0; itb < 2; ++itb) {
        u32x4 lo4[4], hi4[4];
#pragma unroll
        for (int q = 0; q < 4; ++q) { const int t = t0 + (itb * 4 + q) * 8 + tok8; lo4[q] = (u32x4){0u, 0u, 0u, 0u}; hi4[q] = lo4[q];
            if (t >= 0) { const bf16* p = U + (mrow0 + t) * DIN + colb + d0; lo4[q] = *(const u32x4*)p; hi4[q] = *(const u32x4*)(p + 64); } }
#pragma unroll
        for (int q = 0; q < 4; ++q) { const int it = itb * 4 + q; const int i = it * 8 + tok8, t = t0 + i;
            float r1[8], r2[8];
#pragma unroll
            for (int e = 0; e < 8; ++e) { r1[e] = 0.f; r2[e] = 0.f; }
            if (it >= it0) {
                float lo[8], hi[8]; unpack8(lo4[q], lo); unpack8(hi4[q], hi);
                const float sc = part ? QSCALE * exp2f((float)(63 - i) * lg2) : exp2f((float)(i + 1) * lg2);
#pragma unroll
                for (int e = 0; e < 8; ++e) { r1[e] = (lo[e] * cc[e] - hi[e] * ss[e]) * sc; r2[e] = (lo[e] * ss[e] + hi[e] * cc[e]) * sc;
                    const float cn = cc[e] * cr[e] - ss[e] * sr[e], sn = ss[e] * cr[e] + cc[e] * sr[e]; cc[e] = cn; ss[e] = sn; }
                bf16* p = U + (mrow0 + t) * DIN + colb + d0;
                *(u32x4*)p = pack8(r1); *(u32x4*)(p + 64) = pack8(r2); }
            if (part) { *(LAS u32x4*)(T + tsw(i, d0 >> 3)) = pack8(r1); *(LAS u32x4*)(T + tsw(i, 8 + (d0 >> 3))) = pack8(r2); } } }
        if (part) { LDS_WAIT(); transpose_out(T, KRT, lane); LDS_WAIT(); }
    }
    { const int tok4 = lane >> 4, grp = lane & 15; u32x4 raw[16];
#pragma unroll
        for (int it = 0; it < 16; ++it) { const int t = t0 + it * 4 + tok4; raw[it] = (u32x4){0u, 0u, 0u, 0u};
            if (t >= 0) raw[it] = *(const u32x4*)(U + (mrow0 + t) * DIN + 2048 + h * 128 + grp * 8); }
#pragma unroll
        for (int it = 0; it < 16; ++it) *(LAS u32x4*)(T + tsw(it * 4 + tok4, grp)) = raw[it];
        LDS_WAIT(); transpose_out(T, VT, lane); LDS_WAIT(); }
    VM_WAIT();
    const bf16x8 zf = (bf16x8){0, 0, 0, 0, 0, 0, 0, 0};
    bf16x8 kf[4][4];
#pragma unroll
    for (int rb = 0; rb < 4; ++rb) { const int t = t0 + rb * 16 + fr;
#pragma unroll
        for (int kc = 0; kc < 4; ++kc) kf[rb][kc] = t >= 0 ? *(const bf16x8*)(U + (mrow0 + t) * DIN + 1536 + h * 128 + kc * 32 + 8 * fq) : zf; }
    const float ginv = exp2f(-64.f * lg2);
#pragma unroll
    for (int ib2 = 0; ib2 < 2; ++ib2) {
    bf16x8 qfa[2][4];
#pragma unroll
    for (int q = 0; q < 2; ++q) { const int t = t0 + (ib2 * 2 + q) * 16 + fr;
#pragma unroll
        for (int kc = 0; kc < 4; ++kc) qfa[q][kc] = t >= 0 ? *(const bf16x8*)(U + (mrow0 + t) * DIN + 1024 + h * 128 + kc * 32 + 8 * fq) : zf; }
#pragma unroll
    for (int q = 0; q < 2; ++q) { const int ib = ib2 * 2 + q; bf16x8 qf[4]; const int i = ib * 16 + fr;
#pragma unroll
        for (int kc = 0; kc < 4; ++kc) qf[kc] = qfa[q][kc];
#pragma unroll
        for (int jb = 0; jb < 4; ++jb) { f32x4 val = (f32x4){0.f, 0.f, 0.f, 0.f};
            if (jb <= ib) { f32x4 acc = (f32x4){0.f, 0.f, 0.f, 0.f};
#pragma unroll
                for (int kc = 0; kc < 4; ++kc) acc = mfma16(kf[jb][kc], qf[kc], acc);
#pragma unroll
                for (int r = 0; r < 4; ++r) { const int j = jb * 16 + 4 * fq + r; val[r] = (i >= j) ? acc[r] * ginv : 0.f; } }
            *(u32x2*)(SC + i * 64 + jb * 16 + 4 * fq) = pack4(val); } } }
    LDS_WAIT();
    TS_END(6);
}

template <bool DEC>
DI void p2_rg_item(const Args& A, const Ctx& C, LAS unsigned char* pl, int l, int bt, int c, int n) {
    const int lane = C.lane, fr = lane & 15, fq = lane >> 4;
    TS_BEGIN(7); TS_BEGIN(20);
    bf16* U = (bf16*)(A.ws + WS_U); LAS float* XR = (LAS float*)pl;
    const int t0 = DEC ? 0 : 64 * c - 48; const size_t mrow0 = DEC ? (size_t)MP + 64 * bt : (size_t)bt * TP;
    bf16x8 xf[4][2];
#pragma unroll
    for (int kc = 0; kc < 2; ++kc) { const int ch8 = n * 64 + kc * 32 + 8 * fq;
        float cw[4][8], cb[8];
#pragma unroll
        for (int j = 0; j < 4; ++j) { const float* p = A.in[9] + ((size_t)l * 4 + j) * 512 + ch8; const f32x4 a = *(const f32x4*)p, bq = *(const f32x4*)(p + 4);
            cw[j][0] = a[0]; cw[j][1] = a[1]; cw[j][2] = a[2]; cw[j][3] = a[3]; cw[j][4] = bq[0]; cw[j][5] = bq[1]; cw[j][6] = bq[2]; cw[j][7] = bq[3]; }
        { const float* p = A.in[10] + (size_t)l * 512 + ch8; const f32x4 a = *(const f32x4*)p, bq = *(const f32x4*)(p + 4);
            cb[0] = a[0]; cb[1] = a[1]; cb[2] = a[2]; cb[3] = a[3]; cb[4] = bq[0]; cb[5] = bq[1]; cb[6] = bq[2]; cb[7] = bq[3]; }
        u32x4 rawp[4][4];
        if (!DEC) {
#pragma unroll
            for (int tb = 0; tb < 4; ++tb)
#pragma unroll
                for (int j = 0; j < 4; ++j) { const int tt = t0 + tb * 16 + fr - 3 + j; rawp[tb][j] = (u32x4){0u, 0u, 0u, 0u}; if (tt >= 0) rawp[tb][j] = *(const u32x4*)(U + (mrow0 + tt) * DIN + ch8); }
        }
#pragma unroll
        for (int tb = 0; tb < 4; ++tb) { const int i = tb * 16 + fr;
            float xr[8];
#pragma unroll
            for (int e = 0; e < 8; ++e) xr[e] = cb[e];
            if (!DEC) { const int t = t0 + i; float x3[8];
#pragma unroll
                for (int e = 0; e < 8; ++e) x3[e] = 0.f;
#pragma unroll
                for (int j = 0; j < 4; ++j) { float x[8]; unpack8(rawp[tb][j], x);
#pragma unroll
                        for (int e = 0; e < 8; ++e) { xr[e] = fmaf(cw[j][e], x[e], xr[e]); if (j == 3) x3[e] = x[e]; } }
                if (c == NCH - 1 && i >= 61) { float* o = A.out + O_CP + ((size_t)(l * NB + bt) * 3 + (i - 61)) * 512 + ch8;
                    *(f32x4*)o = (f32x4){x3[0], x3[1], x3[2], x3[3]}; *(f32x4*)(o + 4) = (f32x4){x3[4], x3[5], x3[6], x3[7]}; }
            } else { const int s = 64 * bt + i; const float* cv = A.in[3] + ((size_t)(l * NS + s) * 3) * 512 + ch8; float* oc = A.out + O_CS + ((size_t)(l * NS + s) * 3) * 512 + ch8;
                float x[8];
#pragma unroll
                for (int j = 0; j < 3; ++j) { const f32x4 a = *(const f32x4*)(cv + j * 512), bq = *(const f32x4*)(cv + j * 512 + 4);
                    x[0] = a[0]; x[1] = a[1]; x[2] = a[2]; x[3] = a[3]; x[4] = bq[0]; x[5] = bq[1]; x[6] = bq[2]; x[7] = bq[3];
#pragma unroll
                    for (int e = 0; e < 8; ++e) xr[e] = fmaf(cw[j][e], x[e], xr[e]);
                    if (j >= 1) { *(f32x4*)(oc + (j - 1) * 512) = a; *(f32x4*)(oc + (j - 1) * 512 + 4) = bq; } }
                unpack8(*(const u32x4*)(U + (mrow0 + i) * DIN + ch8), x);
#pragma unroll
                for (int e = 0; e < 8; ++e) xr[e] = fmaf(cw[3][e], x[e], xr[e]);
                *(f32x4*)(oc + 2 * 512) = (f32x4){x[0], x[1], x[2], x[3]}; *(f32x4*)(oc + 2 * 512 + 4) = (f32x4){x[4], x[5], x[6], x[7]};
            }
            *(LAS f32x4*)(XR + i * 68 + kc * 32 + 8 * fq) = (f32x4){xr[0], xr[1], xr[2], xr[3]};
            *(LAS f32x4*)(XR + i * 68 + kc * 32 + 8 * fq + 4) = (f32x4){xr[4], xr[5], xr[6], xr[7]};
            xf[tb][kc] = __builtin_bit_cast(bf16x8, pack8(xr)); } }
    LDS_WAIT();
    TS_END(20); TS_BEGIN(21);
    const bf16* GW = (const bf16*)(A.ws + ((l & 1) ? WS_GATEW1 : WS_GATEW));
    bf16* MIX = (bf16*)(A.ws + WS_MIX); bf16* BETA = (bf16*)(A.ws + WS_BETA);
    bf16x8 wafN[2], wxfN[2]; f32x4 ba4N, bx4N, lam4N; u32x2 zrawN[4];
#define RG_LOADS(DB_) do { const int chl_ = (DB_) * 16 + 4 * fq, ch0_ = n * 64 + chl_; \
        _Pragma("unroll") for (int kc = 0; kc < 2; ++kc) { wafN[kc] = *(const bf16x8*)(GW + (size_t)(0 * 8 + n) * 4096 + ((DB_) * 16 + fr) * 64 + kc * 32 + 8 * fq); \
                                         wxfN[kc] = *(const bf16x8*)(GW + (size_t)(1 * 8 + n) * 4096 + ((DB_) * 16 + fr) * 64 + kc * 32 + 8 * fq); } \
        ba4N = *(const f32x4*)(A.in[12] + (size_t)l * 512 + ch0_); bx4N = *(const f32x4*)(A.in[14] + (size_t)l * 512 + ch0_); lam4N = *(const f32x4*)(A.in[15] + (size_t)l * 512 + ch0_); \
        _Pragma("unroll") for (int tb = 0; tb < 4; ++tb) { const int t_ = t0 + tb * 16 + fr; const size_t row_ = mrow0 + (DEC ? tb * 16 + fr : (t_ >= 0 ? t_ : 0)); zrawN[tb] = *(const u32x2*)(U + row_ * DIN + 512 + ch0_); } } while (0)
    RG_LOADS(0);
#pragma unroll 1
    for (int db = 0; db < 4; ++db) {
        bf16x8 waf[2], wxf[2]; u32x2 zraw[4];
#pragma unroll
        for (int kc = 0; kc < 2; ++kc) { waf[kc] = wafN[kc]; wxf[kc] = wxfN[kc]; }
        const f32x4 ba4 = ba4N, bx4 = bx4N, lam4 = lam4N;
#pragma unroll
        for (int tb = 0; tb < 4; ++tb) zraw[tb] = zrawN[tb];
        const int chl = db * 16 + 4 * fq, ch0 = n * 64 + chl;
        if (db + 1 < 4) RG_LOADS(db + 1);
        f32x4 sp4;
#pragma unroll
        for (int r = 0; r < 4; ++r) sp4[r] = softplusf_(-lam4[r]);
        float Ac[4], Hc[4];
#pragma unroll
        for (int r = 0; r < 4; ++r) { Ac[r] = 1.f; Hc[r] = 0.f; }
#pragma unroll
        for (int tb = 0; tb < 4; ++tb) { const int i = tb * 16 + fr; const int t = t0 + i; const bool valid = DEC || t >= 0; const size_t row = mrow0 + (DEC ? i : (t >= 0 ? t : 0));
            f32x4 aa = (f32x4){0.f, 0.f, 0.f, 0.f}, ax = aa;
#pragma unroll
            for (int kc = 0; kc < 2; ++kc) { aa = mfma16(waf[kc], xf[tb][kc], aa); ax = mfma16(wxf[kc], xf[tb][kc], ax); }
            const f32x4 xr4 = *(const LAS f32x4*)(XR + i * 68 + chl);
            const f32x4 z4 = unpack4(zraw[tb]);
            f32x4 av, uv, sz;
#pragma unroll
            for (int r = 0; r < 4; ++r) { const float rg = sigmoidf_(aa[r] + ba4[r]), ig = sigmoidf_(ax[r] + bx4[r]);
                const float la = -8.f * rg * sp4[r];
                av[r] = __expf(la); uv[r] = sqrtf(fmaxf(neg_expm1f_(2.f * la), 0.f)) * ig * xr4[r]; sz[r] = siluf_(z4[r]); }
            if (DEC) { const int s = 64 * bt + i;
                const f32x4 h0 = *(const f32x4*)(A.in[2] + (size_t)(l * NS + s) * 512 + ch0);
                const f32x4 hv = av * h0 + uv;
                *(f32x4*)(A.out + O_HS + (size_t)(l * NS + s) * 512 + ch0) = hv;
                *(u32x2*)(MIX + row * DMIX + ch0) = pack4(hv * sz);
            } else {
                f32x4 al, be;
#pragma unroll
                for (int r = 0; r < 4; ++r) { float a = valid ? av[r] : 1.f, u = valid ? uv[r] : 0.f;
                    { float pa, pu;
                      pa = dpp_f<0x111>(1.f, a); pu = dpp_f<0x111>(0.f, u); u = fmaf(a, pu, u); a = pa * a;
                      pa = dpp_f<0x112>(1.f, a); pu = dpp_f<0x112>(0.f, u); u = fmaf(a, pu, u); a = pa * a;
                      pa = dpp_f<0x114>(1.f, a); pu = dpp_f<0x114>(0.f, u); u = fmaf(a, pu, u); a = pa * a;
                      pa = dpp_f<0x118>(1.f, a); pu = dpp_f<0x118>(0.f, u); u = fmaf(a, pu, u); a = pa * a; }
                    const float P = Ac[r] * a, hl = fmaf(a, Hc[r], u);
                    al[r] = hl * sz[r]; be[r] = P * sz[r];
                    Ac[r] = row_bcast15(P); Hc[r] = row_bcast15(hl); }
                if (valid) { *(u32x2*)(U + row * DIN + 512 + ch0) = pack4(al); *(u32x2*)(BETA + ((size_t)bt * TP + t) * 512 + ch0) = pack4(be); }
            } }
        if (!DEC && fr == 15) { f32x2* RGS = (f32x2*)(A.ws + WS_RGS) + ((size_t)bt * NCH + c) * 512 + n * 64 + chl;
#pragma unroll
            for (int r = 0; r < 4; ++r) RGS[r] = (f32x2){Ac[r], Hc[r]}; }
    }
#undef RG_LOADS
    LDS_WAIT();
    TS_END(21); TS_END(7);
}

DI void p2_rg_any(const Args& A, const Ctx& C, LAS unsigned char* pl, int l, int it) {
    const int NRG = NB * NCH * 8;
    if (it < NRG) { const int n = it & 7, bc = it >> 3; p2_rg_item<false>(A, C, pl, l, bc / NCH, bc % NCH, n); }
    else { const int r = it - NRG; p2_rg_item<true>(A, C, pl, l, r >> 3, 0, r & 7); }
}
DI void phase_p2(const Args& A, const Ctx& C, int l) {
    LAS unsigned char* pl = C.lds + C.wave * PRIV_BYTES;
    const int slot = C.wave * C.G + C.bid, NSLOT = C.G * NWAVES;
    if (NSLOT != 2048) return;
    constexpr int NL = 2048 - NCHH, NRGT = NB * NCH * 8 + 16, XRG = NRGT - 2 * NL, XRET = NCHH - NL;
    if (slot < NCHH) {
        p2_gdn_item(A, C, pl, l, slot);
        if (slot < XRG) p2_rg_any(A, C, pl, l, 2 * NL + slot);
        else p2_ret_item(A, C, pl, l, slot - XRG);
        return; }
    const int j = slot - NCHH;
    p2_rg_any(A, C, pl, l, j); p2_rg_any(A, C, pl, l, NL + j);
    if (j < NCHH - (NCHH - XRG)) p2_ret_item(A, C, pl, l, (NCHH - XRG) + j);
}

constexpr int CL_A = 0;
constexpr int CL_B = 17408;
constexpr int CL_KT = 34816;
constexpr int CL_AT = 53248;
constexpr int CL_PRIV = 62464;
constexpr int CL_PRIV_BYTES = 6656;
constexpr int CL_OT = CL_PRIV + 8 * CL_PRIV_BYTES;
static_assert(CL_OT + 64 * 72 * 2 <= MISC_OFF, "chain LDS map");

DI void p3_gdn_chain(const Args& A, const Ctx& C, int l, int b, int h, int half) {
    const int tid = C.tid, lane = C.lane, fr = lane & 15, fq = lane >> 4, cw = C.wave & 3, hp = C.wave >> 2, vb = 4 * half + cw;
    LAS unsigned char* L = C.lds;
    LAS bf16* Wb = (LAS bf16*)(L + CL_A); LAS bf16* QGb = (LAS bf16*)(L + CL_B); LAS bf16* KTb = (LAS bf16*)(L + CL_KT); LAS bf16* ATb = (LAS bf16*)(L + CL_AT);
    LAS bf16* ST = (LAS bf16*)(L + CL_PRIV + cw * CL_PRIV_BYTES); LAS bf16* VNT = ST + 16 * 136; LAS bf16* OT = (LAS bf16*)(L + CL_OT);
    bf16* U = (bf16*)(A.ws + WS_U); const size_t mrow0 = (size_t)b * TP;
    const bf16* gW = (const bf16*)(A.ws + G_W); const bf16* gQG = (const bf16*)(A.ws + G_QG); const bf16* gKDT = (const bf16*)(A.ws + G_KDT);
    const bf16* gUT = (const bf16*)(A.ws + G_UT); const bf16* gATT = (const bf16*)(A.ws + G_ATT); const float* EGL = (const float*)(A.ws + WS_EGL);
    if (hp == 0) for (int e = lane; e < 16 * 136 / 2; e += 64) ((LAS unsigned*)ST)[e] = 0u;
    f32x4 Sacc[4];
#pragma unroll
    for (int kb = 0; kb < 4; ++kb) Sacc[kb] = (f32x4){0.f, 0.f, 0.f, 0.f};
    u32x4 RA[7], RB[7]; u32x2 urA[2], urB[2]; float eglA, eglB;
    const int r16 = tid >> 4, c16 = tid & 15, r8 = tid >> 3, c8 = tid & 7;
#define GDN_PREFETCH(R, ur, eglr, CC_) do { const size_t ch_ = ((size_t)b * NCH + (CC_)) * 4 + h; \
        R[0] = *(const u32x4*)(gW + ch_ * 8192 + (size_t)tid * 8); R[1] = *(const u32x4*)(gW + ch_ * 8192 + (size_t)(tid + 512) * 8); \
        R[2] = *(const u32x4*)(gQG + ch_ * 8192 + (size_t)tid * 8); R[3] = *(const u32x4*)(gQG + ch_ * 8192 + (size_t)(tid + 512) * 8); \
        R[4] = *(const u32x4*)(gKDT + ch_ * 8192 + (size_t)tid * 8); R[5] = *(const u32x4*)(gKDT + ch_ * 8192 + (size_t)(tid + 512) * 8); \
        R[6] = *(const u32x4*)(gATT + ch_ * 4096 + (size_t)tid * 8); \
        _Pragma("unroll") for (int tb_ = 0; tb_ < 2; ++tb_) ur[tb_] = *(const u32x2*)(gUT + ch_ * 8192 + (vb * 16 + fr) * 64 + (2 * hp + tb_) * 16 + 4 * fq); \
        eglr = EGL[ch_]; } while (0)
#define GDN_COPYOUT(CC_) do { const int t_ = 64 * (CC_) - 48 + r8; const u32x4 v_ = *(const LAS u32x4*)(OT + r8 * 72 + c8 * 8); \
        if (t_ >= 0) *(u32x4*)(U + (mrow0 + t_) * DIN + 4096 + h * 128 + half * 64 + c8 * 8) = v_; } while (0)
#define GDN_STEP(c, R, ur, eglr) do { \
        TS_BEGIN(11); __syncthreads(); TS_END(11); TS_BEGIN(15); \
        *(LAS u32x4*)(Wb + r16 * 136 + c16 * 8) = R[0];        *(LAS u32x4*)(Wb + (r16 + 32) * 136 + c16 * 8) = R[1]; \
        *(LAS u32x4*)(QGb + r16 * 136 + c16 * 8) = R[2];       *(LAS u32x4*)(QGb + (r16 + 32) * 136 + c16 * 8) = R[3]; \
        *(LAS u32x4*)(KTb + r8 * 72 + c8 * 8) = R[4];          *(LAS u32x4*)(KTb + (r8 + 64) * 72 + c8 * 8) = R[5]; \
        *(LAS u32x4*)(ATb + r8 * 72 + c8 * 8) = R[6]; \
        f32x4 uv[2]; \
        _Pragma("unroll") for (int tb = 0; tb < 2; ++tb) uv[tb] = unpack4(ur[tb]); \
        const float egl = eglr; \
        if ((c) >= 1) GDN_COPYOUT((c) - 1); \
        LDS_WAIT(); TS_END(15); TS_BEGIN(16); \
        __syncthreads(); TS_END(16); TS_BEGIN(12); \
        if ((c) + 2 < NCH) GDN_PREFETCH(R, ur, eglr, (c) + 2); \
          \
        bf16x8 sf[4]; \
        _Pragma("unroll") for (int kc = 0; kc < 4; ++kc) sf[kc] = *(const LAS bf16x8*)(ST + fr * 136 + kc * 32 + 8 * fq); \
        f32x4 o[2]; \
        { bf16x8 wf[2][4], qf[2][4]; \
            _Pragma("unroll") for (int q2 = 0; q2 < 2; ++q2) _Pragma("unroll") for (int kc = 0; kc < 4; ++kc) { \
                wf[q2][kc] = *(const LAS bf16x8*)(Wb + ((hp * 2 + q2) * 16 + fr) * 136 + kc * 32 + 8 * fq); qf[q2][kc] = *(const LAS bf16x8*)(QGb + ((hp * 2 + q2) * 16 + fr) * 136 + kc * 32 + 8 * fq); } \
            LDS_WAIT(); \
            _Pragma("unroll") for (int q2 = 0; q2 < 2; ++q2) { const int tb = hp * 2 + q2; f32x4 aw = (f32x4){0.f, 0.f, 0.f, 0.f}, aq = aw; \
                _Pragma("unroll") for (int kc = 0; kc < 4; ++kc) { aw = mfma16(wf[q2][kc], sf[kc], aw); aq = mfma16(qf[q2][kc], sf[kc], aq); } \
                const f32x4 vn = uv[q2] - aw; o[q2] = aq; \
                *(LAS u32x2*)(VNT + fr * 72 + tb * 16 + 4 * fq) = pack4(vn); } } \
        bf16x8 af[2][2], kf[4][2];                   \
        _Pragma("unroll") for (int q2 = 0; q2 < 2; ++q2) _Pragma("unroll") for (int k2 = 0; k2 < 2; ++k2) af[q2][k2] = *(const LAS bf16x8*)(ATb + ((hp * 2 + q2) * 16 + fr) * 72 + k2 * 32 + 8 * fq); \
        _Pragma("unroll") for (int q4 = 0; q4 < 4; ++q4) _Pragma("unroll") for (int k2 = 0; k2 < 2; ++k2) kf[q4][k2] = *(const LAS bf16x8*)(KTb + ((hp * 4 + q4) * 16 + fr) * 72 + k2 * 32 + 8 * fq); \
        LDS_WAIT(); \
        __syncthreads();                             \
        bf16x8 vf[2]; \
        _Pragma("unroll") for (int k2 = 0; k2 < 2; ++k2) vf[k2] = *(const LAS bf16x8*)(VNT + fr * 72 + k2 * 32 + 8 * fq); \
        LDS_WAIT(); \
        _Pragma("unroll") for (int q2 = 0; q2 < 2; ++q2) \
            _Pragma("unroll") for (int k2 = 0; k2 < 2; ++k2) o[q2] = mfma16(af[q2][k2], vf[k2], o[q2]); \
        _Pragma("unroll") for (int q4 = 0; q4 < 4; ++q4) { const int kb = hp * 4 + q4; f32x4 s = Sacc[q4] * egl; \
            _Pragma("unroll") for (int k2 = 0; k2 < 2; ++k2) s = mfma16(kf[q4][k2], vf[k2], s); \
            Sacc[q4] = s; \
            *(LAS u32x2*)(ST + fr * 136 + kb * 16 + 4 * fq) = pack4(s); } \
        _Pragma("unroll") for (int q2 = 0; q2 < 2; ++q2) \
            _Pragma("unroll") for (int r = 0; r < 4; ++r) OT[((hp * 2 + q2) * 16 + 4 * fq + r) * 72 + cw * 16 + fr] = (bf16)f2bf(o[q2][r]); \
        LDS_WAIT(); TS_END(12); } while (0)
    GDN_PREFETCH(RA, urA, eglA, 0); GDN_PREFETCH(RB, urB, eglB, 1);
#pragma unroll 1
    for (int c = 0; c + 1 < NCH; c += 2) { GDN_STEP(c, RA, urA, eglA); GDN_STEP(c + 1, RB, urB, eglB); }
    GDN_STEP(NCH - 1, RA, urA, eglA);
#undef GDN_STEP
#undef GDN_PREFETCH
    { float* so = A.out + O_GP + ((size_t)(l * NB + b) * 4 + h) * 16384;
#pragma unroll
        for (int q4 = 0; q4 < 4; ++q4)
#pragma unroll
            for (int r = 0; r < 4; ++r) so[(size_t)((hp * 4 + q4) * 16 + 4 * fq + r) * 128 + vb * 16 + fr] = Sacc[q4][r]; }
    LDS_WAIT(); __syncthreads();
    GDN_COPYOUT(NCH - 1);
#undef GDN_COPYOUT
}

DI void p3_ret_chain(const Args& A, const Ctx& C, int l, int b, int h, int half) {
    const int tid = C.tid, lane = C.lane, fr = lane & 15, fq = lane >> 4, cw = C.wave & 3, hp = C.wave >> 2, vb = 4 * half + cw;
    LAS unsigned char* L = C.lds;
    LAS bf16* Qb = (LAS bf16*)(L + CL_A); LAS bf16* KTb = (LAS bf16*)(L + CL_KT); LAS bf16* SCb = (LAS bf16*)(L + CL_AT);
    LAS bf16* ST = (LAS bf16*)(L + CL_PRIV + cw * CL_PRIV_BYTES); LAS bf16* OT = (LAS bf16*)(L + CL_OT);
    bf16* U = (bf16*)(A.ws + WS_U); const size_t mrow0 = (size_t)b * TP;
    const bf16* gKRT = (const bf16*)(A.ws + R_KRT); const bf16* gVT = (const bf16*)(A.ws + R_VT); const bf16* gSC = (const bf16*)(A.ws + R_SC);
    if (hp == 0) for (int e = lane; e < 16 * 136 / 2; e += 64) ((LAS unsigned*)ST)[e] = 0u;
    f32x4 Sacc[4];
#pragma unroll
    for (int kb = 0; kb < 4; ++kb) Sacc[kb] = (f32x4){0.f, 0.f, 0.f, 0.f};
    const float sdec = exp2f(64.f * log2f(1.f - exp2f(-5.f - (float)h)));
    u32x4 RA[5], RB[5]; bf16x8 vfA[2], vfB[2];
    const int r16 = tid >> 4, c16 = tid & 15, r8 = tid >> 3, c8 = tid & 7;
#define RET_PREFETCH(R, vfr, CC_) do { const int cc_ = (CC_); const size_t ch_ = ((size_t)b * NCH + cc_) * 4 + h; const int t0_ = 64 * cc_ - 48; \
        { const int ta_ = t0_ + r16, tb2_ = t0_ + r16 + 32; const u32x4 z_ = (u32x4){0u, 0u, 0u, 0u}; \
          R[0] = ta_ >= 0 ? *(const u32x4*)(U + (mrow0 + ta_) * DIN + 1024 + h * 128 + c16 * 8) : z_; \
          R[1] = tb2_ >= 0 ? *(const u32x4*)(U + (mrow0 + tb2_) * DIN + 1024 + h * 128 + c16 * 8) : z_; } \
        R[2] = *(const u32x4*)(gKRT + ch_ * 8192 + (size_t)tid * 8); R[3] = *(const u32x4*)(gKRT + ch_ * 8192 + (size_t)(tid + 512) * 8); \
        R[4] = *(const u32x4*)(gSC + ch_ * 4096 + (size_t)tid * 8); \
        _Pragma("unroll") for (int k2_ = 0; k2_ < 2; ++k2_) vfr[k2_] = *(const bf16x8*)(gVT + ch_ * 8192 + (vb * 16 + fr) * 64 + k2_ * 32 + 8 * fq); } while (0)
#define RET_COPYOUT(CC_) do { const int t_ = 64 * (CC_) - 48 + r8; const u32x4 v_ = *(const LAS u32x4*)(OT + r8 * 72 + c8 * 8); \
        if (t_ >= 0) *(u32x4*)(U + (mrow0 + t_) * DIN + 2048 + h * 128 + half * 64 + c8 * 8) = v_; } while (0)
#define RET_STEP(c, R, vfr) do { \
        __syncthreads(); \
        *(LAS u32x4*)(Qb + r16 * 136 + c16 * 8) = R[0];        *(LAS u32x4*)(Qb + (r16 + 32) * 136 + c16 * 8) = R[1]; \
        *(LAS u32x4*)(KTb + r8 * 72 + c8 * 8) = R[2];          *(LAS u32x4*)(KTb + (r8 + 64) * 72 + c8 * 8) = R[3]; \
        *(LAS u32x4*)(SCb + r8 * 72 + c8 * 8) = R[4]; \
        bf16x8 vf[2]; vf[0] = vfr[0]; vf[1] = vfr[1]; \
        if ((c) >= 1) RET_COPYOUT((c) - 1); \
        LDS_WAIT(); \
        __syncthreads(); \
        if ((c) + 2 < NCH) RET_PREFETCH(R, vfr, (c) + 2); \
        bf16x8 sf[4]; \
        _Pragma("unroll") for (int kc = 0; kc < 4; ++kc) sf[kc] = *(const LAS bf16x8*)(ST + fr * 136 + kc * 32 + 8 * fq); \
        bf16x8 qf[2][4], cf[2][2], kf[4][2]; \
        _Pragma("unroll") for (int q2 = 0; q2 < 2; ++q2) { _Pragma("unroll") for (int kc = 0; kc < 4; ++kc) qf[q2][kc] = *(const LAS bf16x8*)(Qb + ((hp * 2 + q2) * 16 + fr) * 136 + kc * 32 + 8 * fq); \
            _Pragma("unroll") for (int k2 = 0; k2 < 2; ++k2) cf[q2][k2] = *(const LAS bf16x8*)(SCb + ((hp * 2 + q2) * 16 + fr) * 72 + k2 * 32 + 8 * fq); } \
        _Pragma("unroll") for (int q4 = 0; q4 < 4; ++q4) _Pragma("unroll") for (int k2 = 0; k2 < 2; ++k2) kf[q4][k2] = *(const LAS bf16x8*)(KTb + ((hp * 4 + q4) * 16 + fr) * 72 + k2 * 32 + 8 * fq); \
        LDS_WAIT(); \
        f32x4 o[2]; \
        _Pragma("unroll") for (int q2 = 0; q2 < 2; ++q2) { f32x4 aq = (f32x4){0.f, 0.f, 0.f, 0.f}; \
            _Pragma("unroll") for (int kc = 0; kc < 4; ++kc) aq = mfma16(qf[q2][kc], sf[kc], aq); \
            _Pragma("unroll") for (int k2 = 0; k2 < 2; ++k2) aq = mfma16(cf[q2][k2], vf[k2], aq); \
            o[q2] = aq; } \
        __syncthreads();                             \
        _Pragma("unroll") for (int q4 = 0; q4 < 4; ++q4) { const int kb = hp * 4 + q4; f32x4 s = Sacc[q4] * sdec; \
            _Pragma("unroll") for (int k2 = 0; k2 < 2; ++k2) s = mfma16(kf[q4][k2], vf[k2], s); \
            Sacc[q4] = s; \
            *(LAS u32x2*)(ST + fr * 136 + kb * 16 + 4 * fq) = pack4(s); } \
        _Pragma("unroll") for (int q2 = 0; q2 < 2; ++q2) \
            _Pragma("unroll") for (int r = 0; r < 4; ++r) OT[((hp * 2 + q2) * 16 + 4 * fq + r) * 72 + cw * 16 + fr] = (bf16)f2bf(o[q2][r]); \
        LDS_WAIT(); } while (0)
    RET_PREFETCH(RA, vfA, 0); RET_PREFETCH(RB, vfB, 1);
#pragma unroll 1
    for (int c = 0; c + 1 < NCH; c += 2) { RET_STEP(c, RA, vfA); RET_STEP(c + 1, RB, vfB); }
    RET_STEP(NCH - 1, RA, vfA);
#undef RET_STEP
#undef RET_PREFETCH
    { float* so = A.out + O_RP + ((size_t)(l * NB + b) * 4 + h) * 16384;
#pragma unroll
        for (int q4 = 0; q4 < 4; ++q4)
#pragma unroll
            for (int r = 0; r < 4; ++r) so[(size_t)((hp * 4 + q4) * 16 + 4 * fq + r) * 128 + vb * 16 + fr] = Sacc[q4][r]; }
    LDS_WAIT(); __syncthreads();
    RET_COPYOUT(NCH - 1);
#undef RET_COPYOUT
}

DI void phase_p3b(const Args& A, const Ctx& C, int l) {
    const int lane = C.lane, gw = C.bid * NWAVES + C.wave, NGW = C.G * NWAVES;
    const bf16* U = (const bf16*)(A.ws + WS_U); bf16* MIX = (bf16*)(A.ws + WS_MIX);
    float gw0[4], gw1[4], gb0[4], gb1[4];
#pragma unroll
    for (int h = 0; h < 4; ++h) { gw0[h] = A.in[16][l * 512 + h * 128 + 2 * lane]; gw1[h] = A.in[16][l * 512 + h * 128 + 2 * lane + 1];
                                  gb0[h] = A.in[17][l * 512 + h * 128 + 2 * lane]; gb1[h] = A.in[17][l * 512 + h * 128 + 2 * lane + 1]; }
    const float nw0 = A.in[21][l * 128 + 2 * lane], nw1 = A.in[21][l * 128 + 2 * lane + 1];
    unsigned nro[4], nrz[4], ngo[4], ngz[4];
#define P3B_LOAD(m_) do { const bf16* u_ = U + (size_t)(m_) * DIN + 2 * lane; \
        _Pragma("unroll") for (int h = 0; h < 4; ++h) { nro[h] = *(const unsigned*)(u_ + 2048 + h * 128); nrz[h] = *(const unsigned*)(u_ + 2560 + h * 128); ngo[h] = *(const unsigned*)(u_ + 4096 + h * 128); ngz[h] = *(const unsigned*)(u_ + 4608 + h * 128); } } while (0)
    if (gw < MP) P3B_LOAD(gw);
#pragma unroll 1
    for (int m = gw; m < MP; m += NGW) {
        unsigned ro[4], rz[4], go[4], gz[4];
#pragma unroll
        for (int h = 0; h < 4; ++h) { ro[h] = nro[h]; rz[h] = nrz[h]; go[h] = ngo[h]; gz[h] = ngz[h]; }
        if (m + NGW < MP) P3B_LOAD(m + NGW);
        bf16* mx = MIX + (size_t)m * DMIX + 2 * lane;
#pragma unroll
        for (int h = 0; h < 4; ++h) {
            { const float o0 = bflo(ro[h]), o1 = bfhi(ro[h]); const float mu = wave_sum(o0 + o1) * (1.f / 128.f); const float d0 = o0 - mu, d1 = o1 - mu;
              const float rn = rsqrtf(wave_sum(d0 * d0 + d1 * d1) * (1.f / 128.f) + EPS);
              *(unsigned*)(mx + 512 + h * 128) = pk2((d0 * rn * gw0[h] + gb0[h]) * siluf_(bflo(rz[h])), (d1 * rn * gw1[h] + gb1[h]) * siluf_(bfhi(rz[h]))); }
            { const float o0 = bflo(go[h]), o1 = bfhi(go[h]); const float rn = rsqrtf(wave_sum(o0 * o0 + o1 * o1) * (1.f / 128.f) + EPS);
              *(unsigned*)(mx + 1024 + h * 128) = pk2(o0 * rn * nw0 * siluf_(bflo(gz[h])), o1 * rn * nw1 * siluf_(bfhi(gz[h]))); } }
    }
#undef P3B_LOAD
}

template <int KIND>
DI void p3_dec_item(const Args& A, const Ctx& C, int l, int s, int h) {
    const int tid = C.tid, lane = C.lane, wave = C.wave;
    LAS float* F = (LAS float*)C.lds; LAS float* vq = F, *vk = F + 128, *vv = F + 256, *part = F + 384  , *red = F + 896  ;
    const bf16* U = (const bf16*)(A.ws + WS_U); const size_t m = (size_t)MP + s; const bf16* u = U + m * DIN;
    __syncthreads();
    float g = 0.f, beta = 0.f;
    if (KIND == 0) {
        if (tid < 64) { const f32x2 cs = ((const f32x2*)(A.ws + WS_TAB))[2064 * 64 + tid];
            const float q1 = bf2f(u[1024 + h * 128 + tid]), q2 = bf2f(u[1024 + h * 128 + 64 + tid]), k1 = bf2f(u[1536 + h * 128 + tid]), k2 = bf2f(u[1536 + h * 128 + 64 + tid]);
            vq[tid] = q1 * cs[0] - q2 * cs[1]; vq[64 + tid] = q1 * cs[1] + q2 * cs[0];
            vk[tid] = (k1 * cs[0] - k2 * cs[1]) * QSCALE; vk[64 + tid] = (k1 * cs[1] + k2 * cs[0]) * QSCALE; }
        else if (tid >= 128 && tid < 256) vv[tid - 128] = bf2f(u[2048 + h * 128 + (tid - 128)]);
    } else {
        float y = 0.f; const int part3 = tid >> 7, d = tid & 127;
        if (tid < 384) { const int ch = part3 * 512 + h * 128 + d; const float* cv = A.in[5] + ((size_t)(l * NS + s) * 3) * 1536 + ch; const float* cw = A.in[18] + (size_t)l * 4 * 1536 + ch;
            const float x0 = cv[0], x1 = cv[1536], x2 = cv[3072], x3 = bf2f(u[3072 + ch]);
            y = siluf_(cw[0] * x0 + cw[1536] * x1 + cw[3072] * x2 + cw[4608] * x3);
            float* oc = A.out + O_GCS + ((size_t)(l * NS + s) * 3) * 1536 + ch; oc[0] = x1; oc[1536] = x2; oc[3072] = x3; }
        const float ss = wave_sum(y * y);
        if (lane == 0) red[wave] = ss;
        __syncthreads();
        if (tid < 384) { const float tot = red[2 * part3] + red[2 * part3 + 1];
            if (part3 == 0) vq[d] = y * rsqrtf(tot + EPS) * QSCALE; else if (part3 == 1) vk[d] = y * rsqrtf(tot + EPS); else vv[d] = y; }
        const float* gp = (const float*)(A.ws + WS_GAB) + m * 8;
        g = -__expf(A.in[19][l * 4 + h]) * softplusf_(gp[h] + A.in[20][l * 4 + h]); beta = sigmoidf_(gp[4 + h]);
    }
    __syncthreads();
    const int dv = tid & 127, qt = tid >> 7;
    const float* st = (KIND == 0 ? A.in[4] : A.in[6]) + ((size_t)(l * NS + s) * 4 + h) * 16384 + (size_t)(32 * qt) * 128 + dv;
    float* so = A.out + (KIND == 0 ? O_RS : O_GS) + ((size_t)(l * NS + s) * 4 + h) * 16384 + (size_t)(32 * qt) * 128 + dv;
    float S[32];
#pragma unroll
    for (int i = 0; i < 32; ++i) S[i] = st[(size_t)i * 128];
    const float vdv = vv[dv]; float acc = 0.f;
    if (KIND == 0) {
        const float gam = 1.f - exp2f(-5.f - (float)h);
#pragma unroll
        for (int i = 0; i < 32; ++i) { S[i] = fmaf(gam, S[i], vk[32 * qt + i] * vdv); acc = fmaf(vq[32 * qt + i], S[i], acc); }
    } else {
        const float eg = __expf(g); float ks = 0.f;
#pragma unroll
        for (int i = 0; i < 32; ++i) ks = fmaf(vk[32 * qt + i], S[i], ks);
        part[qt * 128 + dv] = ks;
        __syncthreads();
        const float vn = beta * (vdv - eg * (part[dv] + part[128 + dv] + part[256 + dv] + part[384 + dv]));
        __syncthreads();
#pragma unroll
        for (int i = 0; i < 32; ++i) { S[i] = fmaf(eg, S[i], vk[32 * qt + i] * vn); acc = fmaf(vq[32 * qt + i], S[i], acc); }
    }
    part[qt * 128 + dv] = acc;
#pragma unroll
    for (int i = 0; i < 32; ++i) so[(size_t)i * 128] = S[i];
    __syncthreads();
    bf16* MIX = (bf16*)(A.ws + WS_MIX);
    float o = 0.f, sz = 0.f;
    if (tid < 128) { o = part[dv] + part[128 + dv] + part[256 + dv] + part[384 + dv]; sz = siluf_(bf2f(u[(KIND == 0 ? 2560 : 4608) + h * 128 + dv])); }
    if (KIND == 0) {
        const float s1 = wave_sum(o);
        if (lane == 0) red[wave] = s1;
        __syncthreads();
        const float mu = (red[0] + red[1]) * (1.f / 128.f); const float d = tid < 128 ? o - mu : 0.f;
        __syncthreads();
        const float s2 = wave_sum(d * d);
        if (lane == 0) red[wave] = s2;
        __syncthreads();
        const float rn = rsqrtf((red[0] + red[1]) * (1.f / 128.f) + EPS);
        if (tid < 128) MIX[m * DMIX + 512 + h * 128 + dv] = (bf16)f2bf((d * rn * A.in[16][l * 512 + h * 128 + dv] + A.in[17][l * 512 + h * 128 + dv]) * sz);
    } else {
        const float s2 = wave_sum(o * o);
        if (lane == 0) red[wave] = s2;
        __syncthreads();
        const float rn = rsqrtf((red[0] + red[1]) * (1.f / 128.f) + EPS);
        if (tid < 128) MIX[m * DMIX + 1024 + h * 128 + dv] = (bf16)f2bf(o * rn * A.in[21][l * 128 + dv] * sz);
    }
}

DI void p3_rg_fix(const Args& A, const Ctx& C, int l, int b, int c) {
    const int tid = C.tid, ch8 = 8 * (tid & 63), tsub = tid >> 6;
    const bf16* U = (const bf16*)(A.ws + WS_U); const bf16* BETA = (const bf16*)(A.ws + WS_BETA); bf16* MIX = (bf16*)(A.ws + WS_MIX);
    const f32x4* RGS = (const f32x4*)((const f32x2*)(A.ws + WS_RGS) + (size_t)b * NCH * 512 + ch8);
    float hin[8];
#pragma unroll
    for (int e = 0; e < 8; ++e) hin[e] = 0.f;
    for (int cp0 = 0; cp0 < c; cp0 += 4) {
        f32x4 pp[4][4];
#pragma unroll
        for (int q = 0; q < 4; ++q)
#pragma unroll
            for (int e2 = 0; e2 < 4; ++e2) pp[q][e2] = (cp0 + q < c) ? RGS[(size_t)(cp0 + q) * 256 + e2] : (f32x4){1.f, 0.f, 1.f, 0.f};
#pragma unroll
        for (int q = 0; q < 4; ++q)
#pragma unroll
            for (int e2 = 0; e2 < 4; ++e2) { const f32x4 p = pp[q][e2]; hin[2 * e2] = fmaf(p[0], hin[2 * e2], p[1]); hin[2 * e2 + 1] = fmaf(p[2], hin[2 * e2 + 1], p[3]); } }
    const int t0 = 64 * c - 48; const size_t mrow0 = (size_t)b * TP;
    u32x4 ra[8], rb[8];
#pragma unroll
    for (int k = 0; k < 8; ++k) { const int t = t0 + tsub + 8 * k; const int tc = t >= 0 ? t : 0;
        ra[k] = *(const u32x4*)(U + (mrow0 + tc) * DIN + 512 + ch8); rb[k] = *(const u32x4*)(BETA + ((size_t)b * TP + tc) * 512 + ch8); }
#pragma unroll
    for (int k = 0; k < 8; ++k) { const int t = t0 + tsub + 8 * k; if (t < 0) continue;
        float al[8], be[8]; unpack8(ra[k], al); unpack8(rb[k], be);
#pragma unroll
        for (int e = 0; e < 8; ++e) al[e] = fmaf(be[e], hin[e], al[e]);
        *(u32x4*)(MIX + (mrow0 + t) * DMIX + ch8) = pack8(al); }
    if (c == NCH - 1 && tsub == 0) { float* o = A.out + O_HP + (size_t)(l * NB + b) * 512 + ch8;
#pragma unroll
        for (int e2 = 0; e2 < 4; ++e2) { const f32x4 p = RGS[(size_t)c * 256 + e2]; o[2 * e2] = fmaf(p[0], hin[2 * e2], p[1]); o[2 * e2 + 1] = fmaf(p[2], hin[2 * e2 + 1], p[3]); } }
}

DI void phase_p3(const Args& A, const Ctx& C, int l) {
    if (C.G < 256) return;
    if (C.bid < 128) { const int kind = C.bid & 1, bh = (C.bid >> 1) & 31, half = C.bid >> 6;
        if (kind) p3_ret_chain(A, C, l, bh >> 2, bh & 3, half); else p3_gdn_chain(A, C, l, bh >> 2, bh & 3, half);
        return; }
    const int NJ = C.G - 128;
    for (int it = C.bid - 128; it < 1024; it += NJ) {
        if (it < 512) p3_dec_item<1>(A, C, l, it >> 2, it & 3);
        else p3_dec_item<0>(A, C, l, (it - 512) >> 2, it & 3);
    }
    for (int r = C.bid - 128; r < NB * NCH; r += NJ) p3_rg_fix(A, C, l, r / NCH, r % NCH);
}

DI void p4_tail_task(const Args& A, const Ctx& C, int l, int task) {
    const int lane = C.lane, fr = lane & 15, fq = lane >> 4, col0 = (task & 63) * 16, row0 = (M - 256) + (task >> 6) * 64 + (C.wave & 3) * 16, kh = C.wave >> 2;
    const bf16* ap = (const bf16*)(A.ws + WS_MIX) + (size_t)(row0 + fr) * DMIX + kh * 768 + 8 * fq;
    const bf16* bp = (const bf16*)(A.ws + ((l & 1) ? WS_WOUTT1 : WS_WOUTT)) + (size_t)(col0 + fr) * DMIX + kh * 768 + 8 * fq;
    f32x4 acc = (f32x4){0.f, 0.f, 0.f, 0.f};
#pragma unroll
    for (int hb = 0; hb < 2; ++hb) { bf16x8 a[12], bb[12];
#pragma unroll
        for (int u = 0; u < 12; ++u) { a[u] = *(const bf16x8*)(ap + (hb * 12 + u) * 32); bb[u] = *(const bf16x8*)(bp + (hb * 12 + u) * 32); }
#pragma unroll
        for (int u = 0; u < 12; ++u) acc = mfma16(a[u], bb[u], acc); }
    LAS f32x4* red = (LAS f32x4*)C.lds;
    __syncthreads();
    if (kh == 1) red[(C.wave & 3) * 64 + lane] = acc;
    __syncthreads();
    if (kh == 0) { const f32x4 o = acc + red[(C.wave & 3) * 64 + lane]; float* XF = (float*)(A.ws + WS_XF); const bf16* XB = (const bf16*)(A.ws + WS_XB);
#pragma unroll
        for (int r = 0; r < 4; ++r) { const size_t ix = (size_t)(row0 + 4 * fq + r) * DM + col0 + fr; XF[ix] = ALPHA * bf2f(XB[ix]) + o[r]; } }
}


#endif
constexpr int PPL = 6, N_PHASES = 1 + PPL * DEPTH;
#if defined(__HIP_DEVICE_COMPILE__)
DI const Args* launder(const Args* p) { asm volatile("" : "+s"(p)); return p; }
#endif
__global__ void __launch_bounds__(NTHR, 2) mk_fwd(Args args) {
#if defined(__HIP_DEVICE_COMPILE__)
    extern __shared__ __attribute__((aligned(16))) unsigned char lds_raw[];
    const Args* AP = (const Args*)__builtin_amdgcn_kernarg_segment_ptr();
#define A (*launder(AP))
#define MISCP ((volatile LAS unsigned*)((LAS unsigned char*)lds_raw + MISC_OFF))
#define MK_CTX() Ctx C; { int t_ = threadIdx.x; asm volatile("" : "+v"(t_)); C.lds = (LAS unsigned char*)lds_raw; C.tid = t_; C.lane = t_ & 63; C.wave = __builtin_amdgcn_readfirstlane(t_ >> 6); C.G = gridDim.x; C.bid = blockIdx.x; }
#define IN(p) (A.ph_lo <= (p) && (p) < A.ph_hi)
#define SEAM(p) do { if (IN(p) && IN((p) + 1)) { XcdBarrier bar_; bar_.bar = (unsigned*)(A.ws + WS_CTL) + CW_BAR; bar_.x = xb_xcc_id(); bar_.st = MISCP + 8; xcd_barrier(bar_); } } while (0)
    if (threadIdx.x < 32) MISCP[threadIdx.x] = 0u;
    __syncthreads();
#if MK_TMASK || MK_TMODE
#define TSTAMP ((volatile LAS unsigned long long*)((LAS unsigned char*)lds_raw + MISC_OFF + 64))
#define STAMP(ph) do { if (blockIdx.x == MK_TBLOCK && threadIdx.x == 0) { const unsigned long long now_ = __builtin_amdgcn_s_memrealtime(); if (!MK_TMODE && ((MK_TMASK >> (ph)) & 1)) TSTAMP[1] += now_ - TSTAMP[0]; TSTAMP[0] = now_; } } while (0)
#define STAMP_PRE(ph) do { if (MK_TMODE) { __syncthreads(); if (blockIdx.x == MK_TBLOCK && threadIdx.x == 0 && ((MK_TMASK >> (ph)) & 1)) TSTAMP[1] += __builtin_amdgcn_s_memrealtime() - TSTAMP[0]; } } while (0)
    if (blockIdx.x == MK_TBLOCK && threadIdx.x == 0) { TSTAMP[0] = __builtin_amdgcn_s_memrealtime(); TSTAMP[1] = 0ull; }
#else
#define STAMP(ph) do { } while (0)
#define STAMP_PRE(ph) do { } while (0)
#endif
    if (A.ph_hi - A.ph_lo > 1) (void)xcd_barrier_post((unsigned*)(A.ws + WS_CTL) + CW_BAR, MISCP + 8);
    if (IN(0)) { MK_CTX(); convert_weights(A, C, 0, C.bid * NWAVES + C.wave, C.G * NWAVES); build_rope_table(A, C); row_pass(A, C, 0); }
    STAMP_PRE(0); SEAM(0); STAMP(0);
#define LAYER(l) do { \
        if (IN(1 + PPL * (l))) { struct { LAS unsigned char* lds; int G, bid; } C{(LAS unsigned char*)lds_raw, (int)gridDim.x, (int)blockIdx.x}; \
            { pg8::Gemm g{(const pg8::bf16_t*)(A.ws + WS_XB), (const pg8::bf16_t*)(A.ws + (((l) & 1) ? WS_WINT1 : WS_WINT)), M, DIN, DM, DM}; pg8::StaticOrder S; S.init(M, DIN, C.G, C.bid); \
              pg8::EpiU E{(pg8::bf16_t*)(A.ws + WS_U), DIN}; \
              pg8::gemm_phase<pg8::EpiU, pg8::StaticOrder, true, true>(C.lds, g, S, E); } \
              \
            if ((l) + 1 < DEPTH && (int)C.bid >= (M / 256) * (DIN / 256) % C.G) { MK_CTX(); const int nb_ = (M / 256) * (DIN / 256) % C.G; convert_weights(A, C, (l) + 1, ((int)C.bid - nb_) * NWAVES + C.wave, (C.G - nb_) * NWAVES); } } \
        STAMP_PRE(1 + PPL * (l)); SEAM(1 + PPL * (l)); STAMP(1 + PPL * (l)); \
        if (IN(2 + PPL * (l))) { MK_CTX(); phase_p2(A, C, (l)); } \
        STAMP_PRE(2 + PPL * (l)); SEAM(2 + PPL * (l)); STAMP(2 + PPL * (l)); \
        if (IN(3 + PPL * (l))) { MK_CTX(); phase_p3(A, C, (l)); } \
        STAMP_PRE(3 + PPL * (l)); SEAM(3 + PPL * (l)); STAMP(3 + PPL * (l)); \
        if (IN(4 + PPL * (l))) { MK_CTX(); phase_p3b(A, C, (l)); } \
        STAMP_PRE(4 + PPL * (l)); SEAM(4 + PPL * (l)); STAMP(4 + PPL * (l)); \
        if (IN(5 + PPL * (l))) { struct { LAS unsigned char* lds; int G, bid; } C{(LAS unsigned char*)lds_raw, (int)gridDim.x, (int)blockIdx.x}; \
              \
              \
            { pg8::Gemm g{(const pg8::bf16_t*)(A.ws + WS_MIX), (const pg8::bf16_t*)(A.ws + (((l) & 1) ? WS_WOUTT1 : WS_WOUTT)), M - 256, DM, DMIX, DMIX}; pg8::StaticOrder S; S.init(M - 256, DM, C.G, C.bid); \
              pg8::EpiAcc E{(float*)(A.ws + WS_XF), (const pg8::bf16_t*)(A.ws + WS_XB), DM, ALPHA}; \
              pg8::gemm_phase<pg8::EpiAcc, pg8::StaticOrder, false, true>(C.lds, g, S, E); } \
            { MK_CTX(); p4_tail_task(A, C, (l), (int)C.bid); } } \
        STAMP_PRE(5 + PPL * (l)); SEAM(5 + PPL * (l)); STAMP(5 + PPL * (l)); \
        if (IN(6 + PPL * (l))) { MK_CTX(); row_pass(A, C, (l) + 1); } \
        STAMP_PRE(6 + PPL * (l)); if ((l) + 1 < DEPTH) SEAM(6 + PPL * (l)); STAMP(6 + PPL * (l)); } while (0)
    LAYER(0); LAYER(1); LAYER(2); LAYER(3);
#undef LAYER
#if MK_TMASK || MK_TMODE
    __syncthreads();
    if (blockIdx.x == MK_TBLOCK && threadIdx.x == 0) { const unsigned long long t0_ = __builtin_amdgcn_s_memrealtime(), tgt_ = TSTAMP[1] * 9ull;
        while (__builtin_amdgcn_s_memrealtime() - t0_ < tgt_) __builtin_amdgcn_s_sleep(8); }
#endif
#undef IN
#undef SEAM
#undef A
#undef MK_CTX
#undef MISCP
#endif
}

}

#ifndef MK_DEBUG
#define MK_DEBUG 0
#endif
#ifndef MK_PROBE
#define MK_PROBE -1
#endif
#ifndef MK_LAUNCH_PER_PHASE
#define MK_LAUNCH_PER_PHASE 0
#endif
extern "C" void kernel_launch(void* const* d_in, const int* in_sizes, int n_in, void* d_out, int out_size, void* d_ws, size_t ws_size, hipStream_t stream) {
    using namespace fx;
    static int grid = 0;
    if (grid == 0) {
        int dev = 0, cus = 0;
        if (n_in != 25 || out_size != (int)O_END || ws_size < WS_END) { fprintf(stderr, "kernel_launch: unexpected sizes (n_in %d, out %d, ws %zu)\n", n_in, out_size, ws_size); grid = -1; return; }
        if (hipGetDevice(&dev) != hipSuccess || hipDeviceGetAttribute(&cus, hipDeviceAttributeMultiprocessorCount, dev) != hipSuccess) { grid = -1; return; }
        if (hipFuncSetAttribute((const void*)mk_fwd, hipFuncAttributeMaxDynamicSharedMemorySize, LDS_BYTES) != hipSuccess) { fprintf(stderr, "kernel_launch: hipFuncSetAttribute failed\n"); grid = -1; return; }
        (void)hipGetLastError();
        grid = cus;
    }
    if (grid < 0) return;
    unsigned char* ws = (unsigned char*)d_ws;
    (void)hipMemsetAsync(ws + WS_CTL, 0, CTL_ZERO_BYTES, stream);
    Args a{};
    for (int i = 0; i < 25; ++i) a.in[i] = (GAS const float*)d_in[i];
    a.out = (GAS float*)d_out; a.ws = (GAS unsigned char*)ws;
#if MK_DEBUG
    using namespace dbg;
    float* err = (float*)(ws + D_ERR);
    (void)hipMemsetAsync(err, 0, 8192, stream);
    nv::Io io; for (int i = 0; i < 25; ++i) io.in[i] = (const float*)d_in[i]; io.out = (float*)d_out;
    const float* XF = (const float*)(ws + WS_XF); const bf16* XB = (const bf16*)(ws + WS_XB); const float* GAB = (const float*)(ws + WS_GAB); const bf16* U = (const bf16*)(ws + WS_U);
    const bf16* MIX = (const bf16*)(ws + WS_MIX); float* MIXn = (float*)(ws + D_MIXN); float* CST = (float*)(ws + D_ST); float* XFc = (float*)(ws + D_XFC);
    float* out = (float*)d_out;
    for (int ph = 0; ph < N_PHASES; ++ph) {
        const int l = ph == 0 ? -1 : (ph - 1) / 5, k = ph == 0 ? -1 : (ph - 1) % 5;
        if (k == 1) {
            nv::LayerP P = nv::layer_params(io, l);
            P.o_hp = CST + C_HP; P.o_cp = CST + C_CP; P.o_rp = CST + C_RP; P.o_gcp = CST + C_GCP; P.o_gp = CST + C_GP;
            P.o_hs = CST + C_HS; P.o_cs = CST + C_CS; P.o_rs = CST + C_RS; P.o_gcs = CST + C_GCS; P.o_gs = CST + C_GS;
            const nv::Grp g{0, 1, 0, 16}; const nv::UBF ua{(const unsigned short*)U, GAB, 2064, 0};
            nv::rg_kernel<nv::UBF><<<dim3(8, 17), 64, 0, stream>>>(g, P, ua, MIXn);
            nv::ret_kernel<nv::UBF><<<dim3(4, 17), 256, 0, stream>>>(g, P, ua, MIXn);
            nv::gdn_kernel<nv::UBF><<<dim3(4, 17), 256, 0, stream>>>(g, P, ua, MIXn);
        }
        if (k == 3) copy_rows<<<SUBR, 256, 0, stream>>>(XF, XFc);
        a.ph_lo = ph; a.ph_hi = ph + 1;
        hipLaunchKernelGGL(mk_fwd, dim3(grid), dim3(NTHR), LDS_BYTES, stream, a);
        if (ph == 0 || k == 4) { const int ln = l + 1;
            if (ln < DEPTH) {
                if (ln == 0) chk_x0<<<SUBR, 256, 0, stream>>>(XF, io.in[0], io.in[1], io.in[7], err, 18 * ln + 0);
                chk_rows_in<<<SUBR, 256, 0, stream>>>(XF, XB, GAB, io.in[8] + (size_t)ln * DM * DINX, err, 18 * ln + 0);
                chk_wt<<<1024, 256, 0, stream>>>((const bf16*)(ws + WS_WINT), io.in[8] + (size_t)ln * DM * DINX, DINX, DM, DIN, err, 18 * ln + 1);
                chk_wt<<<512, 256, 0, stream>>>((const bf16*)(ws + WS_WOUTT), io.in[22] + (size_t)ln * DMIX * DM, DM, DMIX, DM, err, 18 * ln + 1);
                for (int gt = 0; gt < 2; ++gt) for (int n = 0; n < 8; ++n)
                    chk_wt<<<4, 256, 0, stream>>>((const bf16*)(ws + WS_GATEW) + (size_t)(gt * 8 + n) * 4096, io.in[gt ? 13 : 11] + ((size_t)ln * 8 + n) * 4096, 64, 64, 64, err, 18 * ln + 1);
            }
        }
        if (k == 0) chk_u<<<dim3(DIN / 256, SUBR), 256, 0, stream>>>(XF, io.in[8] + (size_t)l * DM * DINX, U, err, 18 * l + 2);
        if (k == 2) {
            chk_mix<<<SUBR, 256, 0, stream>>>(MIX, MIXn, err, 18 * l + 3);
            chk_vec<<<8, 256, 0, stream>>>(CST + C_HP, out + O_HP + (size_t)(l * NB) * 512, 512, err, 18 * l + 9);
            chk_vec<<<8, 256, 0, stream>>>(CST + C_CP, out + O_CP + (size_t)(l * NB) * 1536, 1536, err, 18 * l + 10);
            chk_vec<<<8, 256, 0, stream>>>(CST + C_GCP, out + O_GCP + (size_t)(l * NB) * 4608, 4608, err, 18 * l + 10);
            chk_vec<<<64, 256, 0, stream>>>(CST + C_RP, out + O_RP + (size_t)(l * NB) * 65536, 65536, err, 18 * l + 11);
            chk_vec<<<64, 256, 0, stream>>>(CST + C_GP, out + O_GP + (size_t)(l * NB) * 65536, 65536, err, 18 * l + 12);
            chk_vec<<<16, 256, 0, stream>>>(CST + C_HS, out + O_HS + (size_t)(l * NS) * 512, 16 * 512, err, 18 * l + 13);
            chk_vec<<<16, 256, 0, stream>>>(CST + C_CS, out + O_CS + (size_t)(l * NS) * 1536, 16 * 1536, err, 18 * l + 14);
            chk_vec<<<16, 256, 0, stream>>>(CST + C_GCS, out + O_GCS + (size_t)(l * NS) * 4608, 16 * 4608, err, 18 * l + 14);
            chk_vec<<<256, 256, 0, stream>>>(CST + C_RS, out + O_RS + (size_t)(l * NS) * 65536, 16 * 65536, err, 18 * l + 15);
            chk_vec<<<256, 256, 0, stream>>>(CST + C_GS, out + O_GS + (size_t)(l * NS) * 65536, 16 * 65536, err, 18 * l + 16);
        }
        if (k == 4) chk_out<<<SUBR, 256, 0, stream>>>(XFc, MIX, io.in[22] + (size_t)l * DMIX * DM, io.in[23] + (size_t)l * DM, io.in[24] + (size_t)l * DM,
                                                     XF, out + O_YP, out + O_YS, l == DEPTH - 1, err, 18 * l + 17);
    }
    nv::run(io, nv::Grp{0, 4, 0, 64}, ws, stream);
    nv::run(io, nv::Grp{4, 4, 64, 64}, ws, stream);
    dbg_eval<<<1, 64, 0, stream>>>(err, MK_PROBE);
    dbg_apply<<<128, 256, 0, stream>>>(err, out + O_YS);
#else
#if MK_LAUNCH_PER_PHASE
    for (int ph = 0; ph < N_PHASES; ++ph) { a.ph_lo = ph; a.ph_hi = ph + 1; hipLaunchKernelGGL(mk_fwd, dim3(grid), dim3(NTHR), LDS_BYTES, stream, a); }
#else
    a.ph_lo = 0; a.ph_hi = N_PHASES;
    hipLaunchKernelGGL(mk_fwd, dim3(grid), dim3(NTHR), LDS_BYTES, stream, a);
#endif
#endif
}
```

```cpp
#include <hip/hip_runtime.h>
#include <cstdio>
#include <cstdint>
#define MK_DEBUG 0
#define MK_PROBE -1
#define MK_LAUNCH_PER_PHASE 0
#define MK_TMASK 0u
#define MK_TMODE 0
#define MK_TBLOCK 0
#define MK_TSUB 0
#define MK_TTHREAD 0

namespace fx {
#define GAS __attribute__((address_space(1)))
#define LAS __attribute__((address_space(3)))
#define DI __device__ __forceinline__
typedef unsigned short bf16;
typedef short bf16x8 __attribute__((ext_vector_type(8)));
typedef float f32x4 __attribute__((ext_vector_type(4)));
typedef float f32x2 __attribute__((ext_vector_type(2)));
typedef unsigned u32x4 __attribute__((ext_vector_type(4)));
typedef unsigned u32x2 __attribute__((ext_vector_type(2)));
typedef GAS unsigned gu32;

constexpr int NWAVES = 8, NTHR = 512;
constexpr int DM = 1024, TP = 2064, NB = 8, NS = 128, MP = NB * TP, M = MP + NS, DIN = 5120, DINX = 5128, DMIX = 1536, DEPTH = 4, NCH = 33, NCHH = NB * NCH * 4;
constexpr float EPS = 1e-6f, ALPHA = 1.681792830507429f, QSCALE = 0.08838834764831845f;

constexpr size_t MiB = 1u << 20;
constexpr size_t WS_CTL = 0, CTL_ZERO_BYTES = 1 * MiB;
constexpr size_t WS_TAB = 1 * MiB;
constexpr size_t WS_GATEW = 3 * MiB;
constexpr size_t WS_WINT = 4 * MiB;
constexpr size_t WS_WOUTT = 14 * MiB;
constexpr size_t WS_GAB = 17 * MiB;
constexpr size_t WS_RGS = 18 * MiB;
constexpr size_t WS_EGL = 20 * MiB;
constexpr size_t WS_XB = 21 * MiB;
constexpr size_t WS_XF = 54 * MiB;
constexpr size_t WS_U = 119 * MiB;
constexpr size_t WS_MIX = 282 * MiB;
constexpr size_t WS_BETA = 331 * MiB;
constexpr size_t WS_GDN = 348 * MiB;
constexpr size_t WS_RET = 423 * MiB;
constexpr size_t WS_DBG = 465 * MiB;
constexpr size_t WS_WINT1 = 470 * MiB;
constexpr size_t WS_GATEW1 = 3 * MiB + 512 * 1024;
constexpr size_t WS_WOUTT1 = 508 * MiB;
constexpr size_t WS_END = 512 * MiB;
constexpr size_t T16 = 16384, T8 = 8192;
constexpr size_t G_W = WS_GDN, G_QG = G_W + NCHH * T16, G_KDT = G_QG + NCHH * T16, G_UT = G_KDT + NCHH * T16, G_ATT = G_UT + NCHH * T16;
constexpr size_t R_KRT = WS_RET, R_VT = R_KRT + NCHH * T16, R_SC = R_VT + NCHH * T16;
constexpr size_t S_QH = WS_MIX, S_KH = S_QH + NCHH * T16, S_RWT = 481 * MiB;
static_assert(G_ATT + NCHH * T8 <= WS_RET && R_SC + NCHH * T8 <= WS_DBG, "ws map");
static_assert(S_KH + NCHH * T16 <= WS_BETA && S_RWT >= WS_WINT1 + 10 * MiB && S_RWT + NCHH * T16 <= WS_WOUTT1, "ws alias map");
constexpr int CW_BAR = 4096;
constexpr int CW_PANEL = 32768;
constexpr int CW_Q = 16384;

constexpr int RING_BYTES = 131072;
constexpr int PRIV_BYTES = 18432;
constexpr int MISC_OFF = 147456;
constexpr int LDS_BYTES = 149504;

constexpr size_t O_YP = 0, O_YS = 16777216, O_HP = 16908288, O_CP = 16924672, O_RP = 16973824, O_GCP = 19070976, O_GP = 19218432,
                 O_HS = 21315584, O_CS = 21577728, O_RS = 22364160, O_GCS = 55918592, O_GS = 58277888, O_END = 91832320;

typedef __bf16 bf16x2_t __attribute__((ext_vector_type(2)));
DI unsigned pk2(float lo, float hi) { const bf16x2_t r = __builtin_convertvector((f32x2){lo, hi}, bf16x2_t); return __builtin_bit_cast(unsigned, r); }
DI unsigned f2bf(float f) { return pk2(f, 0.f) & 0xffffu; }
DI float bflo(unsigned w) { return __builtin_bit_cast(float, w << 16); }
DI float bfhi(unsigned w) { return __builtin_bit_cast(float, w & 0xffff0000u); }
DI float bf2f(bf16 h) { return __builtin_bit_cast(float, (unsigned)h << 16); }
DI void unpack8(const u32x4 w, float (&x)[8]) { x[0] = bflo(w.x); x[1] = bfhi(w.x); x[2] = bflo(w.y); x[3] = bfhi(w.y); x[4] = bflo(w.z); x[5] = bfhi(w.z); x[6] = bflo(w.w); x[7] = bfhi(w.w); }
DI u32x4 pack8(const float (&x)[8]) { u32x4 w; w.x = pk2(x[0], x[1]); w.y = pk2(x[2], x[3]); w.z = pk2(x[4], x[5]); w.w = pk2(x[6], x[7]); return w; }
DI u32x2 pack4(const f32x4 v) { u32x2 w; w.x = pk2(v[0], v[1]); w.y = pk2(v[2], v[3]); return w; }
DI f32x4 unpack4(const u32x2 w) { return (f32x4){bflo(w.x), bfhi(w.x), bflo(w.y), bfhi(w.y)}; }
DI float sigmoidf_(float x) { return __builtin_amdgcn_rcpf(1.f + __expf(-x)); }
DI float siluf_(float x) { return x * __builtin_amdgcn_rcpf(1.f + __expf(-x)); }
DI float softplusf_(float x) { const float e = __expf(-fabsf(x)); const float l = e < 1e-3f ? e * (1.f - 0.5f * e) : __logf(1.f + e); return fmaxf(x, 0.f) + l; }
template <int CTRL> DI float dpp_f(float old, float x) { return __builtin_bit_cast(float, __builtin_amdgcn_update_dpp(__builtin_bit_cast(int, old), __builtin_bit_cast(int, x), CTRL, 0xf, 0xf, false)); }
DI float row_sum16(float x) {
    x += dpp_f<0xB1>(0.f, x);
    x += dpp_f<0x4E>(0.f, x);
    x += dpp_f<0x141>(0.f, x);
    x += dpp_f<0x140>(0.f, x);
    return x;
}
DI float rdlane(float x, int l) { return __builtin_bit_cast(float, __builtin_amdgcn_readlane(__builtin_bit_cast(int, x), l)); }
DI float wave_sum(float v) { v = row_sum16(v); return (rdlane(v, 0) + rdlane(v, 16)) + (rdlane(v, 32) + rdlane(v, 48)); }
DI float row_bcast15(float x) { return __builtin_bit_cast(float, __builtin_amdgcn_ds_swizzle(__builtin_bit_cast(int, x), 0x1F0)); }
DI float neg_expm1f_(float x) {
    const float ser = -x * (1.f + x * (0.5f + x * (0.16666667f + x * (0.041666668f + x * (0.0083333338f + x * 0.0013888889f)))));
    return x > -0.25f ? ser : 1.f - __expf(x);
}
#define LDS_WAIT() asm volatile("s_waitcnt lgkmcnt(0)" ::: "memory")
#define VM_WAIT() asm volatile("s_waitcnt vmcnt(0)" ::: "memory")
DI f32x4 mfma16(bf16x8 a, bf16x8 b, f32x4 c) { return __builtin_amdgcn_mfma_f32_16x16x32_bf16(a, b, c, 0, 0, 0); }
#if MK_TMODE == 2
#define TS_BEGIN(id) do { if ((id) == MK_TSUB && blockIdx.x == MK_TBLOCK && threadIdx.x == MK_TTHREAD) *(volatile LAS unsigned long long*)(size_t)(MISC_OFF + 80) = __builtin_amdgcn_s_memrealtime(); } while (0)
#define TS_END(id) do { if ((id) == MK_TSUB && blockIdx.x == MK_TBLOCK && threadIdx.x == MK_TTHREAD) *(volatile LAS unsigned long long*)(size_t)(MISC_OFF + 72) += __builtin_amdgcn_s_memrealtime() - *(volatile LAS unsigned long long*)(size_t)(MISC_OFF + 80); } while (0)
#else
#define TS_BEGIN(id) do { } while (0)
#define TS_END(id) do { } while (0)
#endif
}

namespace pg8 {
#define PG8_LAS __attribute__((address_space(3)))
typedef unsigned short bf16_t;
typedef short bf16x8 __attribute__((ext_vector_type(8)));
typedef float f32x4 __attribute__((ext_vector_type(4)));
typedef unsigned u32x4 __attribute__((ext_vector_type(4)));
constexpr int BM = 256, BK = 64, HALF = 128, HTB = HALF * BK * 2  , STAGE_BYTES = 8 * HTB, NXCD = 8, WGM = 8;

__host__ __device__ __forceinline__ int lds_byte(int r, int c) { const int st = (r >> 4) * 2 + (c >> 5), rr = r & 15, cc = c & 31, ob = rr * 64 + cc * 2; return st * 1024 + (ob ^ (((ob >> 9) & 1) << 5)); }
__host__ __device__ __forceinline__ void stage_rc(int b, int& R, int& C) { const int st = b / 1024, sb = b % 1024, swz = sb ^ (((sb >> 9) & 1) << 5); R = (st >> 1) * 16 + swz / 64; C = (st & 1) * 32 + (swz % 64) / 2; }
__host__ __device__ __forceinline__ int perm32(int rho) { const int n = rho >> 4, i = rho & 15; return 8 * (i >> 2) + 4 * n + (i & 3); }

struct Unit { int pm, pn, ko; };
struct Gemm { const bf16_t* A; const bf16_t* Bt; int M, N, K, ld; };

struct StaticOrder {
    int nM, nN, nwg, G, c;
    __host__ __device__ void init(int M, int N, int G_, int c_) { nM = M / BM; nN = N / BM; nwg = nM * nN; G = G_; c = c_; }
    __host__ __device__ bool next(int i, Unit& u) const {
        const long L = (long)i * G + c; if (L >= nwg) return false;
        int wgid = (int)L; { const int q = nwg / NXCD, r = nwg % NXCD, xcd = wgid % NXCD, off = wgid / NXCD; wgid = (xcd < r ? xcd * (q + 1) : r * (q + 1) + (xcd - r) * q) + off; }
        const int nig = WGM * nN, gid = wgid / nig, fm = gid * WGM, gsz = (nM - fm) < WGM ? (nM - fm) : WGM;
        u.pm = fm + ((wgid % nig) % gsz); u.pn = (wgid % nig) / gsz; u.ko = 0; return true;
    }
    __device__ __forceinline__ void a_ready(const Unit&) const {}
    __device__ __forceinline__ void done(const Unit&) const {}
};


__device__ __forceinline__ unsigned cvt_pk_bf16(float lo, float hi) { unsigned r; asm volatile("v_cvt_pk_bf16_f32 %0, %1, %2" : "=v"(r) : "v"(lo), "v"(hi)); return r; }
struct EpiU {
    static constexpr bool PERM = true, AFTER_DRAIN = false;
    bf16_t* O; int ldc;
    __device__ __forceinline__ void operator()(const f32x4 (&acc)[2][2][4][2], const Unit& u, int wr, int wc, int fr, int fq) const {
        const int row0 = u.pm * BM + wr * 64 + fr, col0 = u.pn * BM + wc * 32 + 8 * fq;
#pragma unroll
        for (int ai = 0; ai < 2; ++ai)
#pragma unroll
            for (int m = 0; m < 4; ++m) { bf16_t* rowp = O + (size_t)(row0 + ai * HALF + m * 16) * ldc + col0;
#pragma unroll
                for (int bj = 0; bj < 2; ++bj) { const f32x4 v0 = acc[ai][bj][m][0], v1 = acc[ai][bj][m][1];
                    u32x4 w; w.x = cvt_pk_bf16(v0[0], v0[1]); w.y = cvt_pk_bf16(v0[2], v0[3]); w.z = cvt_pk_bf16(v1[0], v1[1]); w.w = cvt_pk_bf16(v1[2], v1[3]);
                    *(u32x4*)(rowp + bj * HALF) = w; } }
    }
};
struct SliceOrder {
    int pm, nitems, G, c, kslice;
    __device__ __forceinline__ bool next(int i, Unit& u) const { const int id = i * G + c; if (id >= nitems) return false; u.pm = pm; u.pn = id & 3; u.ko = (id >> 2) * kslice; return true; }
    __device__ __forceinline__ void a_ready(const Unit&) const {}
    __device__ __forceinline__ void done(const Unit&) const {}
};
struct EpiAcc {
    static constexpr bool PERM = true, AFTER_DRAIN = false;
    bf16_t* Y; const bf16_t* XB; int ldc; float alpha;
    __device__ __forceinline__ void operator()(const f32x4 (&acc)[2][2][4][2], const Unit& u, int wr, int wc, int fr, int fq) const {
        const int col0 = u.pn * BM + wc * 32 + 8 * fq;
#pragma unroll
        for (int ai = 0; ai < 2; ++ai) {
            u32x4 res[4][2];
#pragma unroll
            for (int m = 0; m < 4; ++m) { const int r = u.pm * BM + ai * HALF + wr * 64 + m * 16 + fr; const bf16_t* rowp = XB + (size_t)r * ldc + col0;
#pragma unroll
                for (int bj = 0; bj < 2; ++bj) res[m][bj] = *(const u32x4*)(rowp + bj * HALF); }
#pragma unroll
            for (int m = 0; m < 4; ++m) { const int r = u.pm * BM + ai * HALF + wr * 64 + m * 16 + fr; bf16_t* rowp = Y + (size_t)r * ldc + col0;
#pragma unroll
                for (int bj = 0; bj < 2; ++bj) { const u32x4 w = res[m][bj];
                    const f32x4 x0 = (f32x4){__builtin_bit_cast(float, w.x << 16), __builtin_bit_cast(float, w.x & 0xffff0000u), __builtin_bit_cast(float, w.y << 16), __builtin_bit_cast(float, w.y & 0xffff0000u)};
                    const f32x4 x1 = (f32x4){__builtin_bit_cast(float, w.z << 16), __builtin_bit_cast(float, w.z & 0xffff0000u), __builtin_bit_cast(float, w.w << 16), __builtin_bit_cast(float, w.w & 0xffff0000u)};
                    const f32x4 y0 = x0 * alpha + acc[ai][bj][m][0], y1 = x1 * alpha + acc[ai][bj][m][1];
                    u32x4 o; o.x = fx::pk2(y0[0], y0[1]); o.y = fx::pk2(y0[2], y0[3]); o.z = fx::pk2(y1[0], y1[1]); o.w = fx::pk2(y1[2], y1[3]);
                    *(u32x4*)(rowp + bj * HALF) = o; } }
            asm volatile("" ::: "memory"); }
    }
};
struct EpiRes {
    static constexpr bool PERM = false, AFTER_DRAIN = false;
    float* X; int ldc; float alpha;
    __device__ __forceinline__ void operator()(const f32x4 (&acc)[2][2][4][2], const Unit& u, int wr, int wc, int fr, int fq) const {
        const int col0 = u.pn * BM + wc * 32 + 4 * fq;
#pragma unroll
        for (int ai = 0; ai < 2; ++ai)
#pragma unroll
            for (int m = 0; m < 4; ++m) { const int r = u.pm * BM + ai * HALF + wr * 64 + m * 16 + fr; float* rowp = X + (size_t)r * ldc + col0;
#pragma unroll
                for (int bj = 0; bj < 2; ++bj)
#pragma unroll
                    for (int n = 0; n < 2; ++n) { f32x4* p = (f32x4*)(rowp + bj * HALF + n * 16); const f32x4 b = *p; *p = b * alpha + acc[ai][bj][m][n]; }
                asm volatile("" ::: "memory"); }
    }
};

template <class Epi, class Sched, bool ALIGN_EPI = false, bool SP2 = false>
__device__ __forceinline__ void gemm_phase(PG8_LAS unsigned char* lds, const Gemm g, const Sched& S, const Epi& E) {
    int tid_ = threadIdx.x; asm volatile("" : "+v"(tid_));
    const int tid = tid_, wid = __builtin_amdgcn_readfirstlane(tid >> 6), lane = tid & 63, wr = wid >> 2, wc = wid & 3, fr = lane & 15, fq = lane >> 4;
    const int K = g.K, nt = K / BK;
    unsigned voffA[2], voffB[2];
#pragma unroll
    for (int i = 0; i < 2; ++i) { int R, C; stage_rc(tid * 16 + i * 8192, R, C); const int Rb = Epi::PERM ? ((R & ~31) + perm32(R & 31)) : R;
        voffA[i] = (unsigned)(R * g.ld + C) * 2u; voffB[i] = (unsigned)(Rb * g.ld + C) * 2u; }
    const size_t kstep = (size_t)(BK * 2);
    const size_t hstep = (size_t)HALF * g.ld * 2;
    const size_t tstep = 2 * hstep;
    const unsigned ldsw = (unsigned)wid * 1024u;
    const int aoff = lds_byte(wr * 64 + fr, fq * 8), boff = lds_byte(wc * 32 + fr, fq * 8);
#define PG8_SA(b, h) (((b) * 2 + (h)) * HTB)
#define PG8_SB(b, h) ((4 + (b) * 2 + (h)) * HTB)
#define PG8_STAGE(bufoff, gbase, voff) do { _Pragma("unroll") for (int _i = 0; _i < 2; ++_i) \
        __builtin_amdgcn_global_load_lds((const unsigned*)((const char*)(gbase) + (voff)[_i]), (PG8_LAS unsigned*)(lds + (bufoff) + ldsw + _i * 8192), 16, 0, 0); } while (0)
#define PG8_LDA(dst, b, h) do { _Pragma("unroll") for (int m = 0; m < 4; ++m) _Pragma("unroll") for (int k = 0; k < 2; ++k) dst[m][k] = *(const PG8_LAS bf16x8*)(lds + PG8_SA(b, h) + aoff + m * 2048 + k * 1024); } while (0)
#define PG8_LDB(dst, b, h) do { _Pragma("unroll") for (int n = 0; n < 2; ++n) _Pragma("unroll") for (int k = 0; k < 2; ++k) dst[n][k] = *(const PG8_LAS bf16x8*)(lds + PG8_SB(b, h) + boff + n * 2048 + k * 1024); } while (0)
#define PG8_MMA(ai, bj, At, Bt) do { __builtin_amdgcn_s_setprio(1); _Pragma("unroll") for (int m = 0; m < 4; ++m) _Pragma("unroll") for (int n = 0; n < 2; ++n) _Pragma("unroll") for (int k = 0; k < 2; ++k) \
        acc[ai][bj][m][n] = __builtin_amdgcn_mfma_f32_16x16x32_bf16(Bt[n][k], At[m][k], acc[ai][bj][m][n], 0, 0, 0); __builtin_amdgcn_s_setprio(0); } while (0)
#define PG8_WAIT_V(n) asm volatile("s_waitcnt vmcnt(" #n ")" ::: "memory")
#define PG8_WAIT_L(n) asm volatile("s_waitcnt lgkmcnt(" #n ")" ::: "memory")
#define PG8_BAR __builtin_amdgcn_s_barrier()
#define PG8_SCHED __builtin_amdgcn_sched_barrier(0)
    Unit cur, nxt; int ui = 0;
    if (!S.next(0, cur)) return;
    f32x4 acc[2][2][4][2];
#pragma unroll
    for (int a = 0; a < 2; ++a)
#pragma unroll
        for (int b = 0; b < 2; ++b)
#pragma unroll
            for (int m = 0; m < 4; ++m)
#pragma unroll
                for (int n = 0; n < 2; ++n) acc[a][b][m][n] = (f32x4){0.f, 0.f, 0.f, 0.f};
    bf16x8 At[4][2], B0[2][2], B1[2][2];
    const char* cA = (const char*)g.A + (size_t)cur.pm * tstep + (size_t)cur.ko * 2; const char* cB = (const char*)g.Bt + (size_t)cur.pn * tstep + (size_t)cur.ko * 2;
    S.a_ready(cur);
    if constexpr (SP2) {
        PG8_STAGE(PG8_SB(0, 0), cB, voffB); PG8_STAGE(PG8_SB(0, 1), cB + hstep, voffB); PG8_STAGE(PG8_SA(0, 0), cA, voffA); PG8_STAGE(PG8_SA(0, 1), cA + hstep, voffA);
        if (wr == 1) PG8_BAR;
        PG8_WAIT_V(2); PG8_BAR;
        PG8_STAGE(PG8_SB(1, 0), cB + kstep, voffB); PG8_STAGE(PG8_SA(1, 0), cA + kstep, voffA); PG8_STAGE(PG8_SB(1, 1), cB + hstep + kstep, voffB);
        PG8_WAIT_V(6); PG8_BAR;
    } else {
        PG8_STAGE(PG8_SB(0, 0), cB, voffB); PG8_STAGE(PG8_SA(0, 0), cA, voffA); PG8_STAGE(PG8_SB(0, 1), cB + hstep, voffB); PG8_STAGE(PG8_SA(0, 1), cA + hstep, voffA);
        if (wr == 1) PG8_BAR;
        PG8_WAIT_V(4); PG8_BAR;
        PG8_STAGE(PG8_SB(1, 0), cB + kstep, voffB); PG8_STAGE(PG8_SA(1, 0), cA + kstep, voffA); PG8_STAGE(PG8_SB(1, 1), cB + hstep + kstep, voffB);
        PG8_WAIT_V(6); PG8_BAR;
    }
    for (;;) {
        const bool has_next = S.next(ui + 1, nxt);
        const char* nA = has_next ? (const char*)g.A + (size_t)nxt.pm * tstep + (size_t)nxt.ko * 2 : cA; const char* nB = has_next ? (const char*)g.Bt + (size_t)nxt.pn * tstep + (size_t)nxt.ko * 2 : cB;
        for (int t = 0; t < nt; t += 2) {
            const bool last = (t == nt - 2);
            const char* a1 = cA + (size_t)(t + 1) * kstep;
            const char* a2 = last ? nA : cA + (size_t)(t + 2) * kstep; const char* b2 = last ? nB : cB + (size_t)(t + 2) * kstep;
            const char* a3 = a2 + kstep; const char* b3 = b2 + kstep;
            if (last && has_next) S.a_ready(nxt);
            if constexpr (SP2) {
            PG8_LDB(B0, 0, 0); PG8_LDB(B1, 0, 1); PG8_SCHED; PG8_LDA(At, 0, 0); PG8_STAGE(PG8_SA(1, 1), a1 + hstep, voffA);
            PG8_WAIT_V(8); PG8_WAIT_L(0); PG8_BAR; PG8_MMA(0, 0, At, B0); PG8_MMA(0, 1, At, B1); PG8_BAR; PG8_SCHED;
            PG8_LDA(At, 0, 1); PG8_STAGE(PG8_SB(0, 0), b2, voffB); PG8_STAGE(PG8_SB(0, 1), b2 + hstep, voffB); PG8_STAGE(PG8_SA(0, 0), a2, voffA);
            PG8_WAIT_V(8); PG8_WAIT_L(0); PG8_BAR; PG8_MMA(1, 0, At, B0); PG8_MMA(1, 1, At, B1); PG8_BAR; PG8_SCHED;
            PG8_LDB(B0, 1, 0); PG8_LDB(B1, 1, 1); PG8_SCHED; PG8_LDA(At, 1, 0); PG8_STAGE(PG8_SA(0, 1), a2 + hstep, voffA);
            PG8_WAIT_V(8); PG8_WAIT_L(0); PG8_BAR; PG8_MMA(0, 0, At, B0); PG8_MMA(0, 1, At, B1); PG8_BAR; PG8_SCHED;
            PG8_LDA(At, 1, 1); PG8_STAGE(PG8_SB(1, 0), b3, voffB); PG8_STAGE(PG8_SB(1, 1), b3 + hstep, voffB); PG8_STAGE(PG8_SA(1, 0), a3, voffA);
            PG8_WAIT_V(8); PG8_WAIT_L(0); PG8_BAR; PG8_MMA(1, 0, At, B0); PG8_MMA(1, 1, At, B1); PG8_BAR; PG8_SCHED;
            } else {
            PG8_LDB(B0, 0, 0); PG8_SCHED; PG8_LDA(At, 0, 0); PG8_STAGE(PG8_SA(1, 1), a1 + hstep, voffA);
            PG8_WAIT_L(8); PG8_BAR; PG8_WAIT_L(0); PG8_MMA(0, 0, At, B0); PG8_BAR; PG8_SCHED;
            PG8_LDB(B1, 0, 1); PG8_STAGE(PG8_SB(0, 0), b2, voffB);
            PG8_BAR; PG8_WAIT_L(0); PG8_MMA(0, 1, At, B1); PG8_BAR;
            PG8_LDA(At, 0, 1); PG8_STAGE(PG8_SA(0, 0), a2, voffA);
            PG8_BAR; PG8_WAIT_L(0); PG8_MMA(1, 0, At, B0); PG8_BAR; PG8_SCHED;
            PG8_STAGE(PG8_SB(0, 1), b2 + hstep, voffB);
            PG8_WAIT_V(6); PG8_BAR; PG8_MMA(1, 1, At, B1); PG8_BAR;
            PG8_LDB(B0, 1, 0); PG8_SCHED; PG8_LDA(At, 1, 0); PG8_STAGE(PG8_SA(0, 1), a2 + hstep, voffA);
            PG8_WAIT_L(8); PG8_BAR; PG8_WAIT_L(0); PG8_MMA(0, 0, At, B0); PG8_BAR; PG8_SCHED;
            PG8_LDB(B1, 1, 1); PG8_STAGE(PG8_SB(1, 0), b3, voffB);
            PG8_BAR; PG8_WAIT_L(0); PG8_MMA(0, 1, At, B1); PG8_BAR;
            PG8_LDA(At, 1, 1); PG8_STAGE(PG8_SA(1, 0), a3, voffA);
            PG8_BAR; PG8_WAIT_L(0); PG8_MMA(1, 0, At, B0); PG8_BAR; PG8_SCHED;
            PG8_STAGE(PG8_SB(1, 1), b3 + hstep, voffB);
            PG8_WAIT_V(6); PG8_BAR; PG8_MMA(1, 1, At, B1); PG8_BAR;
            }
        }
        if constexpr (ALIGN_EPI) { if (wr == 0) PG8_BAR; }
        if constexpr (!Epi::AFTER_DRAIN) { E(acc, cur, wr, wc, fr, fq); S.done(cur); }
        if (!has_next) break;
#pragma unroll
        for (int a = 0; a < 2; ++a)
#pragma unroll
            for (int b = 0; b < 2; ++b)
#pragma unroll
                for (int m = 0; m < 4; ++m)
#pragma unroll
                    for (int n = 0; n < 2; ++n) acc[a][b][m][n] = (f32x4){0.f, 0.f, 0.f, 0.f};
        cur = nxt; cA = nA; cB = nB; ++ui;
        if constexpr (ALIGN_EPI) { if (wr == 1) PG8_BAR; }
    }
    PG8_WAIT_V(0);
    if constexpr (!ALIGN_EPI) { if (wr == 0) PG8_BAR; }
    PG8_BAR;
    if constexpr (Epi::AFTER_DRAIN) { E.fused(acc, cur, wr, wc, fr, fq, lds, wid, lane); S.done(cur); }
#undef PG8_SA
#undef PG8_SB
#undef PG8_STAGE
#undef PG8_LDA
#undef PG8_LDB
#undef PG8_MMA
#undef PG8_WAIT_V
#undef PG8_WAIT_L
#undef PG8_BAR
#undef PG8_SCHED
}
}

namespace fx {
#define XB_TMO      128
#define XB_XCNT(j)  (256  + 64 * (j))
#define XB_XSUB(j)  (1280 + 64 * (j))
#define XB_XGEN(j)  (2304 + 64 * (j))
#define XB_TOP      3328
#define XB_TOPGEN   3392
#define XCD_BAR_WORDS 3456
#define XB_SPIN_CAP (1u << 18)

__device__ __forceinline__ unsigned xb_ld(unsigned* p)              { return __hip_atomic_load(p, __ATOMIC_RELAXED, __HIP_MEMORY_SCOPE_AGENT); }
__device__ __forceinline__ unsigned xb_add(unsigned* p, unsigned v) { return __hip_atomic_fetch_add(p, v, __ATOMIC_RELAXED, __HIP_MEMORY_SCOPE_AGENT); }
__device__ __forceinline__ unsigned xb_xcc_id() { return (unsigned)__builtin_amdgcn_s_getreg((3 << 11) | 20) & 0xFu; }
#define XB_SPIN(cond, bar) do { unsigned _sp = 0; while (cond) { __builtin_amdgcn_s_sleep(1); \
    if ((++_sp & 255u) == 0u) { if (xb_ld(&(bar)[XB_TMO])) break; if (_sp > XB_SPIN_CAP) { atomicAdd(&(bar)[XB_TMO], 1u); break; } } } } while (0)

struct XcdBarrier {
    unsigned* bar; unsigned x;
    volatile LAS unsigned* st;
};

__device__ __forceinline__ XcdBarrier xcd_barrier_post(unsigned* bar, volatile LAS unsigned* st) {
    XcdBarrier b; b.bar = bar; b.x = xb_xcc_id(); b.st = st;
    if (threadIdx.x == 0) (void)xb_add(&bar[XB_XCNT(b.x)], 1u);
    return b;
}
__device__ __forceinline__ void xcd_barrier_complete(unsigned* bar, unsigned x, unsigned& nloc, unsigned& nx) {
    const unsigned G = gridDim.x * gridDim.y * gridDim.z;
    unsigned sum, cnt, mine, sp = 0u;
    for (;;) {
        sum = 0u; cnt = 0u; mine = 0u;
#pragma unroll
        for (unsigned j = 0; j < 16; ++j) { const unsigned c = xb_ld(&bar[XB_XCNT(j)]); sum += c; cnt += (c > 0u) ? 1u : 0u; mine = (j == x) ? c : mine; }
        if (sum == G) break;
        __builtin_amdgcn_s_sleep(1);
        if ((++sp & 255u) == 0u) { if (xb_ld(&bar[XB_TMO])) break; if (sp > XB_SPIN_CAP) { atomicAdd(&bar[XB_TMO], 1u); break; } }
    }
    nloc = mine > 0u ? mine : 1u; nx = cnt > 0u ? cnt : 1u;
}

__device__ __forceinline__ void xcd_barrier(const XcdBarrier& b) {
    asm volatile("s_waitcnt vmcnt(0)" ::: "memory");
    __syncthreads();
    if (threadIdx.x == 0) {
        unsigned* bar = b.bar;
        __builtin_amdgcn_s_waitcnt(0);
        unsigned nloc = b.st[0], nx = b.st[1];
        if (nloc == 0u) { xcd_barrier_complete(bar, b.x, nloc, nx); b.st[0] = nloc; b.st[1] = nx; }
        const unsigned old = xb_add(&bar[XB_XSUB(b.x)], 1u);
        const unsigned gen = old / nloc;
        if (old + 1u == (gen + 1u) * nloc) {
            __builtin_amdgcn_fence(__ATOMIC_RELEASE, "agent");
            asm volatile("s_waitcnt vmcnt(0)" ::: "memory");
            const unsigned og = xb_add(&bar[XB_TOP], 1u);
            const unsigned tg = og / nx;
            if (og + 1u == (tg + 1u) * nx) xb_add(&bar[XB_TOPGEN], 1u);
            else XB_SPIN(xb_ld(&bar[XB_TOPGEN]) == tg, bar);
            __builtin_amdgcn_fence(__ATOMIC_ACQUIRE, "agent");
            xb_add(&bar[XB_XGEN(b.x)], 1u);
            asm volatile("s_waitcnt vmcnt(0)" ::: "memory");
        } else {
            XB_SPIN(xb_ld(&bar[XB_XGEN(b.x)]) == gen, bar);
            __builtin_amdgcn_fence(__ATOMIC_ACQUIRE, "agent");
            asm volatile("s_waitcnt vmcnt(0)" ::: "memory");
        }
    }
    __syncthreads();
}

struct Args { GAS const float* in[25]; GAS float* out; GAS unsigned char* ws; int ph_lo, ph_hi; };
struct Ctx { LAS unsigned char* lds; int tid, lane, wave, G, bid; };
#if defined(__HIP_DEVICE_COMPILE__)

DI void transpose_item(const float* W, int ldw, int K, int N, bf16* WT, LAS float* scr, int item, int lane) {
    const int nblk = N / 32, kb = item / nblk, nb = item % nblk, k0 = 64 * kb, n0 = 32 * nb;
#pragma unroll 8
    for (int i = 0; i < 32; ++i) { const int kk = 2 * i + (lane >> 5); scr[kk * 33 + (lane & 31)] = W[(size_t)(k0 + kk) * ldw + n0 + (lane & 31)]; }
    LDS_WAIT();
    const int c = lane & 7;
#pragma unroll
    for (int j = 0; j < 4; ++j) { const int n = (lane >> 3) + 8 * j; const LAS float* s = scr + (8 * c) * 33 + n;
        u32x4 o; o.x = pk2(s[0 * 33], s[1 * 33]); o.y = pk2(s[2 * 33], s[3 * 33]); o.z = pk2(s[4 * 33], s[5 * 33]); o.w = pk2(s[6 * 33], s[7 * 33]);
        *(u32x4*)(WT + (size_t)(n0 + n) * K + k0 + 8 * c) = o; }
    LDS_WAIT();
}
DI void convert_weights(const Args& A, const Ctx& C, int l, int gw, int NGW, int lo = 0, int hi = 1 << 30) {
    LAS float* scr = (LAS float*)(C.lds + C.wave * 16384);
    constexpr int I_IN = (DM / 64) * (DIN / 32), I_OUT = (DMIX / 64) * (DM / 32), I_G = 2 * 8 * 2;
    bf16* WinT = (bf16*)(A.ws + ((l & 1) ? WS_WINT1 : WS_WINT)); bf16* WoutT = (bf16*)(A.ws + ((l & 1) ? WS_WOUTT1 : WS_WOUTT)); bf16* GW = (bf16*)(A.ws + ((l & 1) ? WS_GATEW1 : WS_GATEW));
    for (int it = lo + gw; it < I_IN + I_OUT + I_G && it < hi; it += NGW) {
        int r = it;
        if (r < I_IN) { transpose_item(A.in[8] + (size_t)l * DM * DINX, DINX, DM, DIN, WinT, scr, r, C.lane); continue; } r -= I_IN;
        if (r < I_OUT) { transpose_item(A.in[22] + (size_t)l * DMIX * DM, DM, DMIX, DM, WoutT, scr, r, C.lane); continue; } r -= I_OUT;
        const int gate = r / 16, n = (r % 16) / 2, sub = r % 2;
        transpose_item(A.in[gate ? 13 : 11] + ((size_t)l * 8 + n) * 4096, 64, 64, 64, GW + (size_t)(gate * 8 + n) * 4096, scr, sub, C.lane);
    }
}
DI void build_rope_table(const Args& A, const Ctx& C) {
    f32x2* TAB = (f32x2*)(A.ws + WS_TAB);
    for (int e = C.bid * NTHR + C.tid; e < 2065 * 64; e += C.G * NTHR) {
        const int p = e >> 6, i = e & 63; const float pos = p < 2064 ? (float)p : 16384.f;
        const float inv = exp2f(-(float)i * (13.287712379549449f / 64.f));
        const float ang = pos * inv;
        const double rev = (double)ang * 0.15915494309189535; const double fr = rev - rint(rev);
        const float r = (float)(fr * 6.283185307179586);
        TAB[e] = (f32x2){__cosf(r), __sinf(r)};
    }
}
DI void wait_panel(const Args& A, int lnext, int pm) {
    if (threadIdx.x == 0) {
        unsigned* cnt = (unsigned*)(A.ws + WS_CTL) + CW_PANEL + ((lnext - 1) * 65 + pm) * 64;
        unsigned spins = 0;
        while (__hip_atomic_load(cnt, __ATOMIC_RELAXED, __HIP_MEMORY_SCOPE_AGENT) < 32u) { __builtin_amdgcn_s_sleep(32); if (++spins > (1u << 20)) break; }
        __builtin_amdgcn_fence(__ATOMIC_ACQUIRE, "agent");
        asm volatile("s_waitcnt vmcnt(0)" ::: "memory");
    }
    __syncthreads();
}
DI void row_pass(const Args& A, const Ctx& C, int lnext) {
    const int gw = C.bid * NWAVES + C.wave, NGW = C.G * NWAVES, lane = C.lane;
    const bf16* YB = (const bf16*)(A.ws + WS_XF); bf16* XB = (bf16*)(A.ws + WS_XB); float* GAB = (float*)(A.ws + WS_GAB);
    const int nmain = M / NGW, nrow = nmain + ((nmain * NGW + gw) < M ? 1 : 0);
    LAS float* WG = (LAS float*)C.lds;
    __syncthreads();
    if (lnext < DEPTH) { const float* wg = A.in[8] + (size_t)lnext * DM * DINX + DIN;
        for (int k = C.tid; k < DM; k += NTHR) { const f32x4 w0 = *(const f32x4*)(wg + (size_t)k * DINX), w1 = *(const f32x4*)(wg + (size_t)k * DINX + 4);
            WG[0 * DM + k] = w0[0]; WG[1 * DM + k] = w0[1]; WG[2 * DM + k] = w0[2]; WG[3 * DM + k] = w0[3]; WG[4 * DM + k] = w1[0]; WG[5 * DM + k] = w1[1]; WG[6 * DM + k] = w1[2]; WG[7 * DM + k] = w1[3]; }
        __syncthreads(); }
    f32x4 vn[4];
#define ROW_OF(i) ((i) < nmain ? gw * nmain + (i) : nmain * NGW + gw)
#define ROW_LOAD(i) do { const int m_ = ROW_OF(i); const float* src_; \
        if (lnext == 0) { if (m_ < MP) { const int b_ = m_ / TP, t_ = m_ % TP; src_ = t_ < 16 ? (const float*)(A.in[7] + (size_t)t_ * DM) : (const float*)(A.in[0] + ((size_t)b_ * 2048 + (t_ - 16)) * DM); } \
                          else src_ = (const float*)(A.in[1] + (size_t)(m_ - MP) * DM); } \
        else src_ = nullptr; \
        if (lnext == 0) { _Pragma("unroll") for (int j = 0; j < 4; ++j) vn[j] = *(const f32x4*)(src_ + 4 * lane + 256 * j); } \
        else { u32x2 yb_[4]; _Pragma("unroll") for (int j = 0; j < 4; ++j) yb_[j] = *(const u32x2*)(YB + (size_t)m_ * DM + 4 * lane + 256 * j); \
               _Pragma("unroll") for (int j = 0; j < 4; ++j) vn[j] = unpack4(yb_[j]); } } while (0)
    const bool blk_has_extra = (nmain * NGW + C.bid * NWAVES) < M;
    if (nmain > 0) ROW_LOAD(0);
#pragma unroll 1
    for (int i = 0; i < nrow; ++i) {
        if (i == nmain && lnext != 0) { }
        const int m = ROW_OF(i);
        f32x4 v[4];
#pragma unroll
        for (int j = 0; j < 4; ++j) v[j] = vn[j];
        if (i + 1 < nmain) ROW_LOAD(i + 1);
        else if (i + 1 == nmain && i + 1 < nrow) ROW_LOAD(i + 1);
        if (lnext != 0) {
            float s = 0.f;
#pragma unroll
            for (int j = 0; j < 4; ++j) s += (v[j][0] + v[j][1]) + (v[j][2] + v[j][3]);
            const float mean = wave_sum(s) * (1.f / DM); float q = 0.f;
#pragma unroll
            for (int j = 0; j < 4; ++j) { v[j] = v[j] - mean; q += (v[j][0] * v[j][0] + v[j][1] * v[j][1]) + (v[j][2] * v[j][2] + v[j][3] * v[j][3]); }
            const float rstd = rsqrtf(wave_sum(q) * (1.f / DM) + EPS);
            const float* lw = A.in[23] + (size_t)(lnext - 1) * DM; const float* lb = A.in[24] + (size_t)(lnext - 1) * DM;
#pragma unroll
            for (int j = 0; j < 4; ++j) { const f32x4 w = *(const f32x4*)(lw + 4 * lane + 256 * j), b = *(const f32x4*)(lb + 4 * lane + 256 * j); v[j] = v[j] * rstd * w + b; }
        }
        if (lnext < DEPTH) {
#pragma unroll
            for (int j = 0; j < 4; ++j) *(u32x2*)(XB + (size_t)m * DM + 4 * lane + 256 * j) = pack4(v[j]);
            float acc[8];
#pragma unroll
            for (int q = 0; q < 8; ++q) { float s = 0.f;
#pragma unroll
                for (int j = 0; j < 4; ++j) { const f32x4 w = *(const LAS f32x4*)(WG + q * DM + 4 * lane + 256 * j); s += (v[j][0] * w[0] + v[j][1] * w[1]) + (v[j][2] * w[2] + v[j][3] * w[3]); }
                acc[q] = s; }
#pragma unroll
            for (int q = 0; q < 8; ++q) acc[q] = wave_sum(acc[q]);
            if (lane == 0) { *(f32x4*)(GAB + (size_t)m * 8) = (f32x4){acc[0], acc[1], acc[2], acc[3]}; *(f32x4*)(GAB + (size_t)m * 8 + 4) = (f32x4){acc[4], acc[5], acc[6], acc[7]}; }
        } else {
            float* dst = nullptr;
            if (m < MP) { const int b = m / TP, t = m % TP; if (t >= 16) dst = (float*)(A.out + O_YP + ((size_t)b * 2048 + (t - 16)) * DM); }
            else dst = (float*)(A.out + O_YS + (size_t)(m - MP) * DM);
            if (dst) {
#pragma unroll
                for (int j = 0; j < 4; ++j) *(f32x4*)(dst + 4 * lane + 256 * j) = v[j]; }
        }
    }
#undef ROW_OF
#undef ROW_LOAD
}

DI int tsw(int i, int ch) { return i * 128 + ((ch ^ ((i >> 3) & 7)) << 3); }
DI void transpose_out(const LAS bf16* T, bf16* outT, int lane) {
    const int dl = lane >> 3, i8 = lane & 7;
#pragma unroll 2
    for (int d0 = 0; d0 < 16; ++d0) { const LAS bf16* s = T + (i8 * 8) * 128 + ((d0 ^ i8) << 3) + dl; u32x4 w;
        w.x = (unsigned)s[0 * 128] | ((unsigned)s[1 * 128] << 16); w.y = (unsigned)s[2 * 128] | ((unsigned)s[3 * 128] << 16);
        w.z = (unsigned)s[4 * 128] | ((unsigned)s[5 * 128] << 16); w.w = (unsigned)s[6 * 128] | ((unsigned)s[7 * 128] << 16);
        *(u32x4*)(outT + (d0 * 8 + dl) * 64 + i8 * 8) = w; }
}

DI void p2_gdn_item(const Args& A, const Ctx& C, LAS unsigned char* pl, int l, int item) {
    const int lane = C.lane, fr = lane & 15, fq = lane >> 4;
    const int CH = item, h = item & 3, bc = item >> 2, c = bc % NCH, b = bc / NCH;
    const int t0 = 64 * c - 48; const size_t mrow0 = (size_t)b * TP;
    bf16* U = (bf16*)(A.ws + WS_U); const float* GAB = (const float*)(A.ws + WS_GAB);
    LAS float* Amat = (LAS float*)pl; LAS bf16* T = (LAS bf16*)pl; LAS float* scb = (LAS float*)(pl + 17408);
    bf16* QH = (bf16*)(A.ws + S_QH) + (size_t)CH * 8192; bf16* KH = (bf16*)(A.ws + S_KH) + (size_t)CH * 8192; bf16* RWT = (bf16*)(A.ws + S_RWT) + (size_t)CH * 8192;
    bf16* Wg = (bf16*)(A.ws + G_W) + (size_t)CH * 8192; bf16* QG = (bf16*)(A.ws + G_QG) + (size_t)CH * 8192; bf16* KDT = (bf16*)(A.ws + G_KDT) + (size_t)CH * 8192;
    bf16* UT = (bf16*)(A.ws + G_UT) + (size_t)CH * 8192; bf16* ATT = (bf16*)(A.ws + G_ATT) + (size_t)CH * 4096; float* EGL = (float*)(A.ws + WS_EGL);
    TS_BEGIN(8); TS_BEGIN(1);
    {
        const int t = t0 + lane; float g = 0.f, beta = 0.f;
        if (t >= 0) { const float* gp = GAB + (mrow0 + t) * 8; g = -__expf(A.in[19][l * 4 + h]) * softplusf_(gp[h] + A.in[20][l * 4 + h]); beta = sigmoidf_(gp[4 + h]); }
        float gc = g;
#pragma unroll
        for (int off = 1; off < 64; off <<= 1) { const float nb = __shfl_up(gc, off); if (lane >= off) gc += nb; }
        scb[lane] = beta; scb[64 + lane] = gc;
        const float gl = __shfl(gc, 63);
        if (lane == 0) EGL[CH] = __expf(gl);
    }
    LDS_WAIT();
    const float g_last = scb[64 + 63];
    TS_END(1); TS_BEGIN(2);
    const int tbk = lane >> 4, grp = lane & 15;
#pragma unroll 1
    for (int part = 0; part < 3; ++part) {
        const int chb = part * 512 + h * 128 + grp * 8;
        const float* cw = A.in[18] + (size_t)l * 4 * 1536 + chb;
        float wgt[4][8];
#pragma unroll
        for (int j = 0; j < 4; ++j) { const f32x4 a = *(const f32x4*)(cw + j * 1536), bq = *(const f32x4*)(cw + j * 1536 + 4);
            wgt[j][0] = a[0]; wgt[j][1] = a[1]; wgt[j][2] = a[2]; wgt[j][3] = a[3]; wgt[j][4] = bq[0]; wgt[j][5] = bq[1]; wgt[j][6] = bq[2]; wgt[j][7] = bq[3]; }
#pragma unroll 1
        for (int half = 0; half < 2; ++half) {
            const int i0 = tbk * 16 + half * 8;
            u32x4 raw[11];
#pragma unroll
            for (int jj = 0; jj < 11; ++jj) { const int tt = t0 + i0 - 3 + jj; raw[jj] = (u32x4){0u, 0u, 0u, 0u}; if (tt >= 0) raw[jj] = *(const u32x4*)(U + (mrow0 + tt) * DIN + 3072 + chb); }
#pragma unroll
            for (int e8 = 0; e8 < 8; ++e8) {
                const int i = i0 + e8;
                float y[8];
#pragma unroll
                for (int e = 0; e < 8; ++e) y[e] = 0.f;
#pragma unroll
                for (int j = 0; j < 4; ++j) { float x[8]; unpack8(raw[e8 + j], x);
#pragma unroll
                    for (int e = 0; e < 8; ++e) y[e] = fmaf(wgt[j][e], x[e], y[e]); }
                if (c == NCH - 1 && i >= 61) { float x3[8]; unpack8(raw[e8 + 3], x3); float* o = A.out + O_GCP + ((size_t)(l * NB + b) * 3 + (i - 61)) * 1536 + chb;
                    *(f32x4*)o = (f32x4){x3[0], x3[1], x3[2], x3[3]}; *(f32x4*)(o + 4) = (f32x4){x3[4], x3[5], x3[6], x3[7]}; }
#pragma unroll
                for (int e = 0; e < 8; ++e) y[e] = siluf_(y[e]);
                const float beta_i = scb[i], gc_i = scb[64 + i];
                if (part < 2) {
                    float ss = 0.f;
#pragma unroll
                    for (int e = 0; e < 8; ++e) ss = fmaf(y[e], y[e], ss);
                    ss = row_sum16(ss);
                    const float rn = rsqrtf(ss + EPS) * (part == 0 ? QSCALE : 1.f);
#pragma unroll
                    for (int e = 0; e < 8; ++e) y[e] *= rn;
                }
                if (part == 0) {
                    *(u32x4*)(QH + i * 128 + grp * 8) = pack8(y);
                    const float eg = __expf(gc_i);
#pragma unroll
                    for (int e = 0; e < 8; ++e) y[e] *= eg;
                    *(u32x4*)(QG + i * 128 + grp * 8) = pack8(y);
                } else if (part == 1) {
                    *(u32x4*)(KH + i * 128 + grp * 8) = pack8(y);
                    const float s = beta_i * __expf(gc_i);
#pragma unroll
                    for (int e = 0; e < 8; ++e) y[e] *= s;
                    *(LAS u32x4*)(T + tsw(i, grp)) = pack8(y);
                } else {
#pragma unroll
                    for (int e = 0; e < 8; ++e) y[e] *= beta_i;
                    *(LAS u32x4*)(T + tsw(i, grp)) = pack8(y);
                }
            }
        }
        if (part == 1) {
            LDS_WAIT(); transpose_out(T, RWT, lane); LDS_WAIT();
            VM_WAIT();
#pragma unroll 1
            for (int half = 0; half < 2; ++half) { const int i0 = tbk * 16 + half * 8; u32x4 raw[8];
#pragma unroll
                for (int e8 = 0; e8 < 8; ++e8) raw[e8] = *(const u32x4*)(KH + (i0 + e8) * 128 + grp * 8);
#pragma unroll
                for (int e8 = 0; e8 < 8; ++e8) { const int i = i0 + e8; float y[8]; unpack8(raw[e8], y);
                    const float s = __expf(g_last - scb[64 + i]);
#pragma unroll
                    for (int e = 0; e < 8; ++e) y[e] *= s;
                    *(LAS u32x4*)(T + tsw(i, grp)) = pack8(y); } }
            LDS_WAIT(); transpose_out(T, KDT, lane); LDS_WAIT();
        }
        if (part == 2) { LDS_WAIT(); transpose_out(T, UT, lane); LDS_WAIT(); }
    }
    VM_WAIT();
    TS_END(2); TS_BEGIN(3);
    bf16x8 kf[4][4];
#pragma unroll
    for (int rb = 0; rb < 4; ++rb)
#pragma unroll
        for (int kc = 0; kc < 4; ++kc) kf[rb][kc] = *(const bf16x8*)(KH + (rb * 16 + fr) * 128 + kc * 32 + 8 * fq);
#pragma unroll
    for (int jb = 0; jb < 4; ++jb) { const float gcj = scb[64 + jb * 16 + fr];
#pragma unroll
        for (int ib = jb; ib < 4; ++ib) { f32x4 acc = (f32x4){0.f, 0.f, 0.f, 0.f};
#pragma unroll
            for (int kc = 0; kc < 4; ++kc) acc = mfma16(kf[ib][kc], kf[jb][kc], acc);
#pragma unroll
            for (int r = 0; r < 4; ++r) { const int i = ib * 16 + 4 * fq + r; Amat[i * 68 + jb * 16 + fr] = acc[r] * scb[i] * __expf(fminf(scb[64 + i] - gcj, 0.f)); } } }
#pragma unroll
    for (int ib2 = 0; ib2 < 2; ++ib2) {
    bf16x8 qfa[2][4];
#pragma unroll
    for (int q = 0; q < 2; ++q)
#pragma unroll
        for (int kc = 0; kc < 4; ++kc) qfa[q][kc] = *(const bf16x8*)(QH + ((ib2 * 2 + q) * 16 + fr) * 128 + kc * 32 + 8 * fq);
#pragma unroll
    for (int q = 0; q < 2; ++q) { const int ib = ib2 * 2 + q; bf16x8 qf[4];
#pragma unroll
        for (int kc = 0; kc < 4; ++kc) qf[kc] = qfa[q][kc];
        const int i = ib * 16 + fr; const float gci = scb[64 + i];
#pragma unroll
        for (int jb = 0; jb < 4; ++jb) { f32x4 val = (f32x4){0.f, 0.f, 0.f, 0.f};
            if (jb <= ib) { f32x4 acc = (f32x4){0.f, 0.f, 0.f, 0.f};
#pragma unroll
                for (int kc = 0; kc < 4; ++kc) acc = mfma16(kf[jb][kc], qf[kc], acc);
#pragma unroll
                for (int r = 0; r < 4; ++r) { const int j = jb * 16 + 4 * fq + r; val[r] = (i >= j) ? acc[r] * __expf(fminf(gci - scb[64 + j], 0.f)) : 0.f; } }
            *(u32x2*)(ATT + i * 64 + jb * 16 + 4 * fq) = pack4(val); } } }
    LDS_WAIT();
    TS_END(3); TS_BEGIN(4);
    float mcol[64];
#pragma unroll
    for (int i = 0; i < 64; ++i) { float acc = (lane == i) ? 1.f : 0.f;
#pragma unroll
        for (int j = 0; j < i; ++j) acc = fmaf(-Amat[i * 68 + j], mcol[j], acc);
        mcol[i] = acc; }
    LDS_WAIT(); asm volatile("" ::: "memory");
    LAS bf16* Mb = (LAS bf16*)pl;
#pragma unroll
    for (int i = 0; i < 64; ++i) Mb[i * 136 + lane] = (bf16)f2bf(mcol[i]);
    LDS_WAIT(); asm volatile("" ::: "memory");
    TS_END(4); TS_BEGIN(5);
    bf16x8 mf[4][2];
#pragma unroll
    for (int ib = 0; ib < 4; ++ib)
#pragma unroll
        for (int k2 = 0; k2 < 2; ++k2) mf[ib][k2] = *(const LAS bf16x8*)(Mb + (ib * 16 + fr) * 136 + k2 * 32 + 8 * fq);
    LDS_WAIT(); asm volatile("" ::: "memory");
    { LAS bf16* Tu = (LAS bf16*)pl;
#pragma unroll 1
      for (int hb = 0; hb < 2; ++hb) { bf16x8 rfa[4][2];
#pragma unroll
        for (int q = 0; q < 4; ++q)
#pragma unroll
            for (int k2 = 0; k2 < 2; ++k2) rfa[q][k2] = *(const bf16x8*)(UT + ((hb * 4 + q) * 16 + fr) * 64 + k2 * 32 + 8 * fq);
#pragma unroll
        for (int q = 0; q < 4; ++q) { const int db = hb * 4 + q;
#pragma unroll
            for (int ib = 0; ib < 4; ++ib) { f32x4 acc = (f32x4){0.f, 0.f, 0.f, 0.f};
#pragma unroll
                for (int k2 = 0; k2 < 2; ++k2) acc = mfma16(mf[ib][k2], rfa[q][k2], acc);
                *(LAS u32x2*)(Tu + (db * 16 + fr) * 72 + ib * 16 + 4 * fq) = pack4(acc); } } }
      LDS_WAIT(); VM_WAIT();
      const int dl = lane >> 3, i8 = lane & 7;
#pragma unroll 4
      for (int d0 = 0; d0 < 16; ++d0) *(u32x4*)(UT + (d0 * 8 + dl) * 64 + i8 * 8) = *(const LAS u32x4*)(Tu + (d0 * 8 + dl) * 72 + i8 * 8);
      LDS_WAIT(); asm volatile("" ::: "memory"); }
    { LAS bf16* Tw = (LAS bf16*)pl;
#pragma unroll 1
      for (int hb = 0; hb < 2; ++hb) { bf16x8 rfa[4][2];
#pragma unroll
        for (int q = 0; q < 4; ++q)
#pragma unroll
            for (int k2 = 0; k2 < 2; ++k2) rfa[q][k2] = *(const bf16x8*)(RWT + ((hb * 4 + q) * 16 + fr) * 64 + k2 * 32 + 8 * fq);
#pragma unroll
        for (int q = 0; q < 4; ++q) { const int kb = hb * 4 + q;
#pragma unroll
            for (int ib = 0; ib < 4; ++ib) { f32x4 acc = (f32x4){0.f, 0.f, 0.f, 0.f};
#pragma unroll
                for (int k2 = 0; k2 < 2; ++k2) acc = mfma16(rfa[q][k2], mf[ib][k2], acc);
                *(LAS u32x2*)(Tw + (ib * 16 + fr) * 136 + kb * 16 + 4 * fq) = pack4(acc); } } }
      LDS_WAIT();
      const int r4 = lane >> 4, c16 = lane & 15;
#pragma unroll 4
      for (int it = 0; it < 16; ++it) *(u32x4*)(Wg + (it * 4 + r4) * 128 + c16 * 8) = *(const LAS u32x4*)(Tw + (it * 4 + r4) * 136 + c16 * 8); }
    LDS_WAIT();
    TS_END(5); TS_END(8);
}

DI void p2_ret_item(const Args& A, const Ctx& C, LAS unsigned char* pl, int l, int item) {
    const int lane = C.lane, fr = lane & 15, fq = lane >> 4;
    const int CH = item, h = item & 3, bc = item >> 2, c = bc % NCH, b = bc / NCH;
    const int t0 = 64 * c - 48; const size_t mrow0 = (size_t)b * TP;
    bf16* U = (bf16*)(A.ws + WS_U); LAS bf16* T = (LAS bf16*)pl; const f32x2* TAB = (const f32x2*)(A.ws + WS_TAB);
    bf16* KRT = (bf16*)(A.ws + R_KRT) + (size_t)CH * 8192; bf16* VT = (bf16*)(A.ws + R_VT) + (size_t)CH * 8192; bf16* SC = (bf16*)(A.ws + R_SC) + (size_t)CH * 4096;
    TS_BEGIN(6);
    const float lg2 = log2f(1.f - exp2f(-5.f - (float)h));
    const int tok8 = lane >> 3, d0 = 8 * (lane & 7);
    const int it0 = t0 < 0 ? 6 : 0;
#pragma unroll 1
    for (int part = 0; part < 2; ++part) {
        const int colb = (part ? 1536 : 1024) + h * 128;

        float cc[8], ss[8], cr[8], sr[8];
        { const f32x4* cs = (const f32x4*)(TAB + (size_t)(t0 + it0 * 8 + tok8) * 64 + d0); const f32x4* rs = (const f32x4*)(TAB + (size_t)8 * 64 + d0);
#pragma unroll
            for (int e2 = 0; e2 < 4; ++e2) { const f32x4 v = cs[e2], r = rs[e2]; cc[2 * e2] = v[0]; ss[2 * e2] = v[1]; cc[2 * e2 + 1] = v[2]; ss[2 * e2 + 1] = v[3];
                cr[2 * e2] = r[0]; sr[2 * e2] = r[1]; cr[2 * e2 + 1] = r[2]; sr[2 * e2 + 1] = r[3]; } }
#pragma unroll 1
        for (int itb = 0; itb < 2; ++itb) {
        u32x4 lo4[4], hi4[4];
#pragma unroll
        for (int q = 0; q < 4; ++q) { const int t = t0 + (itb * 4 + q) * 8 + tok8; lo4[q] = (u32x4){0u, 0u, 0u, 0u}; hi4[q] = lo4[q];
            if (t >= 0) { const bf16* p = U + (mrow0 + t) * DIN + colb + d0; lo4[q] = *(const u32x4*)p; hi4[q] = *(const u32x4*)(p + 64); } }
#pragma unroll
        for (int q = 0; q < 4; ++q) { const int it = itb * 4 + q; const int i = it * 8 + tok8, t = t0 + i;
            float r1[8], r2[8];
#pragma unroll
            for (int e = 0; e < 8; ++e) { r1[e] = 0.f; r2[e] = 0.f; }
            if (it >= it0) {
                float lo[8], hi[8]; unpack8(lo4[q], lo); unpack8(hi4[q], hi);
                const float sc = part ? QSCALE * exp2f((float)(63 - i) * lg2) : exp2f((float)(i + 1) * lg2);
#pragma unroll
                for (int e = 0; e < 8; ++e) { r1[e] = (lo[e] * cc[e] - hi[e] * ss[e]) * sc; r2[e] = (lo[e] * ss[e] + hi[e] * cc[e]) * sc;
                    const float cn = cc[e] * cr[e] - ss[e] * sr[e], sn = ss[e] * cr[e] + cc[e] * sr[e]; cc[e] = cn; ss[e] = sn; }
                bf16* p = U + (mrow0 + t) * DIN + colb + d0;
                *(u32x4*)p = pack8(r1); *(u32x4*)(p + 64) = pack8(r2); }
            if (part) { *(LAS u32x4*)(T + tsw(i, d0 >> 3)) = pack8(r1); *(LAS u32x4*)(T + tsw(i, 8 + (d0 >> 3))) = pack8(r2); } } }
        if (part) { LDS_WAIT(); transpose_out(T, KRT, lane); LDS_WAIT(); }
    }
    { const int tok4 = lane >> 4, grp = lane & 15; u32x4 raw[16];
#pragma unroll
        for (int it = 0; it < 16; ++it) { const int t = t0 + it * 4 + tok4; raw[it] = (u32x4){0u, 0u, 0u, 0u};
            if (t >= 0) raw[it] = *(const u32x4*)(U + (mrow0 + t) * DIN + 2048 + h * 128 + grp * 8); }
#pragma unroll
        for (int it = 0; it < 16; ++it) *(LAS u32x4*)(T + tsw(it * 4 + tok4, grp)) = raw[it];
        LDS_WAIT(); transpose_out(T, VT, lane); LDS_WAIT(); }
    VM_WAIT();
    const bf16x8 zf = (bf16x8){0, 0, 0, 0, 0, 0, 0, 0};
    bf16x8 kf[4][4];
#pragma unroll
    for (int rb = 0; rb < 4; ++rb) { const int t = t0 + rb * 16 + fr;
#pragma unroll
        for (int kc = 0; kc < 4; ++kc) kf[rb][kc] = t >= 0 ? *(const bf16x8*)(U + (mrow0 + t) * DIN + 1536 + h * 128 + kc * 32 + 8 * fq) : zf; }
    const float ginv = exp2f(-64.f * lg2);
#pragma unroll
    for (int ib2 = 0; ib2 < 2; ++ib2) {
    bf16x8 qfa[2][4];
#pragma unroll
    for (int q = 0; q < 2; ++q) { const int t = t0 + (ib2 * 2 + q) * 16 + fr;
#pragma unroll
        for (int kc = 0; kc < 4; ++kc) qfa[q][kc] = t >= 0 ? *(const bf16x8*)(U + (mrow0 + t) * DIN + 1024 + h * 128 + kc * 32 + 8 * fq) : zf; }
#pragma unroll
    for (int q = 0; q < 2; ++q) { const int ib = ib2 * 2 + q; bf16x8 qf[4]; const int i = ib * 16 + fr;
#pragma unroll
        for (int kc = 0; kc < 4; ++kc) qf[kc] = qfa[q][kc];
#pragma unroll
        for (int jb = 0; jb < 4; ++jb) { f32x4 val = (f32x4){0.f, 0.f, 0.f, 0.f};
            if (jb <= ib) { f32x4 acc = (f32x4){0.f, 0.f, 0.f, 0.f};
#pragma unroll
                for (int kc = 0; kc < 4; ++kc) acc = mfma16(kf[jb][kc], qf[kc], acc);
#pragma unroll
                for (int r = 0; r < 4; ++r) { const int j = jb * 16 + 4 * fq + r; val[r] = (i >= j) ? acc[r] * ginv : 0.f; } }
            *(u32x2*)(SC + i * 64 + jb * 16 + 4 * fq) = pack4(val); } } }
    LDS_WAIT();
    TS_END(6);
}

template <bool DEC>
DI void p2_rg_item(const Args& A, const Ctx& C, LAS unsigned char* pl, int l, int bt, int c, int n) {
    const int lane = C.lane, fr = lane & 15, fq = lane >> 4;
    TS_BEGIN(7); TS_BEGIN(20);
    bf16* U = (bf16*)(A.ws + WS_U); LAS float* XR = (LAS float*)pl;
    const int t0 = DEC ? 0 : 64 * c - 48; const size_t mrow0 = DEC ? (size_t)MP + 64 * bt : (size_t)bt * TP;
    bf16x8 xf[4][2];
#pragma unroll
    for (int kc = 0; kc < 2; ++kc) { const int ch8 = n * 64 + kc * 32 + 8 * fq;
        float cw[4][8], cb[8];
#pragma unroll
        for (int j = 0; j < 4; ++j) { const float* p = A.in[9] + ((size_t)l * 4 + j) * 512 + ch8; const f32x4 a = *(const f32x4*)p, bq = *(const f32x4*)(p + 4);
            cw[j][0] = a[0]; cw[j][1] = a[1]; cw[j][2] = a[2]; cw[j][3] = a[3]; cw[j][4] = bq[0]; cw[j][5] = bq[1]; cw[j][6] = bq[2]; cw[j][7] = bq[3]; }
        { const float* p = A.in[10] + (size_t)l * 512 + ch8; const f32x4 a = *(const f32x4*)p, bq = *(const f32x4*)(p + 4);
            cb[0] = a[0]; cb[1] = a[1]; cb[2] = a[2]; cb[3] = a[3]; cb[4] = bq[0]; cb[5] = bq[1]; cb[6] = bq[2]; cb[7] = bq[3]; }
        u32x4 rawp[4][4];
        if (!DEC) {
#pragma unroll
            for (int tb = 0; tb < 4; ++tb)
#pragma unroll
                for (int j = 0; j < 4; ++j) { const int tt = t0 + tb * 16 + fr - 3 + j; rawp[tb][j] = (u32x4){0u, 0u, 0u, 0u}; if (tt >= 0) rawp[tb][j] = *(const u32x4*)(U + (mrow0 + tt) * DIN + ch8); }
        }
#pragma unroll
        for (int tb = 0; tb < 4; ++tb) { const int i = tb * 16 + fr;
            float xr[8];
#pragma unroll
            for (int e = 0; e < 8; ++e) xr[e] = cb[e];
            if (!DEC) { const int t = t0 + i; float x3[8];
#pragma unroll
                for (int e = 0; e < 8; ++e) x3[e] = 0.f;
#pragma unroll
                for (int j = 0; j < 4; ++j) { float x[8]; unpack8(rawp[tb][j], x);
#pragma unroll
                        for (int e = 0; e < 8; ++e) { xr[e] = fmaf(cw[j][e], x[e], xr[e]); if (j == 3) x3[e] = x[e]; } }
                if (c == NCH - 1 && i >= 61) { float* o = A.out + O_CP + ((size_t)(l * NB + bt) * 3 + (i - 61)) * 512 + ch8;
                    *(f32x4*)o = (f32x4){x3[0], x3[1], x3[2], x3[3]}; *(f32x4*)(o + 4) = (f32x4){x3[4], x3[5], x3[6], x3[7]}; }
            } else { const int s = 64 * bt + i; const float* cv = A.in[3] + ((size_t)(l * NS + s) * 3) * 512 + ch8; float* oc = A.out + O_CS + ((size_t)(l * NS + s) * 3) * 512 + ch8;
                float x[8];
#pragma unroll
                for (int j = 0; j < 3; ++j) { const f32x4 a = *(const f32x4*)(cv + j * 512), bq = *(const f32x4*)(cv + j * 512 + 4);
                    x[0] = a[0]; x[1] = a[1]; x[2] = a[2]; x[3] = a[3]; x[4] = bq[0]; x[5] = bq[1]; x[6] = bq[2]; x[7] = bq[3];
#pragma unroll
                    for (int e = 0; e < 8; ++e) xr[e] = fmaf(cw[j][e], x[e], xr[e]);
                    if (j >= 1) { *(f32x4*)(oc + (j - 1) * 512) = a; *(f32x4*)(oc + (j - 1) * 512 + 4) = bq; } }
                unpack8(*(const u32x4*)(U + (mrow0 + i) * DIN + ch8), x);
#pragma unroll
                for (int e = 0; e < 8; ++e) xr[e] = fmaf(cw[3][e], x[e], xr[e]);
                *(f32x4*)(oc + 2 * 512) = (f32x4){x[0], x[1], x[2], x[3]}; *(f32x4*)(oc + 2 * 512 + 4) = (f32x4){x[4], x[5], x[6], x[7]};
            }
            *(LAS f32x4*)(XR + i * 68 + kc * 32 + 8 * fq) = (f32x4){xr[0], xr[1], xr[2], xr[3]};
            *(LAS f32x4*)(XR + i * 68 + kc * 32 + 8 * fq + 4) = (f32x4){xr[4], xr[5], xr[6], xr[7]};
            xf[tb][kc] = __builtin_bit_cast(bf16x8, pack8(xr)); } }
    LDS_WAIT();
    TS_END(20); TS_BEGIN(21);
    const bf16* GW = (const bf16*)(A.ws + ((l & 1) ? WS_GATEW1 : WS_GATEW));
    bf16* MIX = (bf16*)(A.ws + WS_MIX); bf16* BETA = (bf16*)(A.ws + WS_BETA);
    bf16x8 wafN[2], wxfN[2]; f32x4 ba4N, bx4N, lam4N; u32x2 zrawN[4];
#define RG_LOADS(DB_) do { const int chl_ = (DB_) * 16 + 4 * fq, ch0_ = n * 64 + chl_; \
        _Pragma("unroll") for (int kc = 0; kc < 2; ++kc) { wafN[kc] = *(const bf16x8*)(GW + (size_t)(0 * 8 + n) * 4096 + ((DB_) * 16 + fr) * 64 + kc * 32 + 8 * fq); \
                                         wxfN[kc] = *(const bf16x8*)(GW + (size_t)(1 * 8 + n) * 4096 + ((DB_) * 16 + fr) * 64 + kc * 32 + 8 * fq); } \
        ba4N = *(const f32x4*)(A.in[12] + (size_t)l * 512 + ch0_); bx4N = *(const f32x4*)(A.in[14] + (size_t)l * 512 + ch0_); lam4N = *(const f32x4*)(A.in[15] + (size_t)l * 512 + ch0_); \
        _Pragma("unroll") for (int tb = 0; tb < 4; ++tb) { const int t_ = t0 + tb * 16 + fr; const size_t row_ = mrow0 + (DEC ? tb * 16 + fr : (t_ >= 0 ? t_ : 0)); zrawN[tb] = *(const u32x2*)(U + row_ * DIN + 512 + ch0_); } } while (0)
    RG_LOADS(0);
#pragma unroll 1
    for (int db = 0; db < 4; ++db) {
        bf16x8 waf[2], wxf[2]; u32x2 zraw[4];
#pragma unroll
        for (int kc = 0; kc < 2; ++kc) { waf[kc] = wafN[kc]; wxf[kc] = wxfN[kc]; }
        const f32x4 ba4 = ba4N, bx4 = bx4N, lam4 = lam4N;
#pragma unroll
        for (int tb = 0; tb < 4; ++tb) zraw[tb] = zrawN[tb];
        const int chl = db * 16 + 4 * fq, ch0 = n * 64 + chl;
        if (db + 1 < 4) RG_LOADS(db + 1);
        f32x4 sp4;
#pragma unroll
        for (int r = 0; r < 4; ++r) sp4[r] = softplusf_(-lam4[r]);
        float Ac[4], Hc[4];
#pragma unroll
        for (int r = 0; r < 4; ++r) { Ac[r] = 1.f; Hc[r] = 0.f; }
#pragma unroll
        for (int tb = 0; tb < 4; ++tb) { const int i = tb * 16 + fr; const int t = t0 + i; const bool valid = DEC || t >= 0; const size_t row = mrow0 + (DEC ? i : (t >= 0 ? t : 0));
            f32x4 aa = (f32x4){0.f, 0.f, 0.f, 0.f}, ax = aa;
#pragma unroll
            for (int kc = 0; kc < 2; ++kc) { aa = mfma16(waf[kc], xf[tb][kc], aa); ax = mfma16(wxf[kc], xf[tb][kc], ax); }
            const f32x4 xr4 = *(const LAS f32x4*)(XR + i * 68 + chl);
            const f32x4 z4 = unpack4(zraw[tb]);
            f32x4 av, uv, sz;
#pragma unroll
            for (int r = 0; r < 4; ++r) { const float rg = sigmoidf_(aa[r] + ba4[r]), ig = sigmoidf_(ax[r] + bx4[r]);
                const float la = -8.f * rg * sp4[r];
                av[r] = __expf(la); uv[r] = sqrtf(fmaxf(neg_expm1f_(2.f * la), 0.f)) * ig * xr4[r]; sz[r] = siluf_(z4[r]); }
            if (DEC) { const int s = 64 * bt + i;
                const f32x4 h0 = *(const f32x4*)(A.in[2] + (size_t)(l * NS + s) * 512 + ch0);
                const f32x4 hv = av * h0 + uv;
                *(f32x4*)(A.out + O_HS + (size_t)(l * NS + s) * 512 + ch0) = hv;
                *(u32x2*)(MIX + row * DMIX + ch0) = pack4(hv * sz);
            } else {
                f32x4 al, be;
#pragma unroll
                for (int r = 0; r < 4; ++r) { float a = valid ? av[r] : 1.f, u = valid ? uv[r] : 0.f;
                    { float pa, pu;
                      pa = dpp_f<0x111>(1.f, a); pu = dpp_f<0x111>(0.f, u); u = fmaf(a, pu, u); a = pa * a;
                      pa = dpp_f<0x112>(1.f, a); pu = dpp_f<0x112>(0.f, u); u = fmaf(a, pu, u); a = pa * a;
                      pa = dpp_f<0x114>(1.f, a); pu = dpp_f<0x114>(0.f, u); u = fmaf(a, pu, u); a = pa * a;
                      pa = dpp_f<0x118>(1.f, a); pu = dpp_f<0x118>(0.f, u); u = fmaf(a, pu, u); a = pa * a; }
                    const float P = Ac[r] * a, hl = fmaf(a, Hc[r], u);
                    al[r] = hl * sz[r]; be[r] = P * sz[r];
                    Ac[r] = row_bcast15(P); Hc[r] = row_bcast15(hl); }
                if (valid) { *(u32x2*)(U + row * DIN + 512 + ch0) = pack4(al); *(u32x2*)(BETA + ((size_t)bt * TP + t) * 512 + ch0) = pack4(be); }
            } }
        if (!DEC && fr == 15) { f32x2* RGS = (f32x2*)(A.ws + WS_RGS) + ((size_t)bt * NCH + c) * 512 + n * 64 + chl;
#pragma unroll
            for (int r = 0; r < 4; ++r) RGS[r] = (f32x2){Ac[r], Hc[r]}; }
    }
#undef RG_LOADS
    LDS_WAIT();
    TS_END(21); TS_END(7);
}

DI void p2_rg_any(const Args& A, const Ctx& C, LAS unsigned char* pl, int l, int it) {
    const int NRG = NB * NCH * 8;
    if (it < NRG) { const int n = it & 7, bc = it >> 3; p2_rg_item<false>(A, C, pl, l, bc / NCH, bc % NCH, n); }
    else { const int r = it - NRG; p2_rg_item<true>(A, C, pl, l, r >> 3, 0, r & 7); }
}
DI void phase_p2(const Args& A, const Ctx& C, int l) {
    LAS unsigned char* pl = C.lds + C.wave * PRIV_BYTES;
    const int slot = C.wave * C.G + C.bid, NSLOT = C.G * NWAVES;
    if (NSLOT != 2048) return;
    constexpr int NL = 2048 - NCHH, NRGT = NB * NCH * 8 + 16, XRG = NRGT - 2 * NL, XRET = NCHH - NL;
    if (slot < NCHH) {
        p2_gdn_item(A, C, pl, l, slot);
        if (slot < XRG) p2_rg_any(A, C, pl, l, 2 * NL + slot);
        else p2_ret_item(A, C, pl, l, slot - XRG);
        return; }
    const int j = slot - NCHH;
    p2_rg_any(A, C, pl, l, j); p2_rg_any(A, C, pl, l, NL + j);
    if (j < NCHH - (NCHH - XRG)) p2_ret_item(A, C, pl, l, (NCHH - XRG) + j);
}

constexpr int CL_A = 0;
constexpr int CL_B = 17408;
constexpr int CL_KT = 34816;
constexpr int CL_AT = 53248;
constexpr int CL_PRIV = 62464;
constexpr int CL_PRIV_BYTES = 6656;
constexpr int CL_OT = CL_PRIV + 8 * CL_PRIV_BYTES;
static_assert(CL_OT + 64 * 72 * 2 <= MISC_OFF, "chain LDS map");

DI void p3_gdn_chain(const Args& A, const Ctx& C, int l, int b, int h, int half) {
    const int tid = C.tid, lane = C.lane, fr = lane & 15, fq = lane >> 4, cw = C.wave & 3, hp = C.wave >> 2, vb = 4 * half + cw;
    LAS unsigned char* L = C.lds;
    LAS bf16* Wb = (LAS bf16*)(L + CL_A); LAS bf16* QGb = (LAS bf16*)(L + CL_B); LAS bf16* KTb = (LAS bf16*)(L + CL_KT); LAS bf16* ATb = (LAS bf16*)(L + CL_AT);
    LAS bf16* ST = (LAS bf16*)(L + CL_PRIV + cw * CL_PRIV_BYTES); LAS bf16* VNT = ST + 16 * 136; LAS bf16* OT = (LAS bf16*)(L + CL_OT);
    bf16* U = (bf16*)(A.ws + WS_U); const size_t mrow0 = (size_t)b * TP;
    const bf16* gW = (const bf16*)(A.ws + G_W); const bf16* gQG = (const bf16*)(A.ws + G_QG); const bf16* gKDT = (const bf16*)(A.ws + G_KDT);
    const bf16* gUT = (const bf16*)(A.ws + G_UT); const bf16* gATT = (const bf16*)(A.ws + G_ATT); const float* EGL = (const float*)(A.ws + WS_EGL);
    if (hp == 0) for (int e = lane; e < 16 * 136 / 2; e += 64) ((LAS unsigned*)ST)[e] = 0u;
    f32x4 Sacc[4];
#pragma unroll
    for (int kb = 0; kb < 4; ++kb) Sacc[kb] = (f32x4){0.f, 0.f, 0.f, 0.f};
    u32x4 RA[7], RB[7]; u32x2 urA[2], urB[2]; float eglA, eglB;
    const int r16 = tid >> 4, c16 = tid & 15, r8 = tid >> 3, c8 = tid & 7;
#define GDN_PREFETCH(R, ur, eglr, CC_) do { const size_t ch_ = ((size_t)b * NCH + (CC_)) * 4 + h; \
        R[0] = *(const u32x4*)(gW + ch_ * 8192 + (size_t)tid * 8); R[1] = *(const u32x4*)(gW + ch_ * 8192 + (size_t)(tid + 512) * 8); \
        R[2] = *(const u32x4*)(gQG + ch_ * 8192 + (size_t)tid * 8); R[3] = *(const u32x4*)(gQG + ch_ * 8192 + (size_t)(tid + 512) * 8); \
        R[4] = *(const u32x4*)(gKDT + ch_ * 8192 + (size_t)tid * 8); R[5] = *(const u32x4*)(gKDT + ch_ * 8192 + (size_t)(tid + 512) * 8); \
        R[6] = *(const u32x4*)(gATT + ch_ * 4096 + (size_t)tid * 8); \
        _Pragma("unroll") for (int tb_ = 0; tb_ < 2; ++tb_) ur[tb_] = *(const u32x2*)(gUT + ch_ * 8192 + (vb * 16 + fr) * 64 + (2 * hp + tb_) * 16 + 4 * fq); \
        eglr = EGL[ch_]; } while (0)
#define GDN_COPYOUT(CC_) do { const int t_ = 64 * (CC_) - 48 + r8; const u32x4 v_ = *(const LAS u32x4*)(OT + r8 * 72 + c8 * 8); \
        if (t_ >= 0) *(u32x4*)(U + (mrow0 + t_) * DIN + 4096 + h * 128 + half * 64 + c8 * 8) = v_; } while (0)
#define GDN_STEP(c, R, ur, eglr) do { \
        TS_BEGIN(11); __syncthreads(); TS_END(11); TS_BEGIN(15); \
        *(LAS u32x4*)(Wb + r16 * 136 + c16 * 8) = R[0];        *(LAS u32x4*)(Wb + (r16 + 32) * 136 + c16 * 8) = R[1]; \
        *(LAS u32x4*)(QGb + r16 * 136 + c16 * 8) = R[2];       *(LAS u32x4*)(QGb + (r16 + 32) * 136 + c16 * 8) = R[3]; \
        *(LAS u32x4*)(KTb + r8 * 72 + c8 * 8) = R[4];          *(LAS u32x4*)(KTb + (r8 + 64) * 72 + c8 * 8) = R[5]; \
        *(LAS u32x4*)(ATb + r8 * 72 + c8 * 8) = R[6]; \
        f32x4 uv[2]; \
        _Pragma("unroll") for (int tb = 0; tb < 2; ++tb) uv[tb] = unpack4(ur[tb]); \
        const float egl = eglr; \
        if ((c) >= 1) GDN_COPYOUT((c) - 1); \
        LDS_WAIT(); TS_END(15); TS_BEGIN(16); \
        __syncthreads(); TS_END(16); TS_BEGIN(12); \
        if ((c) + 2 < NCH) GDN_PREFETCH(R, ur, eglr, (c) + 2); \
          \
        bf16x8 sf[4]; \
        _Pragma("unroll") for (int kc = 0; kc < 4; ++kc) sf[kc] = *(const LAS bf16x8*)(ST + fr * 136 + kc * 32 + 8 * fq); \
        f32x4 o[2]; \
        { bf16x8 wf[2][4], qf[2][4]; \
            _Pragma("unroll") for (int q2 = 0; q2 < 2; ++q2) _Pragma("unroll") for (int kc = 0; kc < 4; ++kc) { \
                wf[q2][kc] = *(const LAS bf16x8*)(Wb + ((hp * 2 + q2) * 16 + fr) * 136 + kc * 32 + 8 * fq); qf[q2][kc] = *(const LAS bf16x8*)(QGb + ((hp * 2 + q2) * 16 + fr) * 136 + kc * 32 + 8 * fq); } \
            LDS_WAIT(); \
            _Pragma("unroll") for (int q2 = 0; q2 < 2; ++q2) { const int tb = hp * 2 + q2; f32x4 aw = (f32x4){0.f, 0.f, 0.f, 0.f}, aq = aw; \
                _Pragma("unroll") for (int kc = 0; kc < 4; ++kc) { aw = mfma16(wf[q2][kc], sf[kc], aw); aq = mfma16(qf[q2][kc], sf[kc], aq); } \
                const f32x4 vn = uv[q2] - aw; o[q2] = aq; \
                *(LAS u32x2*)(VNT + fr * 72 + tb * 16 + 4 * fq) = pack4(vn); } } \
        bf16x8 af[2][2], kf[4][2];                   \
        _Pragma("unroll") for (int q2 = 0; q2 < 2; ++q2) _Pragma("unroll") for (int k2 = 0; k2 < 2; ++k2) af[q2][k2] = *(const LAS bf16x8*)(ATb + ((hp * 2 + q2) * 16 + fr) * 72 + k2 * 32 + 8 * fq); \
        _Pragma("unroll") for (int q4 = 0; q4 < 4; ++q4) _Pragma("unroll") for (int k2 = 0; k2 < 2; ++k2) kf[q4][k2] = *(const LAS bf16x8*)(KTb + ((hp * 4 + q4) * 16 + fr) * 72 + k2 * 32 + 8 * fq); \
        LDS_WAIT(); \
        __syncthreads();                             \
        bf16x8 vf[2]; \
        _Pragma("unroll") for (int k2 = 0; k2 < 2; ++k2) vf[k2] = *(const LAS bf16x8*)(VNT + fr * 72 + k2 * 32 + 8 * fq); \
        LDS_WAIT(); \
        _Pragma("unroll") for (int q2 = 0; q2 < 2; ++q2) \
            _Pragma("unroll") for (int k2 = 0; k2 < 2; ++k2) o[q2] = mfma16(af[q2][k2], vf[k2], o[q2]); \
        _Pragma("unroll") for (int q4 = 0; q4 < 4; ++q4) { const int kb = hp * 4 + q4; f32x4 s = Sacc[q4] * egl; \
            _Pragma("unroll") for (int k2 = 0; k2 < 2; ++k2) s = mfma16(kf[q4][k2], vf[k2], s); \
            Sacc[q4] = s; \
            *(LAS u32x2*)(ST + fr * 136 + kb * 16 + 4 * fq) = pack4(s); } \
        _Pragma("unroll") for (int q2 = 0; q2 < 2; ++q2) \
            _Pragma("unroll") for (int r = 0; r < 4; ++r) OT[((hp * 2 + q2) * 16 + 4 * fq + r) * 72 + cw * 16 + fr] = (bf16)f2bf(o[q2][r]); \
        LDS_WAIT(); TS_END(12); } while (0)
    GDN_PREFETCH(RA, urA, eglA, 0); GDN_PREFETCH(RB, urB, eglB, 1);
#pragma unroll 1
    for (int c = 0; c + 1 < NCH; c += 2) { GDN_STEP(c, RA, urA, eglA); GDN_STEP(c + 1, RB, urB, eglB); }
    GDN_STEP(NCH - 1, RA, urA, eglA);
#undef GDN_STEP
#undef GDN_PREFETCH
    { float* so = A.out + O_GP + ((size_t)(l * NB + b) * 4 + h) * 16384;
#pragma unroll
        for (int q4 = 0; q4 < 4; ++q4)
#pragma unroll
            for (int r = 0; r < 4; ++r) so[(size_t)((hp * 4 + q4) * 16 + 4 * fq + r) * 128 + vb * 16 + fr] = Sacc[q4][r]; }
    LDS_WAIT(); __syncthreads();
    GDN_COPYOUT(NCH - 1);
#undef GDN_COPYOUT
}

DI void p3_ret_chain(const Args& A, const Ctx& C, int l, int b, int h, int half) {
    const int tid = C.tid, lane = C.lane, fr = lane & 15, fq = lane >> 4, cw = C.wave & 3, hp = C.wave >> 2, vb = 4 * half + cw;
    LAS unsigned char* L = C.lds;
    LAS bf16* Qb = (LAS bf16*)(L + CL_A); LAS bf16* KTb = (LAS bf16*)(L + CL_KT); LAS bf16* SCb = (LAS bf16*)(L + CL_AT);
    LAS bf16* ST = (LAS bf16*)(L + CL_PRIV + cw * CL_PRIV_BYTES); LAS bf16* OT = (LAS bf16*)(L + CL_OT);
    bf16* U = (bf16*)(A.ws + WS_U); const size_t mrow0 = (size_t)b * TP;
    const bf16* gKRT = (const bf16*)(A.ws + R_KRT); const bf16* gVT = (const bf16*)(A.ws + R_VT); const bf16* gSC = (const bf16*)(A.ws + R_SC);
    if (hp == 0) for (int e = lane; e < 16 * 136 / 2; e += 64) ((LAS unsigned*)ST)[e] = 0u;
    f32x4 Sacc[4];
#pragma unroll
    for (int kb = 0; kb < 4; ++kb) Sacc[kb] = (f32x4){0.f, 0.f, 0.f, 0.f};
    const float sdec = exp2f(64.f * log2f(1.f - exp2f(-5.f - (float)h)));
    u32x4 RA[5], RB[5]; bf16x8 vfA[2], vfB[2];
    const int r16 = tid >> 4, c16 = tid & 15, r8 = tid >> 3, c8 = tid & 7;
#define RET_PREFETCH(R, vfr, CC_) do { const int cc_ = (CC_); const size_t ch_ = ((size_t)b * NCH + cc_) * 4 + h; const int t0_ = 64 * cc_ - 48; \
        { const int ta_ = t0_ + r16, tb2_ = t0_ + r16 + 32; const u32x4 z_ = (u32x4){0u, 0u, 0u, 0u}; \
          R[0] = ta_ >= 0 ? *(const u32x4*)(U + (mrow0 + ta_) * DIN + 1024 + h * 128 + c16 * 8) : z_; \
          R[1] = tb2_ >= 0 ? *(const u32x4*)(U + (mrow0 + tb2_) * DIN + 1024 + h * 128 + c16 * 8) : z_; } \
        R[2] = *(const u32x4*)(gKRT + ch_ * 8192 + (size_t)tid * 8); R[3] = *(const u32x4*)(gKRT + ch_ * 8192 + (size_t)(tid + 512) * 8); \
        R[4] = *(const u32x4*)(gSC + ch_ * 4096 + (size_t)tid * 8); \
        _Pragma("unroll") for (int k2_ = 0; k2_ < 2; ++k2_) vfr[k2_] = *(const bf16x8*)(gVT + ch_ * 8192 + (vb * 16 + fr) * 64 + k2_ * 32 + 8 * fq); } while (0)
#define RET_COPYOUT(CC_) do { const int t_ = 64 * (CC_) - 48 + r8; const u32x4 v_ = *(const LAS u32x4*)(OT + r8 * 72 + c8 * 8); \
        if (t_ >= 0) *(u32x4*)(U + (mrow0 + t_) * DIN + 2048 + h * 128 + half * 64 + c8 * 8) = v_; } while (0)
#define RET_STEP(c, R, vfr) do { \
        __syncthreads(); \
        *(LAS u32x4*)(Qb + r16 * 136 + c16 * 8) = R[0];        *(LAS u32x4*)(Qb + (r16 + 32) * 136 + c16 * 8) = R[1]; \
        *(LAS u32x4*)(KTb + r8 * 72 + c8 * 8) = R[2];          *(LAS u32x4*)(KTb + (r8 + 64) * 72 + c8 * 8) = R[3]; \
        *(LAS u32x4*)(SCb + r8 * 72 + c8 * 8) = R[4]; \
        bf16x8 vf[2]; vf[0] = vfr[0]; vf[1] = vfr[1]; \
        if ((c) >= 1) RET_COPYOUT((c) - 1); \
        LDS_WAIT(); \
        __syncthreads(); \
        if ((c) + 2 < NCH) RET_PREFETCH(R, vfr, (c) + 2); \
        bf16x8 sf[4]; \
        _Pragma("unroll") for (int kc = 0; kc < 4; ++kc) sf[kc] = *(const LAS bf16x8*)(ST + fr * 136 + kc * 32 + 8 * fq); \
        bf16x8 qf[2][4], cf[2][2], kf[4][2]; \
        _Pragma("unroll") for (int q2 = 0; q2 < 2; ++q2) { _Pragma("unroll") for (int kc = 0; kc < 4; ++kc) qf[q2][kc] = *(const LAS bf16x8*)(Qb + ((hp * 2 + q2) * 16 + fr) * 136 + kc * 32 + 8 * fq); \
            _Pragma("unroll") for (int k2 = 0; k2 < 2; ++k2) cf[q2][k2] = *(const LAS bf16x8*)(SCb + ((hp * 2 + q2) * 16 + fr) * 72 + k2 * 32 + 8 * fq); } \
        _Pragma("unroll") for (int q4 = 0; q4 < 4; ++q4) _Pragma("unroll") for (int k2 = 0; k2 < 2; ++k2) kf[q4][k2] = *(const LAS bf16x8*)(KTb + ((hp * 4 + q4) * 16 + fr) * 72 + k2 * 32 + 8 * fq); \
        LDS_WAIT(); \
        f32x4 o[2]; \
        _Pragma("unroll") for (int q2 = 0; q2 < 2; ++q2) { f32x4 aq = (f32x4){0.f, 0.f, 0.f, 0.f}; \
            _Pragma("unroll") for (int kc = 0; kc < 4; ++kc) aq = mfma16(qf[q2][kc], sf[kc], aq); \
            _Pragma("unroll") for (int k2 = 0; k2 < 2; ++k2) aq = mfma16(cf[q2][k2], vf[k2], aq); \
            o[q2] = aq; } \
        __syncthreads();                             \
        _Pragma("unroll") for (int q4 = 0; q4 < 4; ++q4) { const int kb = hp * 4 + q4; f32x4 s = Sacc[q4] * sdec; \
            _Pragma("unroll") for (int k2 = 0; k2 < 2; ++k2) s = mfma16(kf[q4][k2], vf[k2], s); \
            Sacc[q4] = s; \
            *(LAS u32x2*)(ST + fr * 136 + kb * 16 + 4 * fq) = pack4(s); } \
        _Pragma("unroll") for (int q2 = 0; q2 < 2; ++q2) \
            _Pragma("unroll") for (int r = 0; r < 4; ++r) OT[((hp * 2 + q2) * 16 + 4 * fq + r) * 72 + cw * 16 + fr] = (bf16)f2bf(o[q2][r]); \
        LDS_WAIT(); } while (0)
    RET_PREFETCH(RA, vfA, 0); RET_PREFETCH(RB, vfB, 1);
#pragma unroll 1
    for (int c = 0; c + 1 < NCH; c += 2) { RET_STEP(c, RA, vfA); RET_STEP(c + 1, RB, vfB); }
    RET_STEP(NCH - 1, RA, vfA);
#undef RET_STEP
#undef RET_PREFETCH
    { float* so = A.out + O_RP + ((size_t)(l * NB + b) * 4 + h) * 16384;
#pragma unroll
        for (int q4 = 0; q4 < 4; ++q4)
#pragma unroll
            for (int r = 0; r < 4; ++r) so[(size_t)((hp * 4 + q4) * 16 + 4 * fq + r) * 128 + vb * 16 + fr] = Sacc[q4][r]; }
    LDS_WAIT(); __syncthreads();
    RET_COPYOUT(NCH - 1);
#undef RET_COPYOUT
}

DI void phase_p3b(const Args& A, const Ctx& C, int l) {
    const int lane = C.lane, gw = C.bid * NWAVES + C.wave, NGW = C.G * NWAVES;
    const bf16* U = (const bf16*)(A.ws + WS_U); bf16* MIX = (bf16*)(A.ws + WS_MIX);
    float gw0[4], gw1[4], gb0[4], gb1[4];
#pragma unroll
    for (int h = 0; h < 4; ++h) { gw0[h] = A.in[16][l * 512 + h * 128 + 2 * lane]; gw1[h] = A.in[16][l * 512 + h * 128 + 2 * lane + 1];
                                  gb0[h] = A.in[17][l * 512 + h * 128 + 2 * lane]; gb1[h] = A.in[17][l * 512 + h * 128 + 2 * lane + 1]; }
    const float nw0 = A.in[21][l * 128 + 2 * lane], nw1 = A.in[21][l * 128 + 2 * lane + 1];
    unsigned nro[4], nrz[4], ngo[4], ngz[4];
#define P3B_LOAD(m_) do { const bf16* u_ = U + (size_t)(m_) * DIN + 2 * lane; \
        _Pragma("unroll") for (int h = 0; h < 4; ++h) { nro[h] = *(const unsigned*)(u_ + 2048 + h * 128); nrz[h] = *(const unsigned*)(u_ + 2560 + h * 128); ngo[h] = *(const unsigned*)(u_ + 4096 + h * 128); ngz[h] = *(const unsigned*)(u_ + 4608 + h * 128); } } while (0)
    if (gw < MP) P3B_LOAD(gw);
#pragma unroll 1
    for (int m = gw; m < MP; m += NGW) {
        unsigned ro[4], rz[4], go[4], gz[4];
#pragma unroll
        for (int h = 0; h < 4; ++h) { ro[h] = nro[h]; rz[h] = nrz[h]; go[h] = ngo[h]; gz[h] = ngz[h]; }
        if (m + NGW < MP) P3B_LOAD(m + NGW);
        bf16* mx = MIX + (size_t)m * DMIX + 2 * lane;
#pragma unroll
        for (int h = 0; h < 4; ++h) {
            { const float o0 = bflo(ro[h]), o1 = bfhi(ro[h]); const float mu = wave_sum(o0 + o1) * (1.f / 128.f); const float d0 = o0 - mu, d1 = o1 - mu;
              const float rn = rsqrtf(wave_sum(d0 * d0 + d1 * d1) * (1.f / 128.f) + EPS);
              *(unsigned*)(mx + 512 + h * 128) = pk2((d0 * rn * gw0[h] + gb0[h]) * siluf_(bflo(rz[h])), (d1 * rn * gw1[h] + gb1[h]) * siluf_(bfhi(rz[h]))); }
            { const float o0 = bflo(go[h]), o1 = bfhi(go[h]); const float rn = rsqrtf(wave_sum(o0 * o0 + o1 * o1) * (1.f / 128.f) + EPS);
              *(unsigned*)(mx + 1024 + h * 128) = pk2(o0 * rn * nw0 * siluf_(bflo(gz[h])), o1 * rn * nw1 * siluf_(bfhi(gz[h]))); } }
    }
#undef P3B_LOAD
}

template <int KIND>
DI void p3_dec_item(const Args& A, const Ctx& C, int l, int s, int h) {
    const int tid = C.tid, lane = C.lane, wave = C.wave;
    LAS float* F = (LAS float*)C.lds; LAS float* vq = F, *vk = F + 128, *vv = F + 256, *part = F + 384  , *red = F + 896  ;
    const bf16* U = (const bf16*)(A.ws + WS_U); const size_t m = (size_t)MP + s; const bf16* u = U + m * DIN;
    __syncthreads();
    float g = 0.f, beta = 0.f;
    if (KIND == 0) {
        if (tid < 64) { const f32x2 cs = ((const f32x2*)(A.ws + WS_TAB))[2064 * 64 + tid];
            const float q1 = bf2f(u[1024 + h * 128 + tid]), q2 = bf2f(u[1024 + h * 128 + 64 + tid]), k1 = bf2f(u[1536 + h * 128 + tid]), k2 = bf2f(u[1536 + h * 128 + 64 + tid]);
            vq[tid] = q1 * cs[0] - q2 * cs[1]; vq[64 + tid] = q1 * cs[1] + q2 * cs[0];
            vk[tid] = (k1 * cs[0] - k2 * cs[1]) * QSCALE; vk[64 + tid] = (k1 * cs[1] + k2 * cs[0]) * QSCALE; }
        else if (tid >= 128 && tid < 256) vv[tid - 128] = bf2f(u[2048 + h * 128 + (tid - 128)]);
    } else {
        float y = 0.f; const int part3 = tid >> 7, d = tid & 127;
        if (tid < 384) { const int ch = part3 * 512 + h * 128 + d; const float* cv = A.in[5] + ((size_t)(l * NS + s) * 3) * 1536 + ch; const float* cw = A.in[18] + (size_t)l * 4 * 1536 + ch;
            const float x0 = cv[0], x1 = cv[1536], x2 = cv[3072], x3 = bf2f(u[3072 + ch]);
            y = siluf_(cw[0] * x0 + cw[1536] * x1 + cw[3072] * x2 + cw[4608] * x3);
            float* oc = A.out + O_GCS + ((size_t)(l * NS + s) * 3) * 1536 + ch; oc[0] = x1; oc[1536] = x2; oc[3072] = x3; }
        const float ss = wave_sum(y * y);
        if (lane == 0) red[wave] = ss;
        __syncthreads();
        if (tid < 384) { const float tot = red[2 * part3] + red[2 * part3 + 1];
            if (part3 == 0) vq[d] = y * rsqrtf(tot + EPS) * QSCALE; else if (part3 == 1) vk[d] = y * rsqrtf(tot + EPS); else vv[d] = y; }
        const float* gp = (const float*)(A.ws + WS_GAB) + m * 8;
        g = -__expf(A.in[19][l * 4 + h]) * softplusf_(gp[h] + A.in[20][l * 4 + h]); beta = sigmoidf_(gp[4 + h]);
    }
    __syncthreads();
    const int dv = tid & 127, qt = tid >> 7;
    const float* st = (KIND == 0 ? A.in[4] : A.in[6]) + ((size_t)(l * NS + s) * 4 + h) * 16384 + (size_t)(32 * qt) * 128 + dv;
    float* so = A.out + (KIND == 0 ? O_RS : O_GS) + ((size_t)(l * NS + s) * 4 + h) * 16384 + (size_t)(32 * qt) * 128 + dv;
    float S[32];
#pragma unroll
    for (int i = 0; i < 32; ++i) S[i] = st[(size_t)i * 128];
    const float vdv = vv[dv]; float acc = 0.f;
    if (KIND == 0) {
        const float gam = 1.f - exp2f(-5.f - (float)h);
#pragma unroll
        for (int i = 0; i < 32; ++i) { S[i] = fmaf(gam, S[i], vk[32 * qt + i] * vdv); acc = fmaf(vq[32 * qt + i], S[i], acc); }
    } else {
        const float eg = __expf(g); float ks = 0.f;
#pragma unroll
        for (int i = 0; i < 32; ++i) ks = fmaf(vk[32 * qt + i], S[i], ks);
        part[qt * 128 + dv] = ks;
        __syncthreads();
        const float vn = beta * (vdv - eg * (part[dv] + part[128 + dv] + part[256 + dv] + part[384 + dv]));
        __syncthreads();
#pragma unroll
        for (int i = 0; i < 32; ++i) { S[i] = fmaf(eg, S[i], vk[32 * qt + i] * vn); acc = fmaf(vq[32 * qt + i], S[i], acc); }
    }
    part[qt * 128 + dv] = acc;
#pragma unroll
    for (int i = 0; i < 32; ++i) so[(size_t)i * 128] = S[i];
    __syncthreads();
    bf16* MIX = (bf16*)(A.ws + WS_MIX);
    float o = 0.f, sz = 0.f;
    if (tid < 128) { o = part[dv] + part[128 + dv] + part[256 + dv] + part[384 + dv]; sz = siluf_(bf2f(u[(KIND == 0 ? 2560 : 4608) + h * 128 + dv])); }
    if (KIND == 0) {
        const float s1 = wave_sum(o);
        if (lane == 0) red[wave] = s1;
        __syncthreads();
        const float mu = (red[0] + red[1]) * (1.f / 128.f); const float d = tid < 128 ? o - mu : 0.f;
        __syncthreads();
        const float s2 = wave_sum(d * d);
        if (lane == 0) red[wave] = s2;
        __syncthreads();
        const float rn = rsqrtf((red[0] + red[1]) * (1.f / 128.f) + EPS);
        if (tid < 128) MIX[m * DMIX + 512 + h * 128 + dv] = (bf16)f2bf((d * rn * A.in[16][l * 512 + h * 128 + dv] + A.in[17][l * 512 + h * 128 + dv]) * sz);
    } else {
        const float s2 = wave_sum(o * o);
        if (lane == 0) red[wave] = s2;
        __syncthreads();
        const float rn = rsqrtf((red[0] + red[1]) * (1.f / 128.f) + EPS);
        if (tid < 128) MIX[m * DMIX + 1024 + h * 128 + dv] = (bf16)f2bf(o * rn * A.in[21][l * 128 + dv] * sz);
    }
}

DI void p3_rg_fix(const Args& A, const Ctx& C, int l, int b, int c) {
    const int tid = C.tid, ch8 = 8 * (tid & 63), tsub = tid >> 6;
    const bf16* U = (const bf16*)(A.ws + WS_U); const bf16* BETA = (const bf16*)(A.ws + WS_BETA); bf16* MIX = (bf16*)(A.ws + WS_MIX);
    const f32x4* RGS = (const f32x4*)((const f32x2*)(A.ws + WS_RGS) + (size_t)b * NCH * 512 + ch8);
    float hin[8];
#pragma unroll
    for (int e = 0; e < 8; ++e) hin[e] = 0.f;
    for (int cp0 = 0; cp0 < c; cp0 += 4) {
        f32x4 pp[4][4];
#pragma unroll
        for (int q = 0; q < 4; ++q)
#pragma unroll
            for (int e2 = 0; e2 < 4; ++e2) pp[q][e2] = (cp0 + q < c) ? RGS[(size_t)(cp0 + q) * 256 + e2] : (f32x4){1.f, 0.f, 1.f, 0.f};
#pragma unroll
        for (int q = 0; q < 4; ++q)
#pragma unroll
            for (int e2 = 0; e2 < 4; ++e2) { const f32x4 p = pp[q][e2]; hin[2 * e2] = fmaf(p[0], hin[2 * e2], p[1]); hin[2 * e2 + 1] = fmaf(p[2], hin[2 * e2 + 1], p[3]); } }
    const int t0 = 64 * c - 48; const size_t mrow0 = (size_t)b * TP;
    u32x4 ra[8], rb[8];
#pragma unroll
    for (int k = 0; k < 8; ++k) { const int t = t0 + tsub + 8 * k; const int tc = t >= 0 ? t : 0;
        ra[k] = *(const u32x4*)(U + (mrow0 + tc) * DIN + 512 + ch8); rb[k] = *(const u32x4*)(BETA + ((size_t)b * TP + tc) * 512 + ch8); }
#pragma unroll
    for (int k = 0; k < 8; ++k) { const int t = t0 + tsub + 8 * k; if (t < 0) continue;
        float al[8], be[8]; unpack8(ra[k], al); unpack8(rb[k], be);
#pragma unroll
        for (int e = 0; e < 8; ++e) al[e] = fmaf(be[e], hin[e], al[e]);
        *(u32x4*)(MIX + (mrow0 + t) * DMIX + ch8) = pack8(al); }
    if (c == NCH - 1 && tsub == 0) { float* o = A.out + O_HP + (size_t)(l * NB + b) * 512 + ch8;
#pragma unroll
        for (int e2 = 0; e2 < 4; ++e2) { const f32x4 p = RGS[(size_t)c * 256 + e2]; o[2 * e2] = fmaf(p[0], hin[2 * e2], p[1]); o[2 * e2 + 1] = fmaf(p[2], hin[2 * e2 + 1], p[3]); } }
}

DI void phase_p3(const Args& A, const Ctx& C, int l) {
    if (C.G < 256) return;
    if (C.bid < 128) { const int kind = C.bid & 1, bh = (C.bid >> 1) & 31, half = C.bid >> 6;
        if (kind) p3_ret_chain(A, C, l, bh >> 2, bh & 3, half); else p3_gdn_chain(A, C, l, bh >> 2, bh & 3, half);
        return; }
    const int NJ = C.G - 128;
    for (int it = C.bid - 128; it < 1024; it += NJ) {
        if (it < 512) p3_dec_item<1>(A, C, l, it >> 2, it & 3);
        else p3_dec_item<0>(A, C, l, (it - 512) >> 2, it & 3);
    }
    for (int r = C.bid - 128; r < NB * NCH; r += NJ) p3_rg_fix(A, C, l, r / NCH, r % NCH);
}

DI void p4_tail_task(const Args& A, const Ctx& C, int l, int task) {
    const int lane = C.lane, fr = lane & 15, fq = lane >> 4, col0 = (task & 63) * 16, row0 = (M - 256) + (task >> 6) * 64 + (C.wave & 3) * 16, kh = C.wave >> 2;
    const bf16* ap = (const bf16*)(A.ws + WS_MIX) + (size_t)(row0 + fr) * DMIX + kh * 768 + 8 * fq;
    const bf16* bp = (const bf16*)(A.ws + ((l & 1) ? WS_WOUTT1 : WS_WOUTT)) + (size_t)(col0 + fr) * DMIX + kh * 768 + 8 * fq;
    f32x4 acc = (f32x4){0.f, 0.f, 0.f, 0.f};
#pragma unroll
    for (int hb = 0; hb < 2; ++hb) { bf16x8 a[12], bb[12];
#pragma unroll
        for (int u = 0; u < 12; ++u) { a[u] = *(const bf16x8*)(ap + (hb * 12 + u) * 32); bb[u] = *(const bf16x8*)(bp + (hb * 12 + u) * 32); }
#pragma unroll
        for (int u = 0; u < 12; ++u) acc = mfma16(a[u], bb[u], acc); }
    LAS f32x4* red = (LAS f32x4*)C.lds;
    __syncthreads();
    if (kh == 1) red[(C.wave & 3) * 64 + lane] = acc;
    __syncthreads();
    if (kh == 0) { const f32x4 o = acc + red[(C.wave & 3) * 64 + lane]; bf16* XF = (bf16*)(A.ws + WS_XF); const bf16* XB = (const bf16*)(A.ws + WS_XB);
#pragma unroll
        for (int r = 0; r < 4; ++r) { const size_t ix = (size_t)(row0 + 4 * fq + r) * DM + col0 + fr; XF[ix] = (bf16)f2bf(ALPHA * bf2f(XB[ix]) + o[r]); } }
}


#endif
constexpr int PPL = 6, N_PHASES = 1 + PPL * DEPTH;
#if defined(__HIP_DEVICE_COMPILE__)
DI const Args* launder(const Args* p) { asm volatile("" : "+s"(p)); return p; }
#endif
__global__ void __launch_bounds__(NTHR, 2) mk_fwd(Args args) {
#if defined(__HIP_DEVICE_COMPILE__)
    extern __shared__ __attribute__((aligned(16))) unsigned char lds_raw[];
    const Args* AP = (const Args*)__builtin_amdgcn_kernarg_segment_ptr();
#define A (*launder(AP))
#define MISCP ((volatile LAS unsigned*)((LAS unsigned char*)lds_raw + MISC_OFF))
#define MK_CTX() Ctx C; { int t_ = threadIdx.x; asm volatile("" : "+v"(t_)); C.lds = (LAS unsigned char*)lds_raw; C.tid = t_; C.lane = t_ & 63; C.wave = __builtin_amdgcn_readfirstlane(t_ >> 6); C.G = gridDim.x; C.bid = blockIdx.x; }
#define IN(p) (A.ph_lo <= (p) && (p) < A.ph_hi)
#define SEAM(p) do { if (IN(p) && IN((p) + 1)) { XcdBarrier bar_; bar_.bar = (unsigned*)(A.ws + WS_CTL) + CW_BAR; bar_.x = xb_xcc_id(); bar_.st = MISCP + 8; xcd_barrier(bar_); } } while (0)
    if (threadIdx.x < 32) MISCP[threadIdx.x] = 0u;
    __syncthreads();
#if MK_TMASK || MK_TMODE
#define TSTAMP ((volatile LAS unsigned long long*)((LAS unsigned char*)lds_raw + MISC_OFF + 64))
#define STAMP(ph) do { if (blockIdx.x == MK_TBLOCK && threadIdx.x == 0) { const unsigned long long now_ = __builtin_amdgcn_s_memrealtime(); if (!MK_TMODE && ((MK_TMASK >> (ph)) & 1)) TSTAMP[1] += now_ - TSTAMP[0]; TSTAMP[0] = now_; } } while (0)
#define STAMP_PRE(ph) do { if (MK_TMODE) { __syncthreads(); if (blockIdx.x == MK_TBLOCK && threadIdx.x == 0 && ((MK_TMASK >> (ph)) & 1)) TSTAMP[1] += __builtin_amdgcn_s_memrealtime() - TSTAMP[0]; } } while (0)
    if (blockIdx.x == MK_TBLOCK && threadIdx.x == 0) { TSTAMP[0] = __builtin_amdgcn_s_memrealtime(); TSTAMP[1] = 0ull; }
#else
#define STAMP(ph) do { } while (0)
#define STAMP_PRE(ph) do { } while (0)
#endif
    if (A.ph_hi - A.ph_lo > 1) (void)xcd_barrier_post((unsigned*)(A.ws + WS_CTL) + CW_BAR, MISCP + 8);
    if (IN(0)) { MK_CTX(); convert_weights(A, C, 0, C.bid * NWAVES + C.wave, C.G * NWAVES); build_rope_table(A, C); row_pass(A, C, 0); }
    STAMP_PRE(0); SEAM(0); STAMP(0);
#define LAYER(l) do { \
        if (IN(1 + PPL * (l))) { struct { LAS unsigned char* lds; int G, bid; } C{(LAS unsigned char*)lds_raw, (int)gridDim.x, (int)blockIdx.x}; \
            { pg8::Gemm g{(const pg8::bf16_t*)(A.ws + WS_XB), (const pg8::bf16_t*)(A.ws + (((l) & 1) ? WS_WINT1 : WS_WINT)), M, DIN, DM, DM}; pg8::StaticOrder S; S.init(M, DIN, C.G, C.bid); \
              pg8::EpiU E{(pg8::bf16_t*)(A.ws + WS_U), DIN}; \
              pg8::gemm_phase<pg8::EpiU, pg8::StaticOrder, true, true>(C.lds, g, S, E); } \
              \
            if ((l) + 1 < DEPTH && (int)C.bid >= (M / 256) * (DIN / 256) % C.G) { MK_CTX(); const int nb_ = (M / 256) * (DIN / 256) % C.G; convert_weights(A, C, (l) + 1, ((int)C.bid - nb_) * NWAVES + C.wave, (C.G - nb_) * NWAVES); } } \
        STAMP_PRE(1 + PPL * (l)); SEAM(1 + PPL * (l)); STAMP(1 + PPL * (l)); \
        if (IN(2 + PPL * (l))) { MK_CTX(); phase_p2(A, C, (l)); } \
        STAMP_PRE(2 + PPL * (l)); SEAM(2 + PPL * (l)); STAMP(2 + PPL * (l)); \
        if (IN(3 + PPL * (l))) { MK_CTX(); phase_p3(A, C, (l)); } \
        STAMP_PRE(3 + PPL * (l)); SEAM(3 + PPL * (l)); STAMP(3 + PPL * (l)); \
        if (IN(4 + PPL * (l))) { MK_CTX(); phase_p3b(A, C, (l)); } \
        STAMP_PRE(4 + PPL * (l)); SEAM(4 + PPL * (l)); STAMP(4 + PPL * (l)); \
        if (IN(5 + PPL * (l))) { struct { LAS unsigned char* lds; int G, bid; } C{(LAS unsigned char*)lds_raw, (int)gridDim.x, (int)blockIdx.x}; \
              \
              \
            { pg8::Gemm g{(const pg8::bf16_t*)(A.ws + WS_MIX), (const pg8::bf16_t*)(A.ws + (((l) & 1) ? WS_WOUTT1 : WS_WOUTT)), M - 256, DM, DMIX, DMIX}; pg8::StaticOrder S; S.init(M - 256, DM, C.G, C.bid); \
              pg8::EpiAcc E{(pg8::bf16_t*)(A.ws + WS_XF), (const pg8::bf16_t*)(A.ws + WS_XB), DM, ALPHA}; \
              pg8::gemm_phase<pg8::EpiAcc, pg8::StaticOrder, false, true>(C.lds, g, S, E); } \
            { MK_CTX(); p4_tail_task(A, C, (l), (int)C.bid); } } \
        STAMP_PRE(5 + PPL * (l)); SEAM(5 + PPL * (l)); STAMP(5 + PPL * (l)); \
        if (IN(6 + PPL * (l))) { MK_CTX(); row_pass(A, C, (l) + 1); } \
        STAMP_PRE(6 + PPL * (l)); if ((l) + 1 < DEPTH) SEAM(6 + PPL * (l)); STAMP(6 + PPL * (l)); } while (0)
    LAYER(0); LAYER(1); LAYER(2); LAYER(3);
#undef LAYER
#if MK_TMASK || MK_TMODE
    __syncthreads();
    if (blockIdx.x == MK_TBLOCK && threadIdx.x == 0) { const unsigned long long t0_ = __builtin_amdgcn_s_memrealtime(), tgt_ = TSTAMP[1] * 9ull;
        while (__builtin_amdgcn_s_memrealtime() - t0_ < tgt_) __builtin_amdgcn_s_sleep(8); }
#endif
#undef IN
#undef SEAM
#undef A
#undef MK_CTX
#undef MISCP
#endif
}

}

#ifndef MK_DEBUG
#define MK_DEBUG 0
#endif
#ifndef MK_PROBE
#define MK_PROBE -1
#endif
#ifndef MK_LAUNCH_PER_PHASE
#define MK_LAUNCH_PER_PHASE 0
#endif
extern "C" void kernel_launch(void* const* d_in, const int* in_sizes, int n_in, void* d_out, int out_size, void* d_ws, size_t ws_size, hipStream_t stream) {
    using namespace fx;
    static int grid = 0;
    if (grid == 0) {
        int dev = 0, cus = 0;
        if (n_in != 25 || out_size != (int)O_END || ws_size < WS_END) { fprintf(stderr, "kernel_launch: unexpected sizes (n_in %d, out %d, ws %zu)\n", n_in, out_size, ws_size); grid = -1; return; }
        if (hipGetDevice(&dev) != hipSuccess || hipDeviceGetAttribute(&cus, hipDeviceAttributeMultiprocessorCount, dev) != hipSuccess) { grid = -1; return; }
        if (hipFuncSetAttribute((const void*)mk_fwd, hipFuncAttributeMaxDynamicSharedMemorySize, LDS_BYTES) != hipSuccess) { fprintf(stderr, "kernel_launch: hipFuncSetAttribute failed\n"); grid = -1; return; }
        (void)hipGetLastError();
        grid = cus;
    }
    if (grid < 0) return;
    unsigned char* ws = (unsigned char*)d_ws;
    (void)hipMemsetAsync(ws + WS_CTL, 0, CTL_ZERO_BYTES, stream);
    Args a{};
    for (int i = 0; i < 25; ++i) a.in[i] = (GAS const float*)d_in[i];
    a.out = (GAS float*)d_out; a.ws = (GAS unsigned char*)ws;
#if MK_DEBUG
    using namespace dbg;
    float* err = (float*)(ws + D_ERR);
    (void)hipMemsetAsync(err, 0, 8192, stream);
    nv::Io io; for (int i = 0; i < 25; ++i) io.in[i] = (const float*)d_in[i]; io.out = (float*)d_out;
    const float* XF = (const float*)(ws + WS_XF); const bf16* XB = (const bf16*)(ws + WS_XB); const float* GAB = (const float*)(ws + WS_GAB); const bf16* U = (const bf16*)(ws + WS_U);
    const bf16* MIX = (const bf16*)(ws + WS_MIX); float* MIXn = (float*)(ws + D_MIXN); float* CST = (float*)(ws + D_ST); float* XFc = (float*)(ws + D_XFC);
    float* out = (float*)d_out;
    for (int ph = 0; ph < N_PHASES; ++ph) {
        const int l = ph == 0 ? -1 : (ph - 1) / 5, k = ph == 0 ? -1 : (ph - 1) % 5;
        if (k == 1) {
            nv::LayerP P = nv::layer_params(io, l);
            P.o_hp = CST + C_HP; P.o_cp = CST + C_CP; P.o_rp = CST + C_RP; P.o_gcp = CST + C_GCP; P.o_gp = CST + C_GP;
            P.o_hs = CST + C_HS; P.o_cs = CST + C_CS; P.o_rs = CST + C_RS; P.o_gcs = CST + C_GCS; P.o_gs = CST + C_GS;
            const nv::Grp g{0, 1, 0, 16}; const nv::UBF ua{(const unsigned short*)U, GAB, 2064, 0};
            nv::rg_kernel<nv::UBF><<<dim3(8, 17), 64, 0, stream>>>(g, P, ua, MIXn);
            nv::ret_kernel<nv::UBF><<<dim3(4, 17), 256, 0, stream>>>(g, P, ua, MIXn);
            nv::gdn_kernel<nv::UBF><<<dim3(4, 17), 256, 0, stream>>>(g, P, ua, MIXn);
        }
        if (k == 3) copy_rows<<<SUBR, 256, 0, stream>>>(XF, XFc);
        a.ph_lo = ph; a.ph_hi = ph + 1;
        hipLaunchKernelGGL(mk_fwd, dim3(grid), dim3(NTHR), LDS_BYTES, stream, a);
        if (ph == 0 || k == 4) { const int ln = l + 1;
            if (ln < DEPTH) {
                if (ln == 0) chk_x0<<<SUBR, 256, 0, stream>>>(XF, io.in[0], io.in[1], io.in[7], err, 18 * ln + 0);
                chk_rows_in<<<SUBR, 256, 0, stream>>>(XF, XB, GAB, io.in[8] + (size_t)ln * DM * DINX, err, 18 * ln + 0);
                chk_wt<<<1024, 256, 0, stream>>>((const bf16*)(ws + WS_WINT), io.in[8] + (size_t)ln * DM * DINX, DINX, DM, DIN, err, 18 * ln + 1);
                chk_wt<<<512, 256, 0, stream>>>((const bf16*)(ws + WS_WOUTT), io.in[22] + (size_t)ln * DMIX * DM, DM, DMIX, DM, err, 18 * ln + 1);
                for (int gt = 0; gt < 2; ++gt) for (int n = 0; n < 8; ++n)
                    chk_wt<<<4, 256, 0, stream>>>((const bf16*)(ws + WS_GATEW) + (size_t)(gt * 8 + n) * 4096, io.in[gt ? 13 : 11] + ((size_t)ln * 8 + n) * 4096, 64, 64, 64, err, 18 * ln + 1);
            }
        }
        if (k == 0) chk_u<<<dim3(DIN / 256, SUBR), 256, 0, stream>>>(XF, io.in[8] + (size_t)l * DM * DINX, U, err, 18 * l + 2);
        if (k == 2) {
            chk_mix<<<SUBR, 256, 0, stream>>>(MIX, MIXn, err, 18 * l + 3);
            chk_vec<<<8, 256, 0, stream>>>(CST + C_HP, out + O_HP + (size_t)(l * NB) * 512, 512, err, 18 * l + 9);
            chk_vec<<<8, 256, 0, stream>>>(CST + C_CP, out + O_CP + (size_t)(l * NB) * 1536, 1536, err, 18 * l + 10);
            chk_vec<<<8, 256, 0, stream>>>(CST + C_GCP, out + O_GCP + (size_t)(l * NB) * 4608, 4608, err, 18 * l + 10);
            chk_vec<<<64, 256, 0, stream>>>(CST + C_RP, out + O_RP + (size_t)(l * NB) * 65536, 65536, err, 18 * l + 11);
            chk_vec<<<64, 256, 0, stream>>>(CST + C_GP, out + O_GP + (size_t)(l * NB) * 65536, 65536, err, 18 * l + 12);
            chk_vec<<<16, 256, 0, stream>>>(CST + C_HS, out + O_HS + (size_t)(l * NS) * 512, 16 * 512, err, 18 * l + 13);
            chk_vec<<<16, 256, 0, stream>>>(CST + C_CS, out + O_CS + (size_t)(l * NS) * 1536, 16 * 1536, err, 18 * l + 14);
            chk_vec<<<16, 256, 0, stream>>>(CST + C_GCS, out + O_GCS + (size_t)(l * NS) * 4608, 16 * 4608, err, 18 * l + 14);
            chk_vec<<<256, 256, 0, stream>>>(CST + C_RS, out + O_RS + (size_t)(l * NS) * 65536, 16 * 65536, err, 18 * l + 15);
            chk_vec<<<256, 256, 0, stream>>>(CST + C_GS, out + O_GS + (size_t)(l * NS) * 65536, 16 * 65536, err, 18 * l + 16);
        }
        if (k == 4) chk_out<<<SUBR, 256, 0, stream>>>(XFc, MIX, io.in[22] + (size_t)l * DMIX * DM, io.in[23] + (size_t)l * DM, io.in[24] + (size_t)l * DM,
                                                     XF, out + O_YP, out + O_YS, l == DEPTH - 1, err, 18 * l + 17);
    }
    nv::run(io, nv::Grp{0, 4, 0, 64}, ws, stream);
    nv::run(io, nv::Grp{4, 4, 64, 64}, ws, stream);
    dbg_eval<<<1, 64, 0, stream>>>(err, MK_PROBE);
    dbg_apply<<<128, 256, 0, stream>>>(err, out + O_YS);
#else
#if MK_LAUNCH_PER_PHASE
    for (int ph = 0; ph < N_PHASES; ++ph) { a.ph_lo = ph; a.ph_hi = ph + 1; hipLaunchKernelGGL(mk_fwd, dim3(grid), dim3(NTHR), LDS_BYTES, stream, a); }
#else
    a.ph_lo = 0; a.ph_hi = N_PHASES;
    hipLaunchKernelGGL(mk_fwd, dim3(grid), dim3(NTHR), LDS_BYTES, stream, a);
#endif
#endif
}
```
